# Optimizing an MI355X kernel written in HIP

```python
import jax, jax.numpy as jnp
from jax import lax
import numpy as np

D_MODEL = 1024
BATCH = 16
SEQ = 2048
DEPTH = 4

HEAD_DIM = D_MODEL // 16
NSA_HEADS = 8
NSA_KV_GROUPS = 2
FOX_HEADS = 4
MOBA_HEADS = 4
MIX_WIDTH = (NSA_HEADS + FOX_HEADS + MOBA_HEADS) * HEAD_DIM
ROPE_DIM = HEAD_DIM // 4
ROPE_THETA = 500000.0
CMP_LEN = 32
CMP_STRIDE = 16
CMP_HIDDEN = 4 * HEAD_DIM
SLC_LEN = 64
SLC_TOPN = 8
WIN = 512
MOBA_BLOCK = 256
MOBA_TOPK = 3
QBLOCK = 128
GATHER_CHUNK = 32
D_FF = 256 * ((8 * D_MODEL // 3 + 255) // 256)
FOX_FGATE_BIAS = 3.0
MAX_POS_OFFSET = 4096
EPS = 1e-6

_NSA_KV = NSA_KV_GROUPS * HEAD_DIM
IN_SPLITS = (
    ("nsa_q", NSA_HEADS * HEAD_DIM),
    ("nsa_kc", _NSA_KV), ("nsa_vc", _NSA_KV),
    ("nsa_ks", _NSA_KV), ("nsa_vs", _NSA_KV),
    ("nsa_kw", _NSA_KV), ("nsa_vw", _NSA_KV),
    ("nsa_gate", 3 * NSA_HEADS),
    ("fox_q", FOX_HEADS * HEAD_DIM), ("fox_k", FOX_HEADS * HEAD_DIM),
    ("fox_v", FOX_HEADS * HEAD_DIM), ("fox_f", FOX_HEADS),
    ("moba_q", MOBA_HEADS * HEAD_DIM), ("moba_k", MOBA_HEADS * HEAD_DIM),
    ("moba_v", MOBA_HEADS * HEAD_DIM),
)
IN_COLS = sum(w for _, w in IN_SPLITS)

kernel_name = "hymba_nsa_fox_moba_macaron_adaln"


def rms_norm(x, g):
    xf = x.astype(jnp.float32)
    y = xf * lax.rsqrt(jnp.mean(xf * xf, axis=-1, keepdims=True) + EPS)
    return (y * g.astype(jnp.float32)).astype(x.dtype)


def ada_norm(x, g, shift, scale):
    return rms_norm(x, g) * (1 + scale[:, None, :]) + shift[:, None, :]


def swiglu(h, w13, w2):
    a, b = jnp.split(h @ w13, 2, axis=-1)
    return (jax.nn.silu(a) * b) @ w2


def masked_softmax(s, mask):
    s = jnp.where(mask, s.astype(jnp.float32), -jnp.inf)
    m = jnp.max(s, axis=-1, keepdims=True)
    m = jnp.where(jnp.isfinite(m), m, 0.0)
    e = jnp.exp(s - m)
    return e / jnp.maximum(jnp.sum(e, axis=-1, keepdims=True), 1e-30)


def rope_tables(positions):
    inv = ROPE_THETA ** (-jnp.arange(0, ROPE_DIM, 2, dtype=jnp.float32) / ROPE_DIM)
    ang = positions.astype(jnp.float32)[..., None] * inv
    return jnp.cos(ang), jnp.sin(ang)


def apply_rope(x, cos, sin):
    r, rest = x[..., :ROPE_DIM], x[..., ROPE_DIM:]
    r1, r2 = r[..., :ROPE_DIM // 2], r[..., ROPE_DIM // 2:]
    c, s = cos[:, :, None, :], sin[:, :, None, :]
    rot = jnp.concatenate([r1 * c - r2 * s, r2 * c + r1 * s], axis=-1).astype(x.dtype)
    return jnp.concatenate([rot, rest], axis=-1)


def split_blocks(a, axis, size):
    n = a.shape[axis] // size
    a = a.reshape(a.shape[:axis] + (n, size) + a.shape[axis + 1:])
    return jnp.moveaxis(a, axis, 0)


def merge_blocks(a, axis):
    a = jnp.moveaxis(a, 0, axis)
    return a.reshape(a.shape[:axis] + (a.shape[axis] * a.shape[axis + 1],) + a.shape[axis + 2:])


def nsa_mixer(q, kc, vc, ks, vs, kw, vw, gates, cmp_pos, cmp_w1, cmp_w2):
    B, S = q.shape[0], q.shape[1]
    G, R, D = NSA_KV_GROUPS, NSA_HEADS // NSA_KV_GROUPS, HEAD_DIM
    scale = D ** -0.5
    qg = q.reshape(B, S, G, R, D).transpose(0, 2, 3, 1, 4)
    t = np.arange(S)

    n_c = (S - CMP_LEN) // CMP_STRIDE + 1
    win_idx = np.arange(n_c)[:, None] * CMP_STRIDE + np.arange(CMP_LEN)[None, :]

    def compress(z, pos, w1, w2):
        zb = z[:, win_idx] + pos[None, None, :, None, :]
        zb = zb.transpose(0, 3, 1, 2, 4).reshape(B, G, n_c, CMP_LEN * D)
        return jax.nn.gelu(zb @ w1) @ w2

    kcmp = compress(kc, cmp_pos[0], cmp_w1[0], cmp_w2[0])
    vcmp = compress(vc, cmp_pos[1], cmp_w1[1], cmp_w2[1])
    cmp_end = np.arange(n_c) * CMP_STRIDE + CMP_LEN - 1
    cmp_mask = cmp_end[None, :] <= t[:, None]
    s_cmp = jnp.einsum('bgrsd,bgcd->bgrsc', qg, kcmp) * scale
    p_cmp = masked_softmax(s_cmp, cmp_mask)
    o_cmp = jnp.einsum('bgrsc,bgcd->bgrsd', p_cmp.astype(vcmp.dtype), vcmp)

    n_s = S // SLC_LEN
    c0 = np.arange(n_c)[:, None] * CMP_STRIDE
    j0 = np.arange(n_s)[None, :] * SLC_LEN
    overlap = ((c0 < j0 + SLC_LEN) & (c0 + CMP_LEN > j0)).astype(np.float32)
    imp = jnp.einsum('bgrsc,cj->bgsj', p_cmp, jnp.asarray(overlap))
    tb = (t // SLC_LEN)[:, None]
    jj = np.arange(n_s)[None, :]
    valid = jj <= tb
    forced = (jj == 0) | (jj == tb) | (jj == tb - 1)
    imp = jnp.where(valid, jnp.where(forced, jnp.inf, imp), -jnp.inf)
    n_top = min(SLC_TOPN, n_s)
    top_val, top_idx = lax.top_k(imp, n_top)
    top_ok = top_val > -jnp.inf

    ks_blk = ks.reshape(B, n_s, SLC_LEN, G, D).transpose(0, 3, 1, 2, 4)
    vs_blk = vs.reshape(B, n_s, SLC_LEN, G, D).transpose(0, 3, 1, 2, 4)
    C = GATHER_CHUNK
    bi = jnp.arange(B)[:, None, None]
    gi = jnp.arange(G)[None, :, None]
    k_sel = n_top * SLC_LEN

    def slc_chunk(args):
        qc, idx, ok, q0 = args
        flat = idx.reshape(B, G, C * n_top)
        kg = ks_blk[bi, gi, flat].reshape(B, G, C, k_sel, D)
        vg = vs_blk[bi, gi, flat].reshape(B, G, C, k_sel, D)
        kpos = (idx[..., None] * SLC_LEN + jnp.arange(SLC_LEN)).reshape(B, G, C, k_sel)
        qpos = q0 + jnp.arange(C)
        mask = jnp.repeat(ok, SLC_LEN, axis=-1) & (kpos <= qpos[:, None])
        s = jnp.einsum('bgrcd,bgckd->bgrck', qc, kg) * scale
        p = masked_softmax(s, mask[:, :, None])
        return jnp.einsum('bgrck,bgckd->bgrcd', p.astype(vg.dtype), vg)

    o_slc = lax.map(slc_chunk, (split_blocks(qg, 3, C), split_blocks(top_idx, 2, C),
                                split_blocks(top_ok, 2, C), jnp.arange(S // C) * C))
    o_slc = merge_blocks(o_slc, 3)

    kw_p = jnp.pad(kw.transpose(0, 2, 1, 3), ((0, 0), (0, 0), (WIN, 0), (0, 0)))
    vw_p = jnp.pad(vw.transpose(0, 2, 1, 3), ((0, 0), (0, 0), (WIN, 0), (0, 0)))
    span = WIN + QBLOCK

    def win_block(args):
        qb, q0 = args
        kb = lax.dynamic_slice_in_dim(kw_p, q0, span, axis=2)
        vb = lax.dynamic_slice_in_dim(vw_p, q0, span, axis=2)
        qpos = q0 + jnp.arange(QBLOCK)
        kpos = q0 - WIN + jnp.arange(span)
        d = qpos[:, None] - kpos[None, :]
        mask = (kpos[None, :] >= 0) & (d >= 0) & (d < WIN)
        s = jnp.einsum('bgrqd,bgkd->bgrqk', qb, kb) * scale
        p = masked_softmax(s, mask)
        return jnp.einsum('bgrqk,bgkd->bgrqd', p.astype(vb.dtype), vb)

    o_win = lax.map(win_block, (split_blocks(qg, 3, QBLOCK), jnp.arange(S // QBLOCK) * QBLOCK))
    o_win = merge_blocks(o_win, 3)

    g = gates.reshape(B, S, G, R, 3).transpose(0, 2, 3, 1, 4)
    o = g[..., 0:1] * o_cmp + g[..., 1:2] * o_slc + g[..., 2:3] * o_win
    return o.transpose(0, 3, 1, 2, 4).reshape(B, S, NSA_HEADS * D)


def fox_mixer(q, k, v, f_logit, f_bias):
    B, S, H, D = q.shape
    scale = D ** -0.5
    logf = jax.nn.log_sigmoid((f_logit + f_bias).astype(jnp.float32))
    F = jnp.cumsum(logf, axis=1).transpose(0, 2, 1)
    qt, kt, vt = (a.transpose(0, 2, 1, 3) for a in (q, k, v))
    kpos = jnp.arange(S)

    def blk(args):
        qb, Fq, q0 = args
        s = (jnp.einsum('bhqd,bhkd->bhqk', qb, kt).astype(jnp.float32) * scale
             + Fq[..., None] - F[:, :, None, :])
        qpos = q0 + jnp.arange(QBLOCK)
        p = masked_softmax(s, kpos[None, :] <= qpos[:, None])
        return jnp.einsum('bhqk,bhkd->bhqd', p.astype(vt.dtype), vt)

    o = lax.map(blk, (split_blocks(qt, 2, QBLOCK), split_blocks(F, 2, QBLOCK),
                      jnp.arange(S // QBLOCK) * QBLOCK))
    o = merge_blocks(o, 2)
    return o.transpose(0, 2, 1, 3).reshape(B, S, H * D)


def moba_mixer(q, k, v):
    B, S, H, D = q.shape
    scale = D ** -0.5
    qt, kt, vt = (a.transpose(0, 2, 1, 3) for a in (q, k, v))
    NB = -(-S // MOBA_BLOCK)
    Sp = NB * MOBA_BLOCK
    kp = jnp.pad(kt, ((0, 0), (0, 0), (0, Sp - S), (0, 0)))
    vp = jnp.pad(vt, ((0, 0), (0, 0), (0, Sp - S), (0, 0)))
    kb = kp.reshape(B, H, NB, MOBA_BLOCK, D)
    vb = vp.reshape(B, H, NB, MOBA_BLOCK, D)
    n_sel = min(MOBA_TOPK, NB - 1)
    C = GATHER_CHUNK
    t = np.arange(S)
    xs = (split_blocks(qt, 2, C), jnp.arange(S // C) * C)
    if n_sel > 0:
        kmean = jnp.mean(kb.astype(jnp.float32), axis=3)
        gate = jnp.einsum('bhsd,bhnd->bhsn', qt.astype(jnp.float32), kmean)
        past = np.arange(NB)[None, :] < (t // MOBA_BLOCK)[:, None]
        gate = jnp.where(past, gate, -jnp.inf)
        top_val, top_idx = lax.top_k(gate, n_sel)
        xs = xs + (split_blocks(top_idx, 2, C), split_blocks(top_val > -jnp.inf, 2, C))
    bi = jnp.arange(B)[:, None, None]
    hi = jnp.arange(H)[None, :, None]
    k_sel = n_sel * MOBA_BLOCK

    def chunk(args):
        qc, q0 = args[0], args[1]
        own = q0 // MOBA_BLOCK
        k_own = lax.dynamic_slice_in_dim(kp, own * MOBA_BLOCK, MOBA_BLOCK, axis=2)
        v_own = lax.dynamic_slice_in_dim(vp, own * MOBA_BLOCK, MOBA_BLOCK, axis=2)
        qpos = q0 + jnp.arange(C)
        own_pos = own * MOBA_BLOCK + jnp.arange(MOBA_BLOCK)
        s_own = jnp.einsum('bhcd,bhkd->bhck', qc, k_own) * scale
        m_own = jnp.broadcast_to(own_pos[None, :] <= qpos[:, None], s_own.shape)
        if n_sel == 0:
            p = masked_softmax(s_own, m_own)
            return jnp.einsum('bhck,bhkd->bhcd', p.astype(v_own.dtype), v_own)
        idx, ok = args[2], args[3]
        flat = idx.reshape(B, H, C * n_sel)
        kg = kb[bi, hi, flat].reshape(B, H, C, k_sel, D)
        vg = vb[bi, hi, flat].reshape(B, H, C, k_sel, D)
        s_sel = jnp.einsum('bhcd,bhckd->bhck', qc, kg) * scale
        m_sel = jnp.repeat(ok, MOBA_BLOCK, axis=-1)
        p = masked_softmax(jnp.concatenate([s_sel, s_own], axis=-1),
                           jnp.concatenate([m_sel, m_own], axis=-1))
        p = p.astype(vg.dtype)
        return (jnp.einsum('bhck,bhckd->bhcd', p[..., :k_sel], vg)
                + jnp.einsum('bhck,bhkd->bhcd', p[..., k_sel:], v_own))

    o = merge_blocks(lax.map(chunk, xs), 2)
    return o.transpose(0, 2, 1, 3).reshape(B, S, H * D)


def token_mixer(h, w_in, f_bias, cmp_pos, cmp_w1, cmp_w2, w_out, cos, sin):
    B, S, _ = h.shape
    proj = h @ w_in
    parts = {}
    off = 0
    for name, width in IN_SPLITS:
        parts[name] = proj[..., off:off + width]
        off += width

    def heads(a, n):
        return a.reshape(B, S, n, HEAD_DIM)

    o_nsa = nsa_mixer(
        apply_rope(heads(parts['nsa_q'], NSA_HEADS), cos, sin),
        apply_rope(heads(parts['nsa_kc'], NSA_KV_GROUPS), cos, sin), heads(parts['nsa_vc'], NSA_KV_GROUPS),
        apply_rope(heads(parts['nsa_ks'], NSA_KV_GROUPS), cos, sin), heads(parts['nsa_vs'], NSA_KV_GROUPS),
        apply_rope(heads(parts['nsa_kw'], NSA_KV_GROUPS), cos, sin), heads(parts['nsa_vw'], NSA_KV_GROUPS),
        jax.nn.sigmoid(parts['nsa_gate']).reshape(B, S, NSA_HEADS, 3),
        cmp_pos, cmp_w1, cmp_w2)
    o_fox = fox_mixer(heads(parts['fox_q'], FOX_HEADS), heads(parts['fox_k'], FOX_HEADS),
                      heads(parts['fox_v'], FOX_HEADS), parts['fox_f'], f_bias)
    o_moba = moba_mixer(apply_rope(heads(parts['moba_q'], MOBA_HEADS), cos, sin),
                        apply_rope(heads(parts['moba_k'], MOBA_HEADS), cos, sin),
                        heads(parts['moba_v'], MOBA_HEADS))
    return jnp.concatenate([o_nsa, o_fox, o_moba], axis=-1) @ w_out


def setup_inputs(seed: int = 0) -> dict:
    key = jax.random.key(seed)
    ks = jax.random.split(key, 16)
    D = D_MODEL

    def nrm(k, shape, s):
        return jax.random.normal(k, shape, jnp.float32) * s

    x = nrm(ks[0], (BATCH, SEQ, D), 1.0)
    c = nrm(ks[1], (BATCH, D), 1.0)
    offset = jax.random.randint(ks[2], (BATCH, 1), 0, MAX_POS_OFFSET, dtype=jnp.int32)
    positions = offset + jnp.arange(SEQ, dtype=jnp.int32)[None, :]
    return {
        "x": x,
        "c": c,
        "positions": positions,
        "norm_g": 1.0 + nrm(ks[3], (DEPTH, 3, D), 0.05),
        "w_ada": nrm(ks[4], (DEPTH, D, 9 * D), 0.5 * D ** -0.5),
        "b_ada": nrm(ks[5], (DEPTH, 9 * D), 0.01),
        "w_in": nrm(ks[6], (DEPTH, D, IN_COLS), D ** -0.5),
        "fox_fbias": FOX_FGATE_BIAS + nrm(ks[7], (DEPTH, FOX_HEADS), 0.1),
        "cmp_pos": nrm(ks[8], (DEPTH, 2, CMP_LEN, HEAD_DIM), 0.1),
        "cmp_w1": nrm(ks[9], (DEPTH, 2, CMP_LEN * HEAD_DIM, CMP_HIDDEN), (CMP_LEN * HEAD_DIM) ** -0.5),
        "cmp_w2": nrm(ks[10], (DEPTH, 2, CMP_HIDDEN, HEAD_DIM), CMP_HIDDEN ** -0.5),
        "w_out": nrm(ks[11], (DEPTH, MIX_WIDTH, D), MIX_WIDTH ** -0.5),
        "ffn_w13": nrm(ks[12], (DEPTH, 2, D, 2 * D_FF), D ** -0.5),
        "ffn_w2": nrm(ks[13], (DEPTH, 2, D_FF, D), D_FF ** -0.5),
        "final_g": 1.0 + nrm(ks[14], (D,), 0.05),
    }


def reference(x, c, positions, norm_g, w_ada, b_ada, w_in, fox_fbias, cmp_pos, cmp_w1, cmp_w2,
              w_out, ffn_w13, ffn_w2, final_g):
    cos, sin = rope_tables(positions)
    c_act = jax.nn.silu(c)
    B = x.shape[0]
    for l in range(DEPTH):
        mod = (c_act @ w_ada[l] + b_ada[l]).reshape(B, 3, 3, D_MODEL)
        h = ada_norm(x, norm_g[l, 0], mod[:, 0, 0], mod[:, 0, 1])
        x = x + 0.5 * mod[:, 0, 2][:, None, :] * swiglu(h, ffn_w13[l, 0], ffn_w2[l, 0])
        h = ada_norm(x, norm_g[l, 1], mod[:, 1, 0], mod[:, 1, 1])
        x = x + mod[:, 1, 2][:, None, :] * token_mixer(h, w_in[l], fox_fbias[l], cmp_pos[l], cmp_w1[l],
                                                        cmp_w2[l], w_out[l], cos, sin)
        h = ada_norm(x, norm_g[l, 2], mod[:, 2, 0], mod[:, 2, 1])
        x = x + 0.5 * mod[:, 2, 2][:, None, :] * swiglu(h, ffn_w13[l, 1], ffn_w2[l, 1])
    return rms_norm(x, final_g)
```

```cpp
#include <hip/hip_runtime.h>
#include <hip/hip_cooperative_groups.h>
#include <cstdio>
#include <cstdint>
namespace cg = cooperative_groups;

#define LAS __attribute__((address_space(3)))
typedef unsigned short bf16_t;
typedef short bf16x8 __attribute__((ext_vector_type(8)));
typedef short s16x4 __attribute__((ext_vector_type(4)));
typedef float f32x4 __attribute__((ext_vector_type(4)));
typedef float f32x2 __attribute__((ext_vector_type(2)));
typedef float f32x16 __attribute__((ext_vector_type(16)));
typedef unsigned u32x4 __attribute__((ext_vector_type(4)));
typedef unsigned u32x2 __attribute__((ext_vector_type(2)));
typedef __bf16 bf16x2_t __attribute__((ext_vector_type(2)));

constexpr int NB = 16, SEQ = 2048, DM = 1024, NTOK = NB * SEQ, DEPTH = 4, FF = 2816, NIN = 3072, NADA = 9216;
constexpr float LOG2E = 1.4426950408889634f;
constexpr float QK_C2 = 0.125f * LOG2E;
constexpr float NEG_INF = -__builtin_inff();

constexpr size_t MiB = 1u << 20;
constexpr size_t WS_CTL = 0;
constexpr size_t WS_B1 = 4 * MiB;
constexpr size_t WS_MOD = 1 * MiB;
constexpr size_t WS_COS = 5 * MiB, WS_SIN = 6 * MiB;
constexpr size_t WS_CW2T = 7 * MiB;
constexpr size_t WS_WIN = 8 * MiB;
constexpr size_t WS_WOUT = 32 * MiB;
constexpr size_t WS_CW1 = 40 * MiB;
constexpr size_t WS_W13 = 48 * MiB;
constexpr size_t WS_W2 = 136 * MiB;
constexpr size_t WS_H = 180 * MiB;
constexpr size_t WS_BIG = 244 * MiB;
constexpr size_t WS_QNSA = 244 * MiB;
constexpr size_t WS_KC = 276 * MiB;
constexpr size_t WS_VC = 285 * MiB;
constexpr size_t WS_KS = 294 * MiB, WS_KW = 302 * MiB;
constexpr size_t WS_FOXQ = 310 * MiB;
constexpr size_t WS_FOXK = 326 * MiB;
constexpr size_t WS_MOBAQ = 342 * MiB, WS_MOBAK = 358 * MiB;
constexpr size_t WS_VST = 374 * MiB, WS_VWT = 382 * MiB;
constexpr size_t WS_FOXVT = 390 * MiB, WS_MOBAVT = 406 * MiB;
constexpr size_t WS_GATES = 422 * MiB;
constexpr size_t WS_FLOG = 425 * MiB;
constexpr size_t WS_FCUM = 426 * MiB;
constexpr size_t WS_KMEAN = 427 * MiB;
constexpr size_t WS_CMPHID = 428 * MiB;
constexpr size_t WS_KCMP = 432 * MiB;
constexpr size_t WS_VCMPT = 433 * MiB;
constexpr size_t WS_END = 436 * MiB;

constexpr int RING_BYTES = 131072;
constexpr int LDS_BYTES = 147456;
constexpr int NWAVES = 8;

__device__ __forceinline__ unsigned cvtpk(float lo, float hi) { f32x2 v = {lo, hi}; bf16x2_t b = __builtin_convertvector(v, bf16x2_t); return __builtin_bit_cast(unsigned, b); }
__device__ __forceinline__ float bf2f(short s) { return __uint_as_float(((unsigned)(unsigned short)s) << 16); }
__device__ __forceinline__ float fast_exp2(float x) { return __builtin_amdgcn_exp2f(x); }
__device__ __forceinline__ float fast_rcp(float x) { return __builtin_amdgcn_rcpf(x); }
__device__ __forceinline__ float silu_f(float a) { return a * fast_rcp(1.0f + fast_exp2(-a * LOG2E)); }
__device__ __forceinline__ float sigmoid_f(float a) { return 1.0f / (1.0f + __expf(-a)); }
__device__ __forceinline__ float gelu_tanh(float x) {
    const float u = 0.7978845608028654f * (x + 0.044715f * x * x * x);
    const float e = fast_exp2(2.0f * LOG2E * u);
    const float th = 1.0f - 2.0f * fast_rcp(e + 1.0f);
    return 0.5f * x * (1.0f + th);
}
__device__ __forceinline__ float wave_sum(float v) {
#pragma unroll
    for (int o = 1; o < 64; o <<= 1) v += __shfl_xor(v, o);
    return v;
}
__device__ __forceinline__ unsigned char* launder_p(unsigned char* p) { size_t z = 0; asm volatile("" : "+s"(z)); return p + z; }
__device__ __forceinline__ int launder_i(int v) { asm volatile("" : "+s"(v)); return v; }
__device__ __forceinline__ int launder_v(int v) { asm volatile("" : "+v"(v)); return v; }
__device__ __forceinline__ int fresh_lane() { unsigned m = ~0u; asm volatile("" : "+s"(m)); return (int)__builtin_amdgcn_mbcnt_hi(m, __builtin_amdgcn_mbcnt_lo(m, 0u)); }
__device__ __forceinline__ int crow(int r, int hi) { return (r & 3) + 8 * (r >> 2) + 4 * hi; }

namespace pg8 {
constexpr int BM = 256, BK = 64, HALF = 128, HTB = HALF * BK * 2, STAGE_BYTES = 8 * HTB, NXCD = 8, WGM = 8;
__host__ __device__ __forceinline__ int lds_byte(int r, int c) { const int st = (r >> 4) * 2 + (c >> 5), rr = r & 15, cc = c & 31, ob = rr * 64 + cc * 2; return st * 1024 + (ob ^ (((ob >> 9) & 1) << 5)); }
__host__ __device__ __forceinline__ void stage_rc(int b, int& R, int& C) { const int st = b / 1024, sb = b % 1024, swz = sb ^ (((sb >> 9) & 1) << 5); R = (st >> 1) * 16 + swz / 64; C = (st & 1) * 32 + (swz % 64) / 2; }
__host__ __device__ __forceinline__ int perm32(int rho) { const int n = rho >> 4, i = rho & 15; return 8 * (i >> 2) + 4 * n + (i & 3); }

struct Unit { int pm, pn; };
struct Gemm { const bf16_t* A; const bf16_t* Bt; int M, N, K, lda; };

struct StaticOrder {
    int nM, nN, nwg, G, c;
    __device__ void init(int M, int N, int G_, int c_) { nM = M / BM; nN = N / BM; nwg = nM * nN; G = G_; c = c_; }
    __device__ bool next(int i, Unit& u) const {
        const long L = (long)i * G + c; if (L >= nwg) return false;
        int wgid = (int)L; { const int q = nwg / NXCD, r = nwg % NXCD, xcd = wgid % NXCD, off = wgid / NXCD; wgid = (xcd < r ? xcd * (q + 1) : r * (q + 1) + (xcd - r) * q) + off; }
        const int nig = WGM * nN, gid = wgid / nig, fm = gid * WGM, gsz = (nM - fm) < WGM ? (nM - fm) : WGM;
        u.pm = fm + ((wgid % nig) % gsz); u.pn = (wgid % nig) / gsz; return true;
    }
};

template <class Epi, bool ALIGN_EPI>
__device__ __forceinline__ void gemm_phase(LAS unsigned char* lds, const Gemm g, const StaticOrder& S, const Epi& E, int wave0) {
    const int wid = wave0, lane = fresh_lane(), tid = wid * 64 + lane, wr = wid >> 2, wc = wid & 3, fr = lane & 15, fq = lane >> 4;
    const int K = g.K, nt = K / BK, lda = g.lda;
    unsigned voffA[2], voffB[2];
#pragma unroll
    for (int i = 0; i < 2; ++i) { int R, C; stage_rc(tid * 16 + i * 8192, R, C); const int Rb = Epi::PERM ? ((R & ~31) + perm32(R & 31)) : R;
        voffA[i] = (unsigned)(R * lda + C) * 2u; voffB[i] = (unsigned)(Rb * K + C) * 2u; }
    const size_t kstep = (size_t)(BK * 2);
    const size_t hstepA = (size_t)HALF * lda * 2, hstepB = (size_t)HALF * K * 2;
    const size_t tstepA = 2 * hstepA, tstepB = 2 * hstepB;
    const unsigned ldsw = (unsigned)wid * 1024u;
    const int aoff = lds_byte(wr * 64 + fr, fq * 8), boff = lds_byte(wc * 32 + fr, fq * 8);
#define PG8_SA(b, h) (((b) * 2 + (h)) * HTB)
#define PG8_SB(b, h) ((4 + (b) * 2 + (h)) * HTB)
#define PG8_STAGE(bufoff, gbase, voff) do { _Pragma("unroll") for (int _i = 0; _i < 2; ++_i) \
        __builtin_amdgcn_global_load_lds((const unsigned*)((const char*)(gbase) + (voff)[_i]), (LAS unsigned*)(lds + (bufoff) + ldsw + _i * 8192), 16, 0, 0); } while (0)
#define PG8_LDA(dst, b, h) do { _Pragma("unroll") for (int m = 0; m < 4; ++m) _Pragma("unroll") for (int k = 0; k < 2; ++k) dst[m][k] = *(const LAS bf16x8*)(lds + PG8_SA(b, h) + aoff + m * 2048 + k * 1024); } while (0)
#define PG8_LDB(dst, b, h) do { _Pragma("unroll") for (int n = 0; n < 2; ++n) _Pragma("unroll") for (int k = 0; k < 2; ++k) dst[n][k] = *(const LAS bf16x8*)(lds + PG8_SB(b, h) + boff + n * 2048 + k * 1024); } while (0)
#define PG8_MMA(ai, bj, At, Bt) do { __builtin_amdgcn_s_setprio(1); _Pragma("unroll") for (int m = 0; m < 4; ++m) _Pragma("unroll") for (int n = 0; n < 2; ++n) _Pragma("unroll") for (int k = 0; k < 2; ++k) \
        acc[ai][bj][m][n] = __builtin_amdgcn_mfma_f32_16x16x32_bf16(Bt[n][k], At[m][k], acc[ai][bj][m][n], 0, 0, 0); __builtin_amdgcn_s_setprio(0); } while (0)
#define PG8_WAIT_V(n) asm volatile("s_waitcnt vmcnt(" #n ")" ::: "memory")
#define PG8_WAIT_L(n) asm volatile("s_waitcnt lgkmcnt(" #n ")" ::: "memory")
#define PG8_BAR __builtin_amdgcn_s_barrier()
#define PG8_SCHED __builtin_amdgcn_sched_barrier(0)
    Unit cur, nxt; int ui = 0;
    if (!S.next(0, cur)) return;
    f32x4 acc[2][2][4][2];
#pragma unroll
    for (int a = 0; a < 2; ++a)
#pragma unroll
        for (int b = 0; b < 2; ++b)
#pragma unroll
            for (int m = 0; m < 4; ++m)
#pragma unroll
                for (int n = 0; n < 2; ++n) acc[a][b][m][n] = (f32x4){0.f, 0.f, 0.f, 0.f};
    bf16x8 At[4][2], B0[2][2], B1[2][2];
    const char* cA = (const char*)g.A + (size_t)cur.pm * tstepA; const char* cB = (const char*)g.Bt + (size_t)cur.pn * tstepB;
    PG8_STAGE(PG8_SB(0, 0), cB, voffB); PG8_STAGE(PG8_SB(0, 1), cB + hstepB, voffB); PG8_STAGE(PG8_SA(0, 0), cA, voffA); PG8_STAGE(PG8_SA(0, 1), cA + hstepA, voffA);
    if (wr == 1) PG8_BAR;
    PG8_WAIT_V(2); PG8_BAR;
    PG8_STAGE(PG8_SB(1, 0), cB + kstep, voffB); PG8_STAGE(PG8_SA(1, 0), cA + kstep, voffA); PG8_STAGE(PG8_SB(1, 1), cB + hstepB + kstep, voffB);
    PG8_WAIT_V(6); PG8_BAR;
    for (;;) {
        const bool has_next = S.next(ui + 1, nxt);
        const char* nA = has_next ? (const char*)g.A + (size_t)nxt.pm * tstepA : cA; const char* nB = has_next ? (const char*)g.Bt + (size_t)nxt.pn * tstepB : cB;
        for (int t = 0; t < nt; t += 2) {
            const bool last = (t == nt - 2);
            const char* a1 = cA + (size_t)(t + 1) * kstep;
            const char* a2 = last ? nA : cA + (size_t)(t + 2) * kstep; const char* b2 = last ? nB : cB + (size_t)(t + 2) * kstep;
            const char* a3 = a2 + kstep; const char* b3 = b2 + kstep;
            PG8_LDB(B0, 0, 0); PG8_LDB(B1, 0, 1); PG8_SCHED; PG8_LDA(At, 0, 0); PG8_STAGE(PG8_SA(1, 1), a1 + hstepA, voffA);
            PG8_WAIT_V(8); PG8_WAIT_L(0); PG8_BAR; PG8_MMA(0, 0, At, B0); PG8_MMA(0, 1, At, B1); PG8_BAR; PG8_SCHED;
            PG8_LDA(At, 0, 1); PG8_STAGE(PG8_SB(0, 0), b2, voffB); PG8_STAGE(PG8_SB(0, 1), b2 + hstepB, voffB); PG8_STAGE(PG8_SA(0, 0), a2, voffA);
            PG8_WAIT_V(8); PG8_WAIT_L(0); PG8_BAR; PG8_MMA(1, 0, At, B0); PG8_MMA(1, 1, At, B1); PG8_BAR; PG8_SCHED;
            PG8_LDB(B0, 1, 0); PG8_LDB(B1, 1, 1); PG8_SCHED; PG8_LDA(At, 1, 0); PG8_STAGE(PG8_SA(0, 1), a2 + hstepA, voffA);
            PG8_WAIT_V(8); PG8_WAIT_L(0); PG8_BAR; PG8_MMA(0, 0, At, B0); PG8_MMA(0, 1, At, B1); PG8_BAR; PG8_SCHED;
            PG8_LDA(At, 1, 1); PG8_STAGE(PG8_SB(1, 0), b3, voffB); PG8_STAGE(PG8_SB(1, 1), b3 + hstepB, voffB); PG8_STAGE(PG8_SA(1, 0), a3, voffA);
            PG8_WAIT_V(8); PG8_WAIT_L(0); PG8_BAR; PG8_MMA(1, 0, At, B0); PG8_MMA(1, 1, At, B1); PG8_BAR; PG8_SCHED;
        }
        if constexpr (ALIGN_EPI) { if (wr == 0) PG8_BAR; }
        { int efr = fr, efq = fq, ewr = wr, ewc = wc; asm volatile("" : "+v"(efr), "+v"(efq), "+s"(ewr), "+s"(ewc)); E(acc, cur, ewr, ewc, efr, efq); }
        if (!has_next) break;
#pragma unroll
        for (int a = 0; a < 2; ++a)
#pragma unroll
            for (int b = 0; b < 2; ++b)
#pragma unroll
                for (int m = 0; m < 4; ++m)
#pragma unroll
                    for (int n = 0; n < 2; ++n) acc[a][b][m][n] = (f32x4){0.f, 0.f, 0.f, 0.f};
        cur = nxt; cA = nA; cB = nB; ++ui;
        if constexpr (ALIGN_EPI) { if (wr == 1) PG8_BAR; }
    }
    PG8_WAIT_V(0);
    if constexpr (!ALIGN_EPI) { if (wr == 0) PG8_BAR; }
    PG8_BAR;
#undef PG8_SA
#undef PG8_SB
#undef PG8_STAGE
#undef PG8_LDA
#undef PG8_LDB
#undef PG8_MMA
#undef PG8_WAIT_V
#undef PG8_WAIT_L
#undef PG8_BAR
#undef PG8_SCHED
}
}

struct EpiSwiglu {
    static constexpr bool PERM = true;
    bf16_t* O;
    __device__ __forceinline__ void operator()(const f32x4 (&acc)[2][2][4][2], const pg8::Unit& u, int wr, int wc, int fr, int fq) const {
        const int row0 = u.pm * 256 + wr * 64 + fr, col0 = u.pn * 128 + wc * 32 + 8 * fq;
#pragma unroll
        for (int ai = 0; ai < 2; ++ai)
#pragma unroll
            for (int m = 0; m < 4; ++m) {
                bf16_t* rowp = O + (size_t)(row0 + ai * 128 + m * 16) * FF + col0;
                const f32x4 a0 = acc[ai][0][m][0], a1 = acc[ai][0][m][1], b0 = acc[ai][1][m][0], b1 = acc[ai][1][m][1];
                u32x4 w;
                w.x = cvtpk(silu_f(a0[0]) * b0[0], silu_f(a0[1]) * b0[1]); w.y = cvtpk(silu_f(a0[2]) * b0[2], silu_f(a0[3]) * b0[3]);
                w.z = cvtpk(silu_f(a1[0]) * b1[0], silu_f(a1[1]) * b1[1]); w.w = cvtpk(silu_f(a1[2]) * b1[2], silu_f(a1[3]) * b1[3]);
                *(u32x4*)rowp = w;
            }
    }
};
struct EpiResid {
    static constexpr bool PERM = false;
    const float* xin; float* xout; const float* gate; float coef;
    __device__ __forceinline__ void operator()(const f32x4 (&acc)[2][2][4][2], const pg8::Unit& u, int wr, int wc, int fr, int fq) const {
        const int b = (u.pm * 256) >> 11;
        const int row0 = u.pm * 256 + wr * 64 + fr;
#pragma unroll
        for (int bj = 0; bj < 2; ++bj)
#pragma unroll
            for (int n = 0; n < 2; ++n) {
                const int col = u.pn * 256 + bj * 128 + wc * 32 + n * 16 + 4 * fq;
                const f32x4 gv = *(const f32x4*)(gate + (size_t)b * NADA + col) * coef;
                f32x4 xv[2][4];
#pragma unroll
                for (int ai = 0; ai < 2; ++ai)
#pragma unroll
                    for (int m = 0; m < 4; ++m) xv[ai][m] = *(const f32x4*)(xin + (size_t)(row0 + ai * 128 + m * 16) * DM + col);
#pragma unroll
                for (int ai = 0; ai < 2; ++ai)
#pragma unroll
                    for (int m = 0; m < 4; ++m) {
                        const size_t off = (size_t)(row0 + ai * 128 + m * 16) * DM + col;
                        *(f32x4*)(xout + off) = xv[ai][m] + gv * acc[ai][bj][m][n];
                    }
            }
    }
};
struct EpiGelu {
    static constexpr bool PERM = true;
    bf16_t* O; const float* bias;
    __device__ __forceinline__ void operator()(const f32x4 (&acc)[2][2][4][2], const pg8::Unit& u, int wr, int wc, int fr, int fq) const {
        const int row0 = u.pm * 256 + wr * 64 + fr;
#pragma unroll
        for (int bj = 0; bj < 2; ++bj) {
            const int col0 = u.pn * 256 + bj * 128 + wc * 32 + 8 * fq;
            const f32x4 bv0 = *(const f32x4*)(bias + col0), bv1 = *(const f32x4*)(bias + col0 + 4);
#pragma unroll
            for (int ai = 0; ai < 2; ++ai)
#pragma unroll
                for (int m = 0; m < 4; ++m) {
                    const f32x4 v0 = acc[ai][bj][m][0] + bv0, v1 = acc[ai][bj][m][1] + bv1;
                    u32x4 w;
                    w.x = cvtpk(gelu_tanh(v0[0]), gelu_tanh(v0[1])); w.y = cvtpk(gelu_tanh(v0[2]), gelu_tanh(v0[3]));
                    w.z = cvtpk(gelu_tanh(v1[0]), gelu_tanh(v1[1])); w.w = cvtpk(gelu_tanh(v1[2]), gelu_tanh(v1[3]));
                    *(u32x4*)(O + (size_t)(row0 + ai * 128 + m * 16) * 256 + col0) = w;
                }
        }
    }
};
struct EpiInProj {
    static constexpr bool PERM = true;
    unsigned char* ws; const float* fbias;
    __device__ __forceinline__ void operator()(const f32x4 (&acc)[2][2][4][2], const pg8::Unit& u, int wr, int wc, int fr, int fq) const {
        part<0>(acc, u, wr, wc, fr, fq); part<1>(acc, u, wr, wc, fr, fq);
    }
    template <int bj>
    __device__ __forceinline__ void part(const f32x4 (&acc)[2][2][4][2], const pg8::Unit& u, int wr, int wc, int fr, int fq) const {
        const float* cosT = (const float*)(ws + WS_COS); const float* sinT = (const float*)(ws + WS_SIN);
        {
            const int cb = u.pn * 256 + bj * 128 + wc * 32;
            const int hg = cb >> 6, half = (cb >> 5) & 1;
            if (hg > 44) return;
            int mode, NH = 1, hd = 0, pitch = 0; bool rope = false; bf16_t* base = nullptr;
            if (hg < 8)       { mode = 0; base = (bf16_t*)(ws + WS_QNSA); pitch = 512; hd = hg; rope = true; }
            else if (hg < 10) { mode = 1; base = (bf16_t*)(ws + WS_KC); NH = 2; hd = hg - 8; rope = true; }
            else if (hg < 12) { mode = 4; base = (bf16_t*)(ws + WS_KS); NH = 2; hd = hg - 10; rope = true; }
            else if (hg < 14) { mode = 4; base = (bf16_t*)(ws + WS_KW); NH = 2; hd = hg - 12; rope = true; }
            else if (hg < 18) { mode = 0; base = (bf16_t*)(ws + WS_FOXQ); pitch = 256; hd = hg - 14; }
            else if (hg < 22) { mode = 4; base = (bf16_t*)(ws + WS_FOXK); NH = 4; hd = hg - 18; }
            else if (hg < 26) { mode = 0; base = (bf16_t*)(ws + WS_MOBAQ); pitch = 256; hd = hg - 22; rope = true; }
            else if (hg < 30) { mode = 4; base = (bf16_t*)(ws + WS_MOBAK); NH = 4; hd = hg - 26; rope = true; }
            else if (hg < 32) { mode = 1; base = (bf16_t*)(ws + WS_VC); NH = 2; hd = hg - 30; }
            else if (hg < 34) { mode = 2; base = (bf16_t*)(ws + WS_VST); NH = 2; hd = hg - 32; }
            else if (hg < 36) { mode = 2; base = (bf16_t*)(ws + WS_VWT); NH = 2; hd = hg - 34; }
            else if (hg < 40) { mode = 2; base = (bf16_t*)(ws + WS_FOXVT); NH = 4; hd = hg - 36; }
            else if (hg < 44) { mode = 2; base = (bf16_t*)(ws + WS_MOBAVT); NH = 4; hd = hg - 40; }
            else { mode = 3; if (half) return; }
            const bool do_rope = rope && (half == 0);
#pragma unroll
            for (int ai = 0; ai < 2; ++ai)
#pragma unroll
                for (int m = 0; m < 4; ++m) {
                    const int row = u.pm * 256 + ai * 128 + wr * 64 + m * 16 + fr;
                    const int b = row >> 11, t = row & 2047;
                    float v[8];
#pragma unroll
                    for (int i = 0; i < 4; ++i) { v[i] = acc[ai][bj][m][0][i]; v[4 + i] = acc[ai][bj][m][1][i]; }
                    if (do_rope) {
                        float pr[8];
#pragma unroll
                        for (int i = 0; i < 8; ++i) pr[i] = __shfl_xor(v[i], 16);
                        if (fq < 2) {
                            const f32x4 c0 = *(const f32x4*)(cosT + (size_t)row * 8), c1 = *(const f32x4*)(cosT + (size_t)row * 8 + 4);
                            const f32x4 s0 = *(const f32x4*)(sinT + (size_t)row * 8), s1 = *(const f32x4*)(sinT + (size_t)row * 8 + 4);
                            const float sg = (fq == 0) ? -1.0f : 1.0f;
#pragma unroll
                            for (int i = 0; i < 4; ++i) { v[i] = v[i] * c0[i] + sg * pr[i] * s0[i]; v[4 + i] = v[4 + i] * c1[i] + sg * pr[4 + i] * s1[i]; }
                        }
                    }
                    if (mode == 3) {
                        float* gates = (float*)(ws + WS_GATES); float* flog = (float*)(ws + WS_FLOG);
                        if (fq < 3) {
                            f32x4 g0, g1;
#pragma unroll
                            for (int i = 0; i < 4; ++i) { g0[i] = sigmoid_f(v[i]); g1[i] = sigmoid_f(v[4 + i]); }
                            *(f32x4*)(gates + (size_t)row * 24 + 8 * fq) = g0; *(f32x4*)(gates + (size_t)row * 24 + 8 * fq + 4) = g1;
                        } else {
#pragma unroll
                            for (int i = 0; i < 4; ++i) {
                                const float z = v[i] + fbias[i];
                                const float ls = (z > 0.f) ? -log1pf(__expf(-z)) : (z - log1pf(__expf(z)));
                                flog[(size_t)(b * 4 + i) * SEQ + t] = ls;
                            }
                        }
                    } else {
                        u32x4 w; w.x = cvtpk(v[0], v[1]); w.y = cvtpk(v[2], v[3]); w.z = cvtpk(v[4], v[5]); w.w = cvtpk(v[6], v[7]);
                        const int dcol = half * 32 + 8 * fq;
                        if (mode == 0) *(u32x4*)(base + (size_t)row * pitch + hd * 64 + dcol) = w;
                        else if (mode == 1) *(u32x4*)(base + ((size_t)(b * NH + hd) * SEQ + t) * 64 + dcol) = w;
                        else if (mode == 4) {
                            const int d0 = half * 2 + (fq >> 1), khi = fq & 1;
                            *(u32x4*)(base + (size_t)(b * NH + hd) * SEQ * 64 + (size_t)(t >> 6) * 4096 + ((((t >> 5) & 1) * 4 + d0) * 64 + khi * 32 + (t & 31)) * 8) = w;
                        } else {
                            const int tt = t & 63, hf = tt >> 5, jj = (tt >> 4) & 1, piece = (tt >> 3) & 1, vhi = (tt >> 2) & 1, e = tt & 3;
                            bf16_t* p = base + (size_t)(b * NH + hd) * SEQ * 64 + (size_t)(t >> 6) * 4096 + (((hf * 2 + jj) * 2 + half) * 64 + vhi * 32 + 8 * fq) * 8 + piece * 4 + e;
                            p[0 * 8] = (bf16_t)(w.x & 0xffffu); p[1 * 8] = (bf16_t)(w.x >> 16);
                            p[2 * 8] = (bf16_t)(w.y & 0xffffu); p[3 * 8] = (bf16_t)(w.y >> 16);
                            p[4 * 8] = (bf16_t)(w.z & 0xffffu); p[5 * 8] = (bf16_t)(w.z >> 16);
                            p[6 * 8] = (bf16_t)(w.w & 0xffffu); p[7 * 8] = (bf16_t)(w.w >> 16);
                        }
                    }
                }
        }
    }
};

#define MFMA32(a, b, c) __builtin_amdgcn_mfma_f32_32x32x16_bf16((a), (b), (c), 0, 0, 0)
__device__ __forceinline__ f32x16 qk32(const bf16_t* kp, const bf16x8 (&qf)[4]) {
    f32x16 p;
#pragma unroll
    for (int r = 0; r < 16; ++r) p[r] = 0.f;
#pragma unroll
    for (int d0 = 0; d0 < 4; ++d0) { const bf16x8 kf = *(const bf16x8*)(kp + 16 * d0); p = MFMA32(kf, qf[d0], p); }
    return p;
}
__device__ __forceinline__ void pv32(f32x16 (&o)[2], const bf16_t* vp, int vpitch, const f32x16& p) {
#pragma unroll
    for (int j = 0; j < 2; ++j) {
        u32x4 pw; pw.x = cvtpk(p[8 * j + 0], p[8 * j + 1]); pw.y = cvtpk(p[8 * j + 2], p[8 * j + 3]); pw.z = cvtpk(p[8 * j + 4], p[8 * j + 5]); pw.w = cvtpk(p[8 * j + 6], p[8 * j + 7]);
        const bf16x8 pb = __builtin_bit_cast(bf16x8, pw);
#pragma unroll
        for (int dh = 0; dh < 2; ++dh) {
            const bf16_t* q = vp + (size_t)dh * 32 * vpitch + 16 * j;
            const s16x4 lo = *(const s16x4*)q, hi4 = *(const s16x4*)(q + 8);
            const bf16x8 va = (bf16x8){lo[0], lo[1], lo[2], lo[3], hi4[0], hi4[1], hi4[2], hi4[3]};
            o[dh] = MFMA32(va, pb, o[dh]);
        }
    }
}
__device__ __forceinline__ void load_k64(bf16x8 (&kf)[8], const bf16_t* ktile, int lane) {
    const bf16_t* p = ktile + lane * 8;
#pragma unroll
    for (int i = 0; i < 8; ++i) kf[i] = *(const bf16x8*)(p + i * 512);
}
__device__ __forceinline__ void load_v64(bf16x8 (&vf)[8], const bf16_t* vtile, int lane) {
    const bf16_t* p = vtile + lane * 8;
#pragma unroll
    for (int i = 0; i < 8; ++i) vf[i] = *(const bf16x8*)(p + i * 512);
}
template <int MODE, bool MASKED>
__device__ __forceinline__ void softmax_pv(f32x16 (&o)[2], float& m, float& l, f32x16& p0, f32x16& p1, const bf16x8 (&vf)[8],
                                           int kb, int t, bool tsel, const float* F8, float Fq8, int hi) {
    if (MODE == 2) {
#pragma unroll
        for (int g = 0; g < 4; ++g) {
            const f32x4 fa = *(const f32x4*)(F8 + kb + 8 * g + 4 * hi), fbv = *(const f32x4*)(F8 + kb + 32 + 8 * g + 4 * hi);
#pragma unroll
            for (int i = 0; i < 4; ++i) { p0[4 * g + i] += Fq8 - fa[i]; p1[4 * g + i] += Fq8 - fbv[i]; }
        }
    }
    if (MASKED) {
#pragma unroll
        for (int r = 0; r < 16; ++r) {
            const int k0 = kb + crow(r, hi), k1 = k0 + 32;
            bool v0, v1;
            if (MODE == 0) { v0 = tsel && (k0 <= t); v1 = tsel && (k1 <= t); }
            else if (MODE == 1) { v0 = (k0 <= t) && (k0 > t - 512); v1 = (k1 <= t) && (k1 > t - 512); }
            else { v0 = (k0 <= t); v1 = (k1 <= t); }
            p0[r] = v0 ? p0[r] : NEG_INF; p1[r] = v1 ? p1[r] : NEG_INF;
        }
    }
    float mx = fmaxf(p0[0], p1[0]);
#pragma unroll
    for (int r = 1; r < 16; ++r) mx = fmaxf(mx, fmaxf(p0[r], p1[r]));
    mx = fmaxf(mx, __shfl_xor(mx, 32));
    const float mnew = fmaxf(m, mx);
    const float msafe = (mnew == NEG_INF) ? 0.f : mnew;
    const float alpha = fast_exp2((m - msafe) * QK_C2);
    const float nm = -msafe * QK_C2;
    float ps = 0.f;
#pragma unroll
    for (int r = 0; r < 16; ++r) { p0[r] = fast_exp2(__builtin_fmaf(p0[r], QK_C2, nm)); p1[r] = fast_exp2(__builtin_fmaf(p1[r], QK_C2, nm)); ps += p0[r] + p1[r]; }
    l = l * alpha + ps; m = mnew;
#pragma unroll
    for (int r = 0; r < 16; ++r) { o[0][r] *= alpha; o[1][r] *= alpha; }
#pragma unroll
    for (int hf = 0; hf < 2; ++hf)
#pragma unroll
        for (int j = 0; j < 2; ++j) {
            const f32x16& p = hf ? p1 : p0;
            u32x4 pw; pw.x = cvtpk(p[8 * j + 0], p[8 * j + 1]); pw.y = cvtpk(p[8 * j + 2], p[8 * j + 3]); pw.z = cvtpk(p[8 * j + 4], p[8 * j + 5]); pw.w = cvtpk(p[8 * j + 6], p[8 * j + 7]);
            const bf16x8 pb = __builtin_bit_cast(bf16x8, pw);
#pragma unroll
            for (int dh = 0; dh < 2; ++dh) o[dh] = MFMA32(vf[(hf * 2 + j) * 2 + dh], pb, o[dh]);
        }
}
template <int MODE, class Sel>
__device__ __forceinline__ void flash_loop(f32x16 (&o)[2], float& m, float& l, const bf16x8 (&qf)[4], const bf16_t* K, const bf16_t* Vt,
                                           int jlo, int jhi, int t, int tmin, int tmax, Sel sel, const float* F8, float Fq8, int lane) {
    const int hi = lane >> 5;
    int j = jlo;
    for (; j <= jhi; ++j) { if (__any(sel(j))) break; }
    bf16x8 kf[8], vf[8];
    if (j <= jhi) load_k64(kf, K + (size_t)j * 4096, lane);
    while (j <= jhi) {
        int jn = j + 1;
        for (; jn <= jhi; ++jn) { if (__any(sel(jn))) break; }
        load_v64(vf, Vt + (size_t)j * 4096, lane);
        f32x16 p0, p1;
#pragma unroll
        for (int r = 0; r < 16; ++r) { p0[r] = 0.f; p1[r] = 0.f; }
#pragma unroll
        for (int d0 = 0; d0 < 4; ++d0) { p0 = MFMA32(kf[d0], qf[d0], p0); p1 = MFMA32(kf[4 + d0], qf[d0], p1); }
        if (jn <= jhi) load_k64(kf, K + (size_t)jn * 4096, lane);
        const int kb = j * 64;
        bool full = (kb + 63 <= tmin);
        if (MODE == 0) full = full && __all(sel(j));
        if (MODE == 1) full = full && (kb > tmax - 512);
        if (full) softmax_pv<MODE, false>(o, m, l, p0, p1, vf, kb, t, true, F8, Fq8, hi);
        else softmax_pv<MODE, true>(o, m, l, p0, p1, vf, kb, t, sel(j), F8, Fq8, hi);
        j = jn;
    }
}
__device__ __forceinline__ void load_q(bf16x8 (&qf)[4], const bf16_t* qrow, int hi) {
#pragma unroll
    for (int d0 = 0; d0 < 4; ++d0) qf[d0] = *(const bf16x8*)(qrow + 16 * d0 + 8 * hi);
}
__device__ __forceinline__ void store_o(bf16_t* dst, const f32x16 (&o)[2], int hi) {
#pragma unroll
    for (int dh = 0; dh < 2; ++dh)
#pragma unroll
        for (int g = 0; g < 4; ++g) {
            u32x2 w; w.x = cvtpk(o[dh][4 * g + 0], o[dh][4 * g + 1]); w.y = cvtpk(o[dh][4 * g + 2], o[dh][4 * g + 3]);
            *(u32x2*)(dst + 32 * dh + 8 * g + 4 * hi) = w;
        }
}
__device__ __forceinline__ unsigned nsa_select(const float (&imp)[32], int t) {
    const int tb = t >> 6;
    unsigned sel = 1u | (1u << tb) | (1u << (tb > 0 ? tb - 1 : 0));
#pragma unroll
    for (int it = 0; it < 5; ++it) {
        float bv = NEG_INF; int bj = -1;
#pragma unroll
        for (int j = 1; j < 32; ++j) { const bool cand = (j <= tb - 2) && !((sel >> j) & 1u) && (imp[j] > bv); if (cand) { bv = imp[j]; bj = j; } }
        if (bj >= 0) sel |= 1u << bj;
    }
    if (tb <= 7) sel = (2u << tb) - 1u;
    return sel;
}

__device__ __forceinline__ void nsa_unit(unsigned char* ws, int b, int g, int qg, int lane, float* wl) {
    const int hi = lane >> 5, c = lane & 31;
    const int t = qg * 8 + (c >> 2), head = g * 4 + (c & 3), row = b * SEQ + t, bg = b * 2 + g;
    bf16x8 qf[4];
    load_q(qf, (const bf16_t*)(ws + WS_QNSA) + (size_t)row * 512 + head * 64, hi);
    const float* gp = (const float*)(ws + WS_GATES) + (size_t)row * 24 + head * 3;
    const float g0 = gp[0];
    f32x16 o[2];
    float* oa = wl + 256 + lane;
    {
        const bf16_t* Kc = (const bf16_t*)(ws + WS_KCMP) + (size_t)bg * 8192;
        const bf16_t* Vct = (const bf16_t*)(ws + WS_VCMPT) + (size_t)bg * 8192;
        f32x16 s[4];
        float mx = NEG_INF;
#pragma unroll
        for (int tile = 0; tile < 2; ++tile) {
            bf16x8 kf[8];
            load_k64(kf, Kc + tile * 4096, lane);
#pragma unroll
            for (int hf = 0; hf < 2; ++hf) {
                const int grp = tile * 2 + hf;
#pragma unroll
                for (int r = 0; r < 16; ++r) s[grp][r] = 0.f;
#pragma unroll
                for (int d0 = 0; d0 < 4; ++d0) s[grp] = MFMA32(kf[hf * 4 + d0], qf[d0], s[grp]);
#pragma unroll
                for (int r = 0; r < 16; ++r) {
                    const int key = 32 * grp + crow(r, hi);
                    const float v = (16 * key + 31 <= t) ? s[grp][r] * QK_C2 : NEG_INF;
                    s[grp][r] = v; mx = fmaxf(mx, v);
                }
            }
        }
        mx = fmaxf(mx, __shfl_xor(mx, 32));
        const float msafe = (mx == NEG_INF) ? 0.f : mx;
        float ps = 0.f;
#pragma unroll
        for (int grp = 0; grp < 4; ++grp)
#pragma unroll
            for (int r = 0; r < 16; ++r) { s[grp][r] = fast_exp2(s[grp][r] - msafe); ps += s[grp][r]; }
        ps += __shfl_xor(ps, 32);
        const float inv = 1.0f / fmaxf(ps, 1e-30f);
#pragma unroll
        for (int grp = 0; grp < 4; ++grp)
#pragma unroll
            for (int r = 0; r < 16; ++r) s[grp][r] *= inv;
#pragma unroll
        for (int r = 0; r < 16; ++r) { o[0][r] = 0.f; o[1][r] = 0.f; }
#pragma unroll
        for (int tile = 0; tile < 2; ++tile) {
            bf16x8 vf[8];
            load_v64(vf, Vct + tile * 4096, lane);
#pragma unroll
            for (int hf = 0; hf < 2; ++hf)
#pragma unroll
                for (int j = 0; j < 2; ++j) {
                    const f32x16& p = s[tile * 2 + hf];
                    u32x4 pw; pw.x = cvtpk(p[8 * j + 0], p[8 * j + 1]); pw.y = cvtpk(p[8 * j + 2], p[8 * j + 3]); pw.z = cvtpk(p[8 * j + 4], p[8 * j + 5]); pw.w = cvtpk(p[8 * j + 6], p[8 * j + 7]);
                    const bf16x8 pb = __builtin_bit_cast(bf16x8, pw);
#pragma unroll
                    for (int dh = 0; dh < 2; ++dh) o[dh] = MFMA32(vf[(hf * 2 + j) * 2 + dh], pb, o[dh]);
                }
        }
#pragma unroll
        for (int r = 0; r < 16; ++r) { oa[r * 64] = g0 * o[0][r]; oa[(16 + r) * 64] = g0 * o[1][r]; }
        float recv[4][4];
#pragma unroll
        for (int grp = 0; grp < 4; ++grp)
#pragma unroll
            for (int gq = 0; gq < 4; ++gq) recv[grp][gq] = __shfl_xor(s[grp][4 * gq + 3], 32);
#pragma unroll
        for (int grp = 0; grp < 4; ++grp)
#pragma unroll
            for (int gq = 0; gq < 4; ++gq) {
                const float own = (s[grp][4 * gq] + s[grp][4 * gq + 1]) + (s[grp][4 * gq + 2] + s[grp][4 * gq + 3]);
                const float plo = (gq > 0) ? recv[grp][gq > 0 ? gq - 1 : 0] : ((grp > 0) ? recv[grp > 0 ? grp - 1 : 0][3] : 0.f);
                const float prev = hi ? recv[grp][gq] : plo;
                float v = own + prev;
                v += __shfl_xor(v, 1); v += __shfl_xor(v, 2);
                if ((c & 3) == 0) wl[(c >> 2) * 32 + 8 * grp + 2 * gq + hi] = v;
            }
    }
    asm volatile("s_waitcnt lgkmcnt(0)" ::: "memory");
    float imp[32];
#pragma unroll
    for (int j4 = 0; j4 < 8; ++j4) { const f32x4 v = *(const f32x4*)(wl + (c >> 2) * 32 + 4 * j4); imp[4 * j4] = v[0]; imp[4 * j4 + 1] = v[1]; imp[4 * j4 + 2] = v[2]; imp[4 * j4 + 3] = v[3]; }
    asm volatile("s_waitcnt lgkmcnt(0)" ::: "memory");
    const unsigned sel = nsa_select(imp, t);
    const int jmax = (qg * 8 + 7) >> 6;
    {
        const bf16_t* Ks = (const bf16_t*)(ws + WS_KS) + (size_t)bg * SEQ * 64;
        const bf16_t* Vst = (const bf16_t*)(ws + WS_VST) + (size_t)bg * 64 * SEQ;
        float m = NEG_INF, l = 0.f;
#pragma unroll
        for (int r = 0; r < 16; ++r) { o[0][r] = 0.f; o[1][r] = 0.f; }
        flash_loop<0>(o, m, l, qf, Ks, Vst, 0, jmax, t, qg * 8, qg * 8 + 7, [&](int j) { return (bool)((sel >> j) & 1u); }, nullptr, 0.f, lane);
        l += __shfl_xor(l, 32);
        const float sc = gp[1] / fmaxf(l, 1e-30f);
#pragma unroll
        for (int r = 0; r < 16; ++r) { oa[r * 64] += sc * o[0][r]; oa[(16 + r) * 64] += sc * o[1][r]; }
        asm volatile("s_waitcnt lgkmcnt(0)" ::: "memory");
    }
    {
        const bf16_t* Kw = (const bf16_t*)(ws + WS_KW) + (size_t)bg * SEQ * 64;
        const bf16_t* Vwt = (const bf16_t*)(ws + WS_VWT) + (size_t)bg * 64 * SEQ;
        float m = NEG_INF, l = 0.f;
#pragma unroll
        for (int r = 0; r < 16; ++r) { o[0][r] = 0.f; o[1][r] = 0.f; }
        const int tl = qg * 8 - 511;
        const int jlo = (tl > 0 ? tl : 0) >> 6;
        flash_loop<1>(o, m, l, qf, Kw, Vwt, jlo, jmax, t, qg * 8, qg * 8 + 7, [&](int) { return true; }, nullptr, 0.f, lane);
        l += __shfl_xor(l, 32);
        const float sc = gp[2] / fmaxf(l, 1e-30f);
#pragma unroll
        for (int r = 0; r < 16; ++r) { o[0][r] = oa[r * 64] + sc * o[0][r]; o[1][r] = oa[(16 + r) * 64] + sc * o[1][r]; }
        asm volatile("s_waitcnt lgkmcnt(0)" ::: "memory");
    }
    store_o((bf16_t*)(ws + WS_H) + (size_t)row * DM + head * 64, o, hi);
}

__device__ __forceinline__ void fox_unit(unsigned char* ws, int bh, int qt, int lane) {
    const int hi = lane >> 5, c = lane & 31, b = bh >> 2, h = bh & 3;
    const int t = qt * 32 + c, row = b * SEQ + t;
    bf16x8 qf[4];
    load_q(qf, (const bf16_t*)(ws + WS_FOXQ) + (size_t)row * 256 + h * 64, hi);
    const bf16_t* K = (const bf16_t*)(ws + WS_FOXK) + (size_t)bh * SEQ * 64;
    const bf16_t* Vt = (const bf16_t*)(ws + WS_FOXVT) + (size_t)bh * 64 * SEQ;
    const float* F2 = (const float*)(ws + WS_FCUM) + (size_t)bh * SEQ;
    const float Fq2 = F2[t];
    f32x16 o[2]; float m = NEG_INF, l = 0.f;
#pragma unroll
    for (int r = 0; r < 16; ++r) { o[0][r] = 0.f; o[1][r] = 0.f; }
    const int jmax = (qt * 32 + 31) >> 6;
    flash_loop<2>(o, m, l, qf, K, Vt, 0, jmax, t, qt * 32, qt * 32 + 31, [&](int) { return true; }, F2, Fq2, lane);
    l += __shfl_xor(l, 32);
    const float sc = 1.0f / fmaxf(l, 1e-30f);
#pragma unroll
    for (int r = 0; r < 16; ++r) { o[0][r] *= sc; o[1][r] *= sc; }
    store_o((bf16_t*)(ws + WS_H) + (size_t)row * DM + 512 + h * 64, o, hi);
}

__device__ __forceinline__ void moba_unit(unsigned char* ws, int bh, int qt, int lane) {
    const int hi = lane >> 5, c = lane & 31, b = bh >> 2, h = bh & 3;
    const int t = qt * 32 + c, row = b * SEQ + t;
    bf16x8 qf[4];
    load_q(qf, (const bf16_t*)(ws + WS_MOBAQ) + (size_t)row * 256 + h * 64, hi);
    const bf16_t* K = (const bf16_t*)(ws + WS_MOBAK) + (size_t)bh * SEQ * 64;
    const bf16_t* Vt = (const bf16_t*)(ws + WS_MOBAVT) + (size_t)bh * 64 * SEQ;
    const int own = (qt * 32) >> 8;
    unsigned sel = 0u;
    {
        float gt[7];
        const float* km = (const float*)(ws + WS_KMEAN) + (size_t)bh * 8 * 64;
#pragma unroll
        for (int blk = 0; blk < 7; ++blk) {
            float a = 0.f;
            if (blk < own) {
#pragma unroll
                for (int d0 = 0; d0 < 4; ++d0) {
                    const f32x4 k0 = *(const f32x4*)(km + blk * 64 + 16 * d0 + 8 * hi), k1 = *(const f32x4*)(km + blk * 64 + 16 * d0 + 8 * hi + 4);
#pragma unroll
                    for (int i = 0; i < 4; ++i) { a += bf2f(qf[d0][i]) * k0[i]; a += bf2f(qf[d0][4 + i]) * k1[i]; }
                }
                a += __shfl_xor(a, 32);
            }
            gt[blk] = a;
        }
#pragma unroll
        for (int it = 0; it < 3; ++it) {
            float bv = NEG_INF; int bj = -1;
#pragma unroll
            for (int blk = 0; blk < 7; ++blk) { const bool cand = (blk < own) && !((sel >> blk) & 1u) && (gt[blk] > bv); if (cand) { bv = gt[blk]; bj = blk; } }
            if (bj >= 0) sel |= 1u << bj;
        }
    }
    f32x16 o[2]; float m = NEG_INF, l = 0.f;
#pragma unroll
    for (int r = 0; r < 16; ++r) { o[0][r] = 0.f; o[1][r] = 0.f; }
    const int jmax = (qt * 32 + 31) >> 6;
    flash_loop<0>(o, m, l, qf, K, Vt, 0, jmax, t, qt * 32, qt * 32 + 31, [&](int j) { const int blk = j >> 2; return (blk == own) || (bool)((sel >> blk) & 1u); }, nullptr, 0.f, lane);
    l += __shfl_xor(l, 32);
    const float sc = 1.0f / fmaxf(l, 1e-30f);
#pragma unroll
    for (int r = 0; r < 16; ++r) { o[0][r] *= sc; o[1][r] *= sc; }
    store_o((bf16_t*)(ws + WS_H) + (size_t)row * DM + 768 + h * 64, o, hi);
}


#define XB_TMO      128
#define XB_XCNT(j)  (256  + 64 * (j))
#define XB_XSUB(j)  (1280 + 64 * (j))
#define XB_XGEN(j)  (2304 + 64 * (j))
#define XB_TOP      3328
#define XB_TOPGEN   3392
#define XCD_BAR_WORDS 3456
#define XB_SPIN_CAP (1u << 22)
__device__ __forceinline__ unsigned xb_ld(unsigned* p)              { return __hip_atomic_load(p, __ATOMIC_RELAXED, __HIP_MEMORY_SCOPE_AGENT); }
__device__ __forceinline__ unsigned xb_add(unsigned* p, unsigned v) { return __hip_atomic_fetch_add(p, v, __ATOMIC_RELAXED, __HIP_MEMORY_SCOPE_AGENT); }
__device__ __forceinline__ unsigned xb_xcc_id() { return (unsigned)__builtin_amdgcn_s_getreg((3 << 11) | 20) & 0xFu; }
#define XB_SPIN(cond, bar) do { unsigned _sp = 0; while (cond) { __builtin_amdgcn_s_sleep(1); \
    if ((++_sp & 255u) == 0u) { if (xb_ld(&(bar)[XB_TMO])) break; if (_sp > XB_SPIN_CAP) { atomicAdd(&(bar)[XB_TMO], 1u); break; } } } } while (0)
__device__ __forceinline__ void xcd_barrier_post(unsigned* bar, unsigned x, volatile LAS unsigned* st) {
    if (threadIdx.x == 0) st[2] = xb_add(&bar[XB_XCNT(x)], 1u);
}
__device__ __forceinline__ void xcd_barrier_complete(unsigned* bar, unsigned x, unsigned& nloc, unsigned& nx) {
    const unsigned G = gridDim.x * gridDim.y * gridDim.z;
    unsigned sum, cnt, mine, sp = 0u;
    for (;;) {
        sum = 0u; cnt = 0u; mine = 0u;
#pragma unroll
        for (unsigned j = 0; j < 16; ++j) { const unsigned c = xb_ld(&bar[XB_XCNT(j)]); sum += c; cnt += (c > 0u) ? 1u : 0u; mine = (j == x) ? c : mine; }
        if (sum == G) break;
        __builtin_amdgcn_s_sleep(1);
        if ((++sp & 255u) == 0u) { if (xb_ld(&bar[XB_TMO])) break; if (sp > XB_SPIN_CAP) { atomicAdd(&bar[XB_TMO], 1u); break; } }
    }
    nloc = mine > 0u ? mine : 1u; nx = cnt > 0u ? cnt : 1u;
}
__device__ __forceinline__ void xcd_barrier(unsigned* bar_, unsigned x_, volatile LAS unsigned* st, bool leader) {
    asm volatile("s_waitcnt vmcnt(0)" ::: "memory");
    __syncthreads();
    if (leader) {
        size_t zo = 0; unsigned x = x_;
        asm volatile("" : "+s"(zo), "+s"(x));
        unsigned* bar = bar_ + zo;
        __builtin_amdgcn_s_waitcnt(0);
        unsigned nloc = st[0], nx = st[1];
        if (nloc == 0u) { xcd_barrier_complete(bar, x, nloc, nx); st[0] = nloc; st[1] = nx; }
        const unsigned old = xb_add(&bar[XB_XSUB(x)], 1u);
        const unsigned gen = old / nloc;
        if (old + 1u == (gen + 1u) * nloc) {
            __builtin_amdgcn_fence(__ATOMIC_RELEASE, "agent");
            asm volatile("s_waitcnt vmcnt(0)" ::: "memory");
            const unsigned og = xb_add(&bar[XB_TOP], 1u);
            const unsigned tg = og / nx;
            if (og + 1u == (tg + 1u) * nx) xb_add(&bar[XB_TOPGEN], 1u);
            else XB_SPIN(xb_ld(&bar[XB_TOPGEN]) == tg, bar);
            __builtin_amdgcn_fence(__ATOMIC_ACQUIRE, "agent");
            xb_add(&bar[XB_XGEN(x)], 1u);
            asm volatile("s_waitcnt vmcnt(0)" ::: "memory");
        } else {
            XB_SPIN(xb_ld(&bar[XB_XGEN(x)]) == gen, bar);
            __builtin_amdgcn_fence(__ATOMIC_ACQUIRE, "agent");
            asm volatile("s_waitcnt vmcnt(0)" ::: "memory");
        }
    }
    __syncthreads();
}

__device__ __forceinline__ int map_identity(int n) { return n; }
__device__ __forceinline__ int map_w13(int n) { const int tile = n >> 8, w = n & 255; return (w < 128) ? tile * 128 + w : FF + tile * 128 + (w - 128); }
__device__ __forceinline__ int map_win(int n) {
    if (n < 640) return n;
    if (n < 768) return n - 640 + 768;
    if (n < 896) return n - 768 + 1024;
    if (n < 1152) return n - 896 + 1304;
    if (n < 1408) return n - 1152 + 1560;
    if (n < 1664) return n - 1408 + 2076;
    if (n < 1920) return n - 1664 + 2332;
    if (n < 2048) return n - 1920 + 640;
    if (n < 2176) return n - 2048 + 896;
    if (n < 2304) return n - 2176 + 1152;
    if (n < 2560) return n - 2304 + 1816;
    if (n < 2816) return n - 2560 + 2588;
    if (n < 2840) return n - 2816 + 1280;
    if (n < 2844) return n - 2840 + 2072;
    return -1;
}
template <int MAP>
__device__ __forceinline__ void transpose_item(const float* W, int K, int Nsrc, int Ndst, bf16_t* WT, float* scr, int item, int lane) {
    const int nblk = Ndst / 64, kb = item / nblk, nb = item % nblk, k0 = 64 * kb, n0 = 64 * nb;
    const int nq = (lane & 15) * 4, nd = n0 + nq;
    const int src = (MAP == 0) ? map_identity(nd) : (MAP == 1) ? map_w13(nd) : map_win(nd);
    f32x4 v[16];
#pragma unroll
    for (int i = 0; i < 16; ++i) { const int kk = 4 * i + (lane >> 4); v[i] = (src >= 0) ? *(const f32x4*)(W + (size_t)(k0 + kk) * Nsrc + src) : (f32x4){0.f, 0.f, 0.f, 0.f}; }
#pragma unroll
    for (int i = 0; i < 16; ++i) { const int kk = 4 * i + (lane >> 4); float* d = scr + kk * 65 + nq; d[0] = v[i][0]; d[1] = v[i][1]; d[2] = v[i][2]; d[3] = v[i][3]; }
    asm volatile("s_waitcnt lgkmcnt(0)" ::: "memory");
    const int cc = lane & 7;
#pragma unroll
    for (int j = 0; j < 8; ++j) { const int n = (lane >> 3) + 8 * j; const float* sp = scr + (8 * cc) * 65 + n;
        u32x4 ov; ov.x = cvtpk(sp[0 * 65], sp[1 * 65]); ov.y = cvtpk(sp[2 * 65], sp[3 * 65]); ov.z = cvtpk(sp[4 * 65], sp[5 * 65]); ov.w = cvtpk(sp[6 * 65], sp[7 * 65]);
        *(u32x4*)(WT + (size_t)(n0 + n) * K + k0 + 8 * cc) = ov; }
    asm volatile("s_waitcnt lgkmcnt(0)" ::: "memory");
}
__device__ __forceinline__ void sincos_acc(float ang, float& sn, float& cs) {
    const double a = (double)ang;
    const double k = __builtin_rint(a * 0.15915494309189535);
    const double r = (a - k * 6.283185307179586) * 0.25;
    const double r2 = r * r;
    double s = r * (1.0 + r2 * (-1.0 / 6 + r2 * (1.0 / 120 + r2 * (-1.0 / 5040 + r2 * (1.0 / 362880 + r2 * (-1.0 / 39916800 + r2 * (1.0 / 6227020800.0)))))));
    double c = 1.0 + r2 * (-0.5 + r2 * (1.0 / 24 + r2 * (-1.0 / 720 + r2 * (1.0 / 40320 + r2 * (-1.0 / 3628800 + r2 * (1.0 / 479001600.0))))));
    double s2 = 2.0 * s * c, c2 = c * c - s * s;
    double s4 = 2.0 * s2 * c2, c4 = c2 * c2 - s2 * s2;
    sn = (float)s4; cs = (float)c4;
}

struct Params {
    const float* x; const float* c; const int* positions; const float* norm_g; const float* w_ada; const float* b_ada; const float* w_in; const float* fox_fbias;
    const float* cmp_pos; const float* cmp_w1; const float* cmp_w2; const float* w_out; const float* ffn_w13; const float* ffn_w2; const float* final_g;
    float* out; unsigned char* ws;
};

__device__ __forceinline__ void prologue(const Params& P, unsigned char* lds, int tid, int lane, int wave, int G) {
    unsigned char* ws = P.ws;
    float* cact = (float*)lds;
    float* part = (float*)(lds + 65536);
    for (int i = tid; i < NB * DM; i += 512) { const float v = P.c[i]; cact[i] = v / (1.0f + __expf(-v)); }
    __syncthreads();
    float* MOD = (float*)(ws + WS_MOD);
    for (int item = blockIdx.x; item < DEPTH * 72; item += G) {
        const int l = item / 72, j0 = (item % 72) * 128 + 2 * lane;
        const float* wp = P.w_ada + (size_t)l * DM * NADA + j0;
        float a0[16], a1[16];
#pragma unroll
        for (int b = 0; b < 16; ++b) { a0[b] = 0.f; a1[b] = 0.f; }
        const int kbeg = wave * 128;
#pragma unroll 16
        for (int k = kbeg; k < kbeg + 128; ++k) {
            const f32x2 w = *(const f32x2*)(wp + (size_t)k * NADA);
#pragma unroll
            for (int b = 0; b < 16; ++b) { const float cv = cact[b * DM + k]; a0[b] += cv * w.x; a1[b] += cv * w.y; }
        }
#pragma unroll
        for (int b = 0; b < 16; ++b) { part[(wave * 16 + b) * 128 + 2 * lane] = a0[b]; part[(wave * 16 + b) * 128 + 2 * lane + 1] = a1[b]; }
        __syncthreads();
        for (int o = tid; o < 16 * 128; o += 512) {
            const int b = o >> 7, col = o & 127;
            float s = 0.f;
#pragma unroll
            for (int w = 0; w < 8; ++w) s += part[(w * 16 + b) * 128 + col];
            const int j = (item % 72) * 128 + col;
            MOD[((size_t)l * NB + b) * NADA + j] = s + P.b_ada[(size_t)l * NADA + j];
        }
        __syncthreads();
    }
    float* scr = (float*)(lds + wave * 16640);
    const int gw = blockIdx.x * NWAVES + wave, NGW = G * NWAVES;
    constexpr int I_WIN = 16 * 48, I_WOUT = 16 * 16, I_CW1 = 32 * 4, I_W13 = 16 * 88, I_W2 = 44 * 16, I_CW2 = 4 * 1;
    constexpr int T_WIN = 4 * I_WIN, T_WOUT = 4 * I_WOUT, T_CW1 = 8 * I_CW1, T_W13 = 8 * I_W13, T_W2 = 8 * I_W2, T_CW2 = 8 * I_CW2;
    constexpr int NITEMS = T_WIN + T_WOUT + T_CW1 + T_W13 + T_W2 + T_CW2;
    for (int it = gw; it < NITEMS; it += NGW) {
        int r = it;
        if (r < T_W13) { const int q = r / I_W13; transpose_item<1>(P.ffn_w13 + (size_t)q * DM * 2 * FF, DM, 2 * FF, 2 * FF, (bf16_t*)(ws + WS_W13) + (size_t)q * 2 * FF * DM, scr, r % I_W13, lane); continue; } r -= T_W13;
        if (r < T_W2) { const int q = r / I_W2; transpose_item<0>(P.ffn_w2 + (size_t)q * FF * DM, FF, DM, DM, (bf16_t*)(ws + WS_W2) + (size_t)q * DM * FF, scr, r % I_W2, lane); continue; } r -= T_W2;
        if (r < T_WIN) { const int q = r / I_WIN; transpose_item<2>(P.w_in + (size_t)q * DM * 2844, DM, 2844, NIN, (bf16_t*)(ws + WS_WIN) + (size_t)q * NIN * DM, scr, r % I_WIN, lane); continue; } r -= T_WIN;
        if (r < T_WOUT) { const int q = r / I_WOUT; transpose_item<0>(P.w_out + (size_t)q * DM * DM, DM, DM, DM, (bf16_t*)(ws + WS_WOUT) + (size_t)q * DM * DM, scr, r % I_WOUT, lane); continue; } r -= T_WOUT;
        if (r < T_CW1) { const int q = r / I_CW1; transpose_item<0>(P.cmp_w1 + (size_t)q * 2048 * 256, 2048, 256, 256, (bf16_t*)(ws + WS_CW1) + (size_t)q * 256 * 2048, scr, r % I_CW1, lane); continue; } r -= T_CW1;
        { const int q = r / I_CW2; transpose_item<0>(P.cmp_w2 + (size_t)q * 256 * 64, 256, 64, 64, (bf16_t*)(ws + WS_CW2T) + (size_t)q * 64 * 256, scr, r % I_CW2, lane); }
    }
    {
        float* cosT = (float*)(ws + WS_COS); float* sinT = (float*)(ws + WS_SIN);
        for (int e = blockIdx.x * 512 + tid; e < NTOK * 8; e += G * 512) {
            const int i = e & 7;
            const float inv = (i == 0) ? 1.0f : (i == 1) ? 0.1939227432012558f : (i == 2) ? 0.03760603070259094f : (i == 3) ? 0.007292664609849453f :
                              (i == 4) ? 0.0014142135623842478f : (i == 5) ? 0.00027424818836152554f : (i == 6) ? 5.318296098266728e-05f : 1.0313386155758053e-05f;
            const float ang = (float)P.positions[e >> 3] * inv;
            float sn, cs; sincos_acc(ang, sn, cs);
            cosT[e] = cs; sinT[e] = sn;
        }
    }
}

__device__ __forceinline__ void norm_phase(const float* xin, const float* g, const float* mod  , bf16_t* H, int lane, int wave, int G) {
    const int gw = blockIdx.x * NWAVES + wave, NGW = G * NWAVES;
    for (int row = gw; row < NTOK; row += NGW) {
        const int b = row >> 11;
        const f32x4* xr = (const f32x4*)(xin + (size_t)row * DM) + lane;
        f32x4 v[4]; float s = 0.f;
#pragma unroll
        for (int j = 0; j < 4; ++j) { v[j] = xr[64 * j]; s += (v[j].x * v[j].x + v[j].y * v[j].y) + (v[j].z * v[j].z + v[j].w * v[j].w); }
        const float rstd = 1.0f / sqrtf(wave_sum(s) * (1.0f / DM) + 1e-6f);
        const f32x4* gr = (const f32x4*)g + lane;
        const f32x4* sh = (const f32x4*)(mod + (size_t)b * NADA) + lane;
        const f32x4* sc = (const f32x4*)(mod + (size_t)b * NADA + DM) + lane;
        u32x2* o8 = (u32x2*)(H + (size_t)row * DM) + lane;
#pragma unroll
        for (int j = 0; j < 4; ++j) {
            const f32x4 gg = gr[64 * j], s1 = sc[64 * j] + 1.0f, s0 = sh[64 * j];
            const f32x4 y = v[j] * rstd * gg * s1 + s0;
            u32x2 w; w.x = cvtpk(y.x, y.y); w.y = cvtpk(y.z, y.w);
            o8[64 * j] = w;
        }
    }
}
__device__ __forceinline__ void final_norm(float* x, const float* g, int lane, int wave, int G) {
    const int gw = blockIdx.x * NWAVES + wave, NGW = G * NWAVES;
    for (int row = gw; row < NTOK; row += NGW) {
        f32x4* xr = (f32x4*)(x + (size_t)row * DM) + lane;
        f32x4 v[4]; float s = 0.f;
#pragma unroll
        for (int j = 0; j < 4; ++j) { v[j] = xr[64 * j]; s += (v[j].x * v[j].x + v[j].y * v[j].y) + (v[j].z * v[j].z + v[j].w * v[j].w); }
        const float rstd = 1.0f / sqrtf(wave_sum(s) * (1.0f / DM) + 1e-6f);
        const f32x4* gr = (const f32x4*)g + lane;
#pragma unroll
        for (int j = 0; j < 4; ++j) xr[64 * j] = v[j] * rstd * gr[64 * j];
    }
}

__global__ void __launch_bounds__(512, 2) fwd_megakernel(Params P) {
    extern __shared__ __attribute__((aligned(16))) unsigned char lds[];
    cg::grid_group grid = cg::this_grid();
    const int tid = threadIdx.x, lane = tid & 63, wave = __builtin_amdgcn_readfirstlane(tid >> 6), wave0 = wave;
    const int G = gridDim.x;
    unsigned char* ws = P.ws;
    LAS unsigned char* lds3 = (LAS unsigned char*)lds;
    const float* MOD = (const float*)(ws + WS_MOD);
    unsigned* ctl = (unsigned*)(ws + WS_CTL);

    volatile LAS unsigned* bst = (volatile LAS unsigned*)(lds3 + LDS_BYTES - 64);
    if (tid == 0) { bst[0] = 0u; bst[1] = 0u; }
    __syncthreads();
    const unsigned xcc = (unsigned)__builtin_amdgcn_readfirstlane((int)xb_xcc_id());
    xcd_barrier_post(ctl + 65536, xcc, bst);
    const bool leader = (tid == 0);
#define GRID_BAR() xcd_barrier((unsigned*)(P.ws + WS_CTL) + 65536, xcc, bst, leader)
    prologue(P, lds, tid, lane, wave, G);
#ifdef PROBE_PRO2
    grid.sync();
    prologue(P, lds, tid, lane, wave, G);
#endif
    grid.sync();
    if (tid == 0) {
        bool ok = ((G & 7) == 0);
        for (unsigned j = 0; j < 16; ++j) { const unsigned cnt = xb_ld(ctl + 65536 + XB_XCNT(j)); ok = ok && (cnt == ((j < 8u) ? (unsigned)(G >> 3) : 0u)); }
        bst[3] = ok ? (bst[2] * 8u + xcc) : (unsigned)blockIdx.x;
    }
    __syncthreads();
    const int vbid = __builtin_amdgcn_readfirstlane((int)bst[3]);
#ifdef PROBE_SYNC20
    for (int i = 0; i < 20; ++i) GRID_BAR();
#endif
    {
        const int ln = fresh_lane(), wv = wave0;
        for (int it = blockIdx.x * NWAVES + wv; it < 8 * 256; it += G * NWAVES) {
            const int lm = it >> 8;
            const bf16_t* wr_ = (const bf16_t*)(ws + WS_CW1) + (size_t)it * 2048 + ln * 32;
            const float* pp = P.cmp_pos + (size_t)lm * 2048 + ln * 32;
            float a = 0.f;
#pragma unroll
            for (int j = 0; j < 4; ++j) {
                const bf16x8 wv8 = *(const bf16x8*)(wr_ + 8 * j);
                const f32x4 p0 = *(const f32x4*)(pp + 8 * j), p1 = *(const f32x4*)(pp + 8 * j + 4);
#pragma unroll
                for (int i = 0; i < 4; ++i) { a += p0[i] * bf2f(wv8[i]); a += p1[i] * bf2f(wv8[4 + i]); }
            }
            a = wave_sum(a);
            if (ln == 0) ((float*)(ws + WS_B1))[it] = a;
        }
    }

    const float* xin = P.x;
    for (int l = 0; l < DEPTH; ++l) {
        const float* modl = MOD + (size_t)l * NB * NADA;
        for (int sub = 0; sub < 3; ++sub) {
            unsigned char* ws = launder_p(P.ws);
            const int bid = launder_i(vbid);
            const int lane = fresh_lane(), wave = wave0;
            norm_phase(xin, P.norm_g + ((size_t)l * 3 + sub) * DM, modl + (size_t)sub * 3 * DM, (bf16_t*)(ws + WS_H), lane, wave, G);
            GRID_BAR();
            if (sub != 1) {
                const int s = (sub == 0) ? 0 : 1;
                {
                    pg8::Gemm g{(const bf16_t*)(ws + WS_H), (const bf16_t*)(ws + WS_W13) + (size_t)(l * 2 + s) * 2 * FF * DM, NTOK, 2 * FF, DM, DM};
                    pg8::StaticOrder S; S.init(NTOK, 2 * FF, G, bid);
                    EpiSwiglu E{(bf16_t*)(ws + WS_BIG)};
#ifndef NO_G1
                    pg8::gemm_phase<EpiSwiglu, true>(lds3, g, S, E, wave0);
#endif
#ifdef PROBE_G1X2
                    pg8::gemm_phase<EpiSwiglu, true>(lds3, g, S, E, wave0);
#endif
                }
                GRID_BAR();
                {
                    pg8::Gemm g{(const bf16_t*)(ws + WS_BIG), (const bf16_t*)(ws + WS_W2) + (size_t)(l * 2 + s) * DM * FF, NTOK, DM, FF, FF};
                    pg8::StaticOrder S; S.init(NTOK, DM, G, bid);
                    EpiResid E{xin, P.out, modl + (size_t)(sub * 3 + 2) * DM, 0.5f};
#ifndef NO_G2
                    pg8::gemm_phase<EpiResid, true>(lds3, g, S, E, wave0);
#endif
                }
                xin = P.out;
                GRID_BAR();
            } else {
                {
                    pg8::Gemm g{(const bf16_t*)(ws + WS_H), (const bf16_t*)(ws + WS_WIN) + (size_t)l * NIN * DM, NTOK, NIN, DM, DM};
                    pg8::StaticOrder S; S.init(NTOK, NIN, G, bid);
                    EpiInProj E{ws, P.fox_fbias + l * 4};
#ifndef NO_INPROJ
                    pg8::gemm_phase<EpiInProj, true>(lds3, g, S, E, wave0);
#endif
                }
                GRID_BAR();
                if (bid < 32) {
                    const int mat = bid >> 4;
                    pg8::Gemm g{(const bf16_t*)(ws + (mat ? WS_VC : WS_KC)), (const bf16_t*)(ws + WS_CW1) + (size_t)(l * 2 + mat) * 256 * 2048, 4096, 256, 2048, 1024};
                    pg8::StaticOrder S; S.init(4096, 256, 16, bid & 15);
                    EpiGelu E{(bf16_t*)(ws + WS_CMPHID) + (size_t)mat * 4096 * 256, (const float*)(ws + WS_B1) + (l * 2 + mat) * 256};
#ifndef NO_CMP1
                    pg8::gemm_phase<EpiGelu, true>(lds3, g, S, E, wave0);
#endif
                } else {
                    const int nw = (G - 32) * NWAVES;
                    for (int it = (bid - 32) * NWAVES + wave; it < 64 + 512; it += nw) {
                        if (it < 64) {
                            const float* src = (const float*)(ws + WS_FLOG) + (size_t)it * SEQ + lane * 32;
                            float v[32];
#pragma unroll
                            for (int j = 0; j < 8; ++j) { const f32x4 q = *(const f32x4*)(src + 4 * j); v[4 * j] = q.x; v[4 * j + 1] = q.y; v[4 * j + 2] = q.z; v[4 * j + 3] = q.w; }
#pragma unroll
                            for (int j = 1; j < 32; ++j) v[j] += v[j - 1];
                            float tot = v[31], inc = tot;
#pragma unroll
                            for (int o = 1; o < 64; o <<= 1) { const float n = __shfl_up(inc, o); if (lane >= o) inc += n; }
                            const float excl = inc - tot;
                            float* dst = (float*)(ws + WS_FCUM) + (size_t)it * SEQ + lane * 32;
#pragma unroll
                            for (int j = 0; j < 8; ++j) { f32x4 q; q.x = (v[4 * j] + excl) * 8.0f; q.y = (v[4 * j + 1] + excl) * 8.0f; q.z = (v[4 * j + 2] + excl) * 8.0f; q.w = (v[4 * j + 3] + excl) * 8.0f; *(f32x4*)(dst + 4 * j) = q; }
                        } else {
                            const int id = it - 64;
                            const bf16_t* kp = (const bf16_t*)(ws + WS_MOBAK) + (size_t)id * 256 * 64 + (((lane >> 4) * 64 + ((lane >> 3) & 1) * 32) * 8 + (lane & 7));
                            float a = 0.f;
#pragma unroll 8
                            for (int k = 0; k < 256; ++k) a += bf2f((short)kp[(size_t)(k >> 6) * 4096 + (((k >> 5) & 1) * 4 * 64 + (k & 31)) * 8]);
                            ((float*)(ws + WS_KMEAN))[(size_t)id * 64 + lane] = a * (1.0f / 256.0f);
                        }
                    }
                }
                GRID_BAR();
                for (int it = bid * NWAVES + wave; it < 256; it += G * NWAVES) {
                    const int mat = it >> 7, rt = it & 127, hi = lane >> 5, c = lane & 31;
                    const bf16_t* A = (const bf16_t*)(ws + WS_CMPHID) + ((size_t)mat * 4096 + rt * 32 + c) * 256 + 8 * hi;
                    const bf16_t* Bt = (const bf16_t*)(ws + WS_CW2T) + (size_t)(l * 2 + mat) * 64 * 256 + (size_t)c * 256 + 8 * hi;
                    f32x16 a0, a1;
#pragma unroll
                    for (int r = 0; r < 16; ++r) { a0[r] = 0.f; a1[r] = 0.f; }
#pragma unroll 4
                    for (int ks = 0; ks < 16; ++ks) {
                        const bf16x8 af = *(const bf16x8*)(A + 16 * ks);
                        const bf16x8 b0 = *(const bf16x8*)(Bt + 16 * ks), b1 = *(const bf16x8*)(Bt + 32 * 256 + 16 * ks);
                        a0 = MFMA32(af, b0, a0); a1 = MFMA32(af, b1, a1);
                    }
#pragma unroll
                    for (int r = 0; r < 16; ++r) {
                        const int row = rt * 32 + crow(r, hi), rl = row & 127, bg = row >> 7;
                        const float v0 = (rl == 127) ? 0.f : a0[r], v1 = (rl == 127) ? 0.f : a1[r];
                        const bf16_t h0 = (bf16_t)(cvtpk(v0, 0.f) & 0xffffu), h1 = (bf16_t)(cvtpk(v1, 0.f) & 0xffffu);
                        if (mat == 0) {
                            bf16_t* kc = (bf16_t*)(ws + WS_KCMP) + (size_t)bg * 8192 + (rl >> 6) * 4096 + ((((rl >> 5) & 1) * 4) * 64 + (rl & 31)) * 8;
                            const int o0 = ((c >> 4) * 64 + ((c >> 3) & 1) * 32) * 8 + (c & 7);
                            kc[o0] = h0; kc[o0 + 2 * 64 * 8] = h1;
                        } else {
                            const int tt = rl & 63;
                            bf16_t* vc = (bf16_t*)(ws + WS_VCMPT) + (size_t)bg * 8192 + (rl >> 6) * 4096
                                         + ((((tt >> 5) * 2 + ((tt >> 4) & 1)) * 2) * 64 + ((tt >> 2) & 1) * 32 + c) * 8 + ((tt >> 3) & 1) * 4 + (tt & 3);
                            vc[0] = h0; vc[64 * 8] = h1;
                        }
                    }
                }
                GRID_BAR();
                {
#ifdef PROBE_ATTN2
                  for (int rep = 0; rep < 2; ++rep)
#else
                  const int rep = 0;
#endif
                  {
                    float* wl = (float*)(lds + wave * 16384);
                    const int lane_ = lane;
                    const int myq = (int)(__builtin_amdgcn_s_getreg((3 << 11) | 20) & 7u);
                    for (int qi = 0; qi < 8; ++qi) {
                        const int q = (myq + qi) & 7;
                        unsigned* ctr = ctl + 64 * (1 + (l * 2 + rep) * 8 + q);
                        for (;;) {
                            unsigned u = 0;
                            if (lane_ == 0) u = atomicAdd(ctr, 1u);
                            u = (unsigned)__builtin_amdgcn_readfirstlane((int)u);
                            if (u >= 2048u) break;
                            const int lane = launder_v(lane_);
                            if (u < 1024u) {
                                const int pr = (int)(u >> 9), i = (int)(u & 511u), slot = 63 - (i >> 3), w = i & 7;
                                const int bg = 4 * q + 2 * pr + (w >> 2);
                                nsa_unit(ws, bg >> 1, bg & 1, slot * 4 + (w & 3), lane, wl);
                            } else if (u < 1536u) {
                                const int i = (int)(u - 1024u), hf = i >> 8, slot = 63 - ((i & 255) >> 2);
                                fox_unit(ws, 8 * q + 4 * hf + (i & 3), slot, lane);
                            } else {
                                const int i = (int)(u - 1536u), hf = i >> 8, slot = 63 - ((i & 255) >> 2);
                                moba_unit(ws, 8 * q + 4 * hf + (i & 3), slot, lane);
                            }
                        }
                    }
                  }
                }
                GRID_BAR();
                {
                    pg8::Gemm g{(const bf16_t*)(ws + WS_H), (const bf16_t*)(ws + WS_WOUT) + (size_t)l * DM * DM, NTOK, DM, DM, DM};
                    pg8::StaticOrder S; S.init(NTOK, DM, G, bid);
                    EpiResid E{xin, P.out, modl + (size_t)(1 * 3 + 2) * DM, 1.0f};
#ifndef NO_OUTPROJ
                    pg8::gemm_phase<EpiResid, true>(lds3, g, S, E, wave0);
#endif
                }
                GRID_BAR();
            }
        }
    }
    final_norm(P.out, P.final_g, fresh_lane(), wave0, G);
}

extern "C" void kernel_launch(void* const* d_in, const int* in_sizes, int n_in, void* d_out, int out_size, void* d_ws, size_t ws_size, hipStream_t stream) {
    static int grid_blocks = 0;
    if (grid_blocks == 0) {
        if (n_in != 15 || ws_size < WS_END) { fprintf(stderr, "kernel_launch: unexpected inputs (n_in %d, ws %zu)\n", n_in, ws_size); grid_blocks = -1; return; }
        int dev = 0, cus = 0, per_cu = 0;
        hipGetDevice(&dev);
        hipDeviceGetAttribute(&cus, hipDeviceAttributeMultiprocessorCount, dev);
        if (hipFuncSetAttribute((const void*)fwd_megakernel, hipFuncAttributeMaxDynamicSharedMemorySize, LDS_BYTES) != hipSuccess) fprintf(stderr, "kernel_launch: hipFuncSetAttribute failed\n");
        if (hipOccupancyMaxActiveBlocksPerMultiprocessor(&per_cu, (const void*)fwd_megakernel, 512, LDS_BYTES) != hipSuccess || per_cu < 1) { fprintf(stderr, "kernel_launch: occupancy query gave %d\n", per_cu); per_cu = 1; }
        (void)hipGetLastError();
        grid_blocks = cus * per_cu;
        if (grid_blocks > 256) grid_blocks = 256;
    }
    if (grid_blocks < 0) return;
    hipMemsetAsync((char*)d_ws + WS_CTL, 0, 1 * MiB, stream);
    Params p{};
    p.x = (const float*)d_in[0]; p.c = (const float*)d_in[1]; p.positions = (const int*)d_in[2]; p.norm_g = (const float*)d_in[3];
    p.w_ada = (const float*)d_in[4]; p.b_ada = (const float*)d_in[5]; p.w_in = (const float*)d_in[6]; p.fox_fbias = (const float*)d_in[7];
    p.cmp_pos = (const float*)d_in[8]; p.cmp_w1 = (const float*)d_in[9]; p.cmp_w2 = (const float*)d_in[10]; p.w_out = (const float*)d_in[11];
    p.ffn_w13 = (const float*)d_in[12]; p.ffn_w2 = (const float*)d_in[13]; p.final_g = (const float*)d_in[14];
    p.out = (float*)d_out; p.ws = (unsigned char*)d_ws;
    void* args[] = {&p};
    hipError_t e = hipLaunchCooperativeKernel((const void*)fwd_megakernel, dim3(grid_blocks), dim3(512), args, LDS_BYTES, stream);
    if (e != hipSuccess) fprintf(stderr, "kernel_launch: cooperative launch failed: %s (grid %d)\n", hipGetErrorString(e), grid_blocks);
}
```

```cpp
#include <hip/hip_runtime.h>
#include <hip/hip_cooperative_groups.h>
#include <cstdio>
#include <cstdint>
namespace cg = cooperative_groups;

#define LAS __attribute__((address_space(3)))
typedef unsigned short bf16_t;
typedef short bf16x8 __attribute__((ext_vector_type(8)));
typedef short s16x4 __attribute__((ext_vector_type(4)));
typedef float f32x4 __attribute__((ext_vector_type(4)));
typedef float f32x2 __attribute__((ext_vector_type(2)));
typedef float f32x16 __attribute__((ext_vector_type(16)));
typedef unsigned u32x4 __attribute__((ext_vector_type(4)));
typedef unsigned u32x2 __attribute__((ext_vector_type(2)));
typedef __bf16 bf16x2_t __attribute__((ext_vector_type(2)));

constexpr int NB = 16, SEQ = 2048, DM = 1024, NTOK = NB * SEQ, DEPTH = 4, FF = 2816, NIN = 3072, NADA = 9216;
constexpr float LOG2E = 1.4426950408889634f;
constexpr float QK_C2 = 0.125f * LOG2E;
constexpr float NEG_INF = -__builtin_inff();

constexpr size_t MiB = 1u << 20;
constexpr size_t WS_CTL = 0;
constexpr size_t WS_B1 = 4 * MiB;
constexpr size_t WS_MOD = 1 * MiB;
constexpr size_t WS_COS = 5 * MiB, WS_SIN = 6 * MiB;
constexpr size_t WS_CW2T = 7 * MiB;
constexpr size_t WS_WIN = 8 * MiB;
constexpr size_t WS_WOUT = 32 * MiB;
constexpr size_t WS_CW1 = 40 * MiB;
constexpr size_t WS_W13 = 48 * MiB;
constexpr size_t WS_W2 = 136 * MiB;
constexpr size_t WS_H = 180 * MiB;
constexpr size_t WS_BIG = 244 * MiB;
constexpr size_t WS_QNSA = 244 * MiB;
constexpr size_t WS_KC = 276 * MiB;
constexpr size_t WS_VC = 285 * MiB;
constexpr size_t WS_KS = 294 * MiB, WS_KW = 302 * MiB;
constexpr size_t WS_FOXQ = 310 * MiB;
constexpr size_t WS_FOXK = 326 * MiB;
constexpr size_t WS_MOBAQ = 342 * MiB, WS_MOBAK = 358 * MiB;
constexpr size_t WS_VST = 374 * MiB, WS_VWT = 382 * MiB;
constexpr size_t WS_FOXVT = 390 * MiB, WS_MOBAVT = 406 * MiB;
constexpr size_t WS_GATES = 422 * MiB;
constexpr size_t WS_FLOG = 425 * MiB;
constexpr size_t WS_FCUM = 426 * MiB;
constexpr size_t WS_KMEAN = 427 * MiB;
constexpr size_t WS_CMPHID = 428 * MiB;
constexpr size_t WS_KCMP = 432 * MiB;
constexpr size_t WS_VCMPT = 433 * MiB;
constexpr size_t WS_END = 436 * MiB;

constexpr int RING_BYTES = 131072;
constexpr int LDS_BYTES = 147456;
constexpr int NWAVES = 8;

__device__ __forceinline__ unsigned cvtpk(float lo, float hi) { f32x2 v = {lo, hi}; bf16x2_t b = __builtin_convertvector(v, bf16x2_t); return __builtin_bit_cast(unsigned, b); }
__device__ __forceinline__ float bf2f(short s) { return __uint_as_float(((unsigned)(unsigned short)s) << 16); }
__device__ __forceinline__ float fast_exp2(float x) { return __builtin_amdgcn_exp2f(x); }
__device__ __forceinline__ float fast_rcp(float x) { return __builtin_amdgcn_rcpf(x); }
__device__ __forceinline__ float silu_f(float a) { return a * fast_rcp(1.0f + fast_exp2(-a * LOG2E)); }
__device__ __forceinline__ float sigmoid_f(float a) { return 1.0f / (1.0f + __expf(-a)); }
__device__ __forceinline__ float gelu_tanh(float x) {
    const float u = 0.7978845608028654f * (x + 0.044715f * x * x * x);
    const float e = fast_exp2(2.0f * LOG2E * u);
    const float th = 1.0f - 2.0f * fast_rcp(e + 1.0f);
    return 0.5f * x * (1.0f + th);
}
__device__ __forceinline__ float wave_sum(float v) {
#pragma unroll
    for (int o = 1; o < 64; o <<= 1) v += __shfl_xor(v, o);
    return v;
}
__device__ __forceinline__ unsigned char* launder_p(unsigned char* p) { size_t z = 0; asm volatile("" : "+s"(z)); return p + z; }
__device__ __forceinline__ int launder_i(int v) { asm volatile("" : "+s"(v)); return v; }
__device__ __forceinline__ int launder_v(int v) { asm volatile("" : "+v"(v)); return v; }
__device__ __forceinline__ int fresh_lane() { unsigned m = ~0u; asm volatile("" : "+s"(m)); return (int)__builtin_amdgcn_mbcnt_hi(m, __builtin_amdgcn_mbcnt_lo(m, 0u)); }
__device__ __forceinline__ int crow(int r, int hi) { return (r & 3) + 8 * (r >> 2) + 4 * hi; }

namespace pg8 {
constexpr int BM = 256, BK = 64, HALF = 128, HTB = HALF * BK * 2, STAGE_BYTES = 8 * HTB, NXCD = 8, WGM = 8;
__host__ __device__ __forceinline__ int lds_byte(int r, int c) { const int st = (r >> 4) * 2 + (c >> 5), rr = r & 15, cc = c & 31, ob = rr * 64 + cc * 2; return st * 1024 + (ob ^ (((ob >> 9) & 1) << 5)); }
__host__ __device__ __forceinline__ void stage_rc(int b, int& R, int& C) { const int st = b / 1024, sb = b % 1024, swz = sb ^ (((sb >> 9) & 1) << 5); R = (st >> 1) * 16 + swz / 64; C = (st & 1) * 32 + (swz % 64) / 2; }
__host__ __device__ __forceinline__ int perm32(int rho) { const int n = rho >> 4, i = rho & 15; return 8 * (i >> 2) + 4 * n + (i & 3); }

struct Unit { int pm, pn; };
struct Gemm { const bf16_t* A; const bf16_t* Bt; int M, N, K, lda; };

struct StaticOrder {
    int nM, nN, nwg, G, c;
    __device__ void init(int M, int N, int G_, int c_) { nM = M / BM; nN = N / BM; nwg = nM * nN; G = G_; c = c_; }
    __device__ bool next(int i, Unit& u) const {
        const long L = (long)i * G + c; if (L >= nwg) return false;
        int wgid = (int)L; { const int q = nwg / NXCD, r = nwg % NXCD, xcd = wgid % NXCD, off = wgid / NXCD; wgid = (xcd < r ? xcd * (q + 1) : r * (q + 1) + (xcd - r) * q) + off; }
        const int nig = WGM * nN, gid = wgid / nig, fm = gid * WGM, gsz = (nM - fm) < WGM ? (nM - fm) : WGM;
        u.pm = fm + ((wgid % nig) % gsz); u.pn = (wgid % nig) / gsz; return true;
    }
};

template <class Epi, bool ALIGN_EPI>
__device__ __forceinline__ void gemm_phase(LAS unsigned char* lds, const Gemm g, const StaticOrder& S, const Epi& E, int wave0) {
    const int wid = wave0, lane = fresh_lane(), tid = wid * 64 + lane, wr = wid >> 2, wc = wid & 3, fr = lane & 15, fq = lane >> 4;
    const int K = g.K, nt = K / BK, lda = g.lda;
    unsigned voffA[2], voffB[2];
#pragma unroll
    for (int i = 0; i < 2; ++i) { int R, C; stage_rc(tid * 16 + i * 8192, R, C); const int Rb = Epi::PERM ? ((R & ~31) + perm32(R & 31)) : R;
        voffA[i] = (unsigned)(R * lda + C) * 2u; voffB[i] = (unsigned)(Rb * K + C) * 2u; }
    const size_t kstep = (size_t)(BK * 2);
    const size_t hstepA = (size_t)HALF * lda * 2, hstepB = (size_t)HALF * K * 2;
    const size_t tstepA = 2 * hstepA, tstepB = 2 * hstepB;
    const unsigned ldsw = (unsigned)wid * 1024u;
    const int aoff = lds_byte(wr * 64 + fr, fq * 8), boff = lds_byte(wc * 32 + fr, fq * 8);
#define PG8_SA(b, h) (((b) * 2 + (h)) * HTB)
#define PG8_SB(b, h) ((4 + (b) * 2 + (h)) * HTB)
#define PG8_STAGE(bufoff, gbase, voff) do { _Pragma("unroll") for (int _i = 0; _i < 2; ++_i) \
        __builtin_amdgcn_global_load_lds((const unsigned*)((const char*)(gbase) + (voff)[_i]), (LAS unsigned*)(lds + (bufoff) + ldsw + _i * 8192), 16, 0, 0); } while (0)
#define PG8_LDA(dst, b, h) do { _Pragma("unroll") for (int m = 0; m < 4; ++m) _Pragma("unroll") for (int k = 0; k < 2; ++k) dst[m][k] = *(const LAS bf16x8*)(lds + PG8_SA(b, h) + aoff + m * 2048 + k * 1024); } while (0)
#define PG8_LDB(dst, b, h) do { _Pragma("unroll") for (int n = 0; n < 2; ++n) _Pragma("unroll") for (int k = 0; k < 2; ++k) dst[n][k] = *(const LAS bf16x8*)(lds + PG8_SB(b, h) + boff + n * 2048 + k * 1024); } while (0)
#define PG8_MMA(ai, bj, At, Bt) do { __builtin_amdgcn_s_setprio(1); _Pragma("unroll") for (int m = 0; m < 4; ++m) _Pragma("unroll") for (int n = 0; n < 2; ++n) _Pragma("unroll") for (int k = 0; k < 2; ++k) \
        acc[ai][bj][m][n] = __builtin_amdgcn_mfma_f32_16x16x32_bf16(Bt[n][k], At[m][k], acc[ai][bj][m][n], 0, 0, 0); __builtin_amdgcn_s_setprio(0); } while (0)
#define PG8_WAIT_V(n) asm volatile("s_waitcnt vmcnt(" #n ")" ::: "memory")
#define PG8_WAIT_L(n) asm volatile("s_waitcnt lgkmcnt(" #n ")" ::: "memory")
#define PG8_BAR __builtin_amdgcn_s_barrier()
#define PG8_SCHED __builtin_amdgcn_sched_barrier(0)
    Unit cur, nxt; int ui = 0;
    if (!S.next(0, cur)) return;
    f32x4 acc[2][2][4][2];
#pragma unroll
    for (int a = 0; a < 2; ++a)
#pragma unroll
        for (int b = 0; b < 2; ++b)
#pragma unroll
            for (int m = 0; m < 4; ++m)
#pragma unroll
                for (int n = 0; n < 2; ++n) acc[a][b][m][n] = (f32x4){0.f, 0.f, 0.f, 0.f};
    bf16x8 At[4][2], B0[2][2], B1[2][2];
    const char* cA = (const char*)g.A + (size_t)cur.pm * tstepA; const char* cB = (const char*)g.Bt + (size_t)cur.pn * tstepB;
    PG8_STAGE(PG8_SB(0, 0), cB, voffB); PG8_STAGE(PG8_SB(0, 1), cB + hstepB, voffB); PG8_STAGE(PG8_SA(0, 0), cA, voffA); PG8_STAGE(PG8_SA(0, 1), cA + hstepA, voffA);
    if (wr == 1) PG8_BAR;
    PG8_WAIT_V(2); PG8_BAR;
    PG8_STAGE(PG8_SB(1, 0), cB + kstep, voffB); PG8_STAGE(PG8_SA(1, 0), cA + kstep, voffA); PG8_STAGE(PG8_SB(1, 1), cB + hstepB + kstep, voffB);
    PG8_WAIT_V(6); PG8_BAR;
    for (;;) {
        const bool has_next = S.next(ui + 1, nxt);
        const char* nA = has_next ? (const char*)g.A + (size_t)nxt.pm * tstepA : cA; const char* nB = has_next ? (const char*)g.Bt + (size_t)nxt.pn * tstepB : cB;
        for (int t = 0; t < nt; t += 2) {
            const bool last = (t == nt - 2);
            const char* a1 = cA + (size_t)(t + 1) * kstep;
            const char* a2 = last ? nA : cA + (size_t)(t + 2) * kstep; const char* b2 = last ? nB : cB + (size_t)(t + 2) * kstep;
            const char* a3 = a2 + kstep; const char* b3 = b2 + kstep;
            PG8_LDB(B0, 0, 0); PG8_LDB(B1, 0, 1); PG8_SCHED; PG8_LDA(At, 0, 0); PG8_STAGE(PG8_SA(1, 1), a1 + hstepA, voffA);
            PG8_WAIT_V(8); PG8_WAIT_L(0); PG8_BAR; PG8_MMA(0, 0, At, B0); PG8_MMA(0, 1, At, B1); PG8_BAR; PG8_SCHED;
            PG8_LDA(At, 0, 1); PG8_STAGE(PG8_SB(0, 0), b2, voffB); PG8_STAGE(PG8_SB(0, 1), b2 + hstepB, voffB); PG8_STAGE(PG8_SA(0, 0), a2, voffA);
            PG8_WAIT_V(8); PG8_WAIT_L(0); PG8_BAR; PG8_MMA(1, 0, At, B0); PG8_MMA(1, 1, At, B1); PG8_BAR; PG8_SCHED;
            PG8_LDB(B0, 1, 0); PG8_LDB(B1, 1, 1); PG8_SCHED; PG8_LDA(At, 1, 0); PG8_STAGE(PG8_SA(0, 1), a2 + hstepA, voffA);
            PG8_WAIT_V(8); PG8_WAIT_L(0); PG8_BAR; PG8_MMA(0, 0, At, B0); PG8_MMA(0, 1, At, B1); PG8_BAR; PG8_SCHED;
            PG8_LDA(At, 1, 1); PG8_STAGE(PG8_SB(1, 0), b3, voffB); PG8_STAGE(PG8_SB(1, 1), b3 + hstepB, voffB); PG8_STAGE(PG8_SA(1, 0), a3, voffA);
            PG8_WAIT_V(8); PG8_WAIT_L(0); PG8_BAR; PG8_MMA(1, 0, At, B0); PG8_MMA(1, 1, At, B1); PG8_BAR; PG8_SCHED;
        }
        if constexpr (ALIGN_EPI) { if (wr == 0) PG8_BAR; }
        { int efr = fr, efq = fq, ewr = wr, ewc = wc; asm volatile("" : "+v"(efr), "+v"(efq), "+s"(ewr), "+s"(ewc)); E(acc, cur, ewr, ewc, efr, efq); }
        if (!has_next) break;
#pragma unroll
        for (int a = 0; a < 2; ++a)
#pragma unroll
            for (int b = 0; b < 2; ++b)
#pragma unroll
                for (int m = 0; m < 4; ++m)
#pragma unroll
                    for (int n = 0; n < 2; ++n) acc[a][b][m][n] = (f32x4){0.f, 0.f, 0.f, 0.f};
        cur = nxt; cA = nA; cB = nB; ++ui;
        if constexpr (ALIGN_EPI) { if (wr == 1) PG8_BAR; }
    }
    PG8_WAIT_V(0);
    if constexpr (!ALIGN_EPI) { if (wr == 0) PG8_BAR; }
    PG8_BAR;
#undef PG8_SA
#undef PG8_SB
#undef PG8_STAGE
#undef PG8_LDA
#undef PG8_LDB
#undef PG8_MMA
#undef PG8_WAIT_V
#undef PG8_WAIT_L
#undef PG8_BAR
#undef PG8_SCHED
}
}

struct EpiSwiglu {
    static constexpr bool PERM = true;
    bf16_t* O;
    __device__ __forceinline__ void operator()(const f32x4 (&acc)[2][2][4][2], const pg8::Unit& u, int wr, int wc, int fr, int fq) const {
        const int row0 = u.pm * 256 + wr * 64 + fr, col0 = u.pn * 128 + wc * 32 + 8 * fq;
#pragma unroll
        for (int ai = 0; ai < 2; ++ai)
#pragma unroll
            for (int m = 0; m < 4; ++m) {
                bf16_t* rowp = O + (size_t)(row0 + ai * 128 + m * 16) * FF + col0;
                const f32x4 a0 = acc[ai][0][m][0], a1 = acc[ai][0][m][1], b0 = acc[ai][1][m][0], b1 = acc[ai][1][m][1];
                u32x4 w;
                w.x = cvtpk(silu_f(a0[0]) * b0[0], silu_f(a0[1]) * b0[1]); w.y = cvtpk(silu_f(a0[2]) * b0[2], silu_f(a0[3]) * b0[3]);
                w.z = cvtpk(silu_f(a1[0]) * b1[0], silu_f(a1[1]) * b1[1]); w.w = cvtpk(silu_f(a1[2]) * b1[2], silu_f(a1[3]) * b1[3]);
                *(u32x4*)rowp = w;
            }
    }
};
struct EpiResid {
    static constexpr bool PERM = false;
    const float* xin; float* xout; const float* gate; float coef;
    __device__ __forceinline__ void operator()(const f32x4 (&acc)[2][2][4][2], const pg8::Unit& u, int wr, int wc, int fr, int fq) const {
        const int b = (u.pm * 256) >> 11;
        const int row0 = u.pm * 256 + wr * 64 + fr;
#pragma unroll
        for (int bj = 0; bj < 2; ++bj)
#pragma unroll
            for (int n = 0; n < 2; ++n) {
                const int col = u.pn * 256 + bj * 128 + wc * 32 + n * 16 + 4 * fq;
                const f32x4 gv = *(const f32x4*)(gate + (size_t)b * NADA + col) * coef;
                f32x4 xv[2][4];
#pragma unroll
                for (int ai = 0; ai < 2; ++ai)
#pragma unroll
                    for (int m = 0; m < 4; ++m) xv[ai][m] = *(const f32x4*)(xin + (size_t)(row0 + ai * 128 + m * 16) * DM + col);
#pragma unroll
                for (int ai = 0; ai < 2; ++ai)
#pragma unroll
                    for (int m = 0; m < 4; ++m) {
                        const size_t off = (size_t)(row0 + ai * 128 + m * 16) * DM + col;
                        *(f32x4*)(xout + off) = xv[ai][m] + gv * acc[ai][bj][m][n];
                    }
            }
    }
};
struct EpiGelu {
    static constexpr bool PERM = true;
    bf16_t* O; const float* bias;
    __device__ __forceinline__ void operator()(const f32x4 (&acc)[2][2][4][2], const pg8::Unit& u, int wr, int wc, int fr, int fq) const {
        const int row0 = u.pm * 256 + wr * 64 + fr;
#pragma unroll
        for (int bj = 0; bj < 2; ++bj) {
            const int col0 = u.pn * 256 + bj * 128 + wc * 32 + 8 * fq;
            const f32x4 bv0 = *(const f32x4*)(bias + col0), bv1 = *(const f32x4*)(bias + col0 + 4);
#pragma unroll
            for (int ai = 0; ai < 2; ++ai)
#pragma unroll
                for (int m = 0; m < 4; ++m) {
                    const f32x4 v0 = acc[ai][bj][m][0] + bv0, v1 = acc[ai][bj][m][1] + bv1;
                    u32x4 w;
                    w.x = cvtpk(gelu_tanh(v0[0]), gelu_tanh(v0[1])); w.y = cvtpk(gelu_tanh(v0[2]), gelu_tanh(v0[3]));
                    w.z = cvtpk(gelu_tanh(v1[0]), gelu_tanh(v1[1])); w.w = cvtpk(gelu_tanh(v1[2]), gelu_tanh(v1[3]));
                    *(u32x4*)(O + (size_t)(row0 + ai * 128 + m * 16) * 256 + col0) = w;
                }
        }
    }
};
struct EpiInProj {
    static constexpr bool PERM = true;
    unsigned char* ws; const float* fbias;
    __device__ __forceinline__ void operator()(const f32x4 (&acc)[2][2][4][2], const pg8::Unit& u, int wr, int wc, int fr, int fq) const {
        part<0>(acc, u, wr, wc, fr, fq); part<1>(acc, u, wr, wc, fr, fq);
    }
    template <int bj>
    __device__ __forceinline__ void part(const f32x4 (&acc)[2][2][4][2], const pg8::Unit& u, int wr, int wc, int fr, int fq) const {
        const float* cosT = (const float*)(ws + WS_COS); const float* sinT = (const float*)(ws + WS_SIN);
        {
            const int cb = u.pn * 256 + bj * 128 + wc * 32;
            const int hg = cb >> 6, half = (cb >> 5) & 1;
            if (hg > 44) return;
            int mode, NH = 1, hd = 0, pitch = 0; bool rope = false; bf16_t* base = nullptr;
            if (hg < 8)       { mode = 0; base = (bf16_t*)(ws + WS_QNSA); pitch = 512; hd = hg; rope = true; }
            else if (hg < 10) { mode = 1; base = (bf16_t*)(ws + WS_KC); NH = 2; hd = hg - 8; rope = true; }
            else if (hg < 12) { mode = 4; base = (bf16_t*)(ws + WS_KS); NH = 2; hd = hg - 10; rope = true; }
            else if (hg < 14) { mode = 4; base = (bf16_t*)(ws + WS_KW); NH = 2; hd = hg - 12; rope = true; }
            else if (hg < 18) { mode = 0; base = (bf16_t*)(ws + WS_FOXQ); pitch = 256; hd = hg - 14; }
            else if (hg < 22) { mode = 4; base = (bf16_t*)(ws + WS_FOXK); NH = 4; hd = hg - 18; }
            else if (hg < 26) { mode = 0; base = (bf16_t*)(ws + WS_MOBAQ); pitch = 256; hd = hg - 22; rope = true; }
            else if (hg < 30) { mode = 4; base = (bf16_t*)(ws + WS_MOBAK); NH = 4; hd = hg - 26; rope = true; }
            else if (hg < 32) { mode = 1; base = (bf16_t*)(ws + WS_VC); NH = 2; hd = hg - 30; }
            else if (hg < 34) { mode = 2; base = (bf16_t*)(ws + WS_VST); NH = 2; hd = hg - 32; }
            else if (hg < 36) { mode = 2; base = (bf16_t*)(ws + WS_VWT); NH = 2; hd = hg - 34; }
            else if (hg < 40) { mode = 2; base = (bf16_t*)(ws + WS_FOXVT); NH = 4; hd = hg - 36; }
            else if (hg < 44) { mode = 2; base = (bf16_t*)(ws + WS_MOBAVT); NH = 4; hd = hg - 40; }
            else { mode = 3; if (half) return; }
            const bool do_rope = rope && (half == 0);
#pragma unroll
            for (int ai = 0; ai < 2; ++ai)
#pragma unroll
                for (int m = 0; m < 4; ++m) {
                    const int row = u.pm * 256 + ai * 128 + wr * 64 + m * 16 + fr;
                    const int b = row >> 11, t = row & 2047;
                    float v[8];
#pragma unroll
                    for (int i = 0; i < 4; ++i) { v[i] = acc[ai][bj][m][0][i]; v[4 + i] = acc[ai][bj][m][1][i]; }
                    if (do_rope) {
                        float pr[8];
#pragma unroll
                        for (int i = 0; i < 8; ++i) pr[i] = __shfl_xor(v[i], 16);
                        if (fq < 2) {
                            const f32x4 c0 = *(const f32x4*)(cosT + (size_t)row * 8), c1 = *(const f32x4*)(cosT + (size_t)row * 8 + 4);
                            const f32x4 s0 = *(const f32x4*)(sinT + (size_t)row * 8), s1 = *(const f32x4*)(sinT + (size_t)row * 8 + 4);
                            const float sg = (fq == 0) ? -1.0f : 1.0f;
#pragma unroll
                            for (int i = 0; i < 4; ++i) { v[i] = v[i] * c0[i] + sg * pr[i] * s0[i]; v[4 + i] = v[4 + i] * c1[i] + sg * pr[4 + i] * s1[i]; }
                        }
                    }
                    if (mode == 3) {
                        float* gates = (float*)(ws + WS_GATES); float* flog = (float*)(ws + WS_FLOG);
                        if (fq < 3) {
                            f32x4 g0, g1;
#pragma unroll
                            for (int i = 0; i < 4; ++i) { g0[i] = sigmoid_f(v[i]); g1[i] = sigmoid_f(v[4 + i]); }
                            *(f32x4*)(gates + (size_t)row * 24 + 8 * fq) = g0; *(f32x4*)(gates + (size_t)row * 24 + 8 * fq + 4) = g1;
                        } else {
#pragma unroll
                            for (int i = 0; i < 4; ++i) {
                                const float z = v[i] + fbias[i];
                                const float ls = (z > 0.f) ? -log1pf(__expf(-z)) : (z - log1pf(__expf(z)));
                                flog[(size_t)(b * 4 + i) * SEQ + t] = ls;
                            }
                        }
                    } else {
                        u32x4 w; w.x = cvtpk(v[0], v[1]); w.y = cvtpk(v[2], v[3]); w.z = cvtpk(v[4], v[5]); w.w = cvtpk(v[6], v[7]);
                        const int dcol = half * 32 + 8 * fq;
                        if (mode == 0) *(u32x4*)(base + (size_t)row * pitch + hd * 64 + dcol) = w;
                        else if (mode == 1) *(u32x4*)(base + ((size_t)(b * NH + hd) * SEQ + t) * 64 + dcol) = w;
                        else if (mode == 4) {
                            const int d0 = half * 2 + (fq >> 1), khi = fq & 1;
                            *(u32x4*)(base + (size_t)(b * NH + hd) * SEQ * 64 + (size_t)(t >> 6) * 4096 + ((((t >> 5) & 1) * 4 + d0) * 64 + khi * 32 + (t & 31)) * 8) = w;
                        } else {
                            const int tt = t & 63, hf = tt >> 5, jj = (tt >> 4) & 1, piece = (tt >> 3) & 1, vhi = (tt >> 2) & 1, e = tt & 3;
                            bf16_t* p = base + (size_t)(b * NH + hd) * SEQ * 64 + (size_t)(t >> 6) * 4096 + (((hf * 2 + jj) * 2 + half) * 64 + vhi * 32 + 8 * fq) * 8 + piece * 4 + e;
                            p[0 * 8] = (bf16_t)(w.x & 0xffffu); p[1 * 8] = (bf16_t)(w.x >> 16);
                            p[2 * 8] = (bf16_t)(w.y & 0xffffu); p[3 * 8] = (bf16_t)(w.y >> 16);
                            p[4 * 8] = (bf16_t)(w.z & 0xffffu); p[5 * 8] = (bf16_t)(w.z >> 16);
                            p[6 * 8] = (bf16_t)(w.w & 0xffffu); p[7 * 8] = (bf16_t)(w.w >> 16);
                        }
                    }
                }
        }
    }
};

#define MFMA32(a, b, c) __builtin_amdgcn_mfma_f32_32x32x16_bf16((a), (b), (c), 0, 0, 0)
__device__ __forceinline__ f32x16 qk32(const bf16_t* kp, const bf16x8 (&qf)[4]) {
    f32x16 p;
#pragma unroll
    for (int r = 0; r < 16; ++r) p[r] = 0.f;
#pragma unroll
    for (int d0 = 0; d0 < 4; ++d0) { const bf16x8 kf = *(const bf16x8*)(kp + 16 * d0); p = MFMA32(kf, qf[d0], p); }
    return p;
}
__device__ __forceinline__ void pv32(f32x16 (&o)[2], const bf16_t* vp, int vpitch, const f32x16& p) {
#pragma unroll
    for (int j = 0; j < 2; ++j) {
        u32x4 pw; pw.x = cvtpk(p[8 * j + 0], p[8 * j + 1]); pw.y = cvtpk(p[8 * j + 2], p[8 * j + 3]); pw.z = cvtpk(p[8 * j + 4], p[8 * j + 5]); pw.w = cvtpk(p[8 * j + 6], p[8 * j + 7]);
        const bf16x8 pb = __builtin_bit_cast(bf16x8, pw);
#pragma unroll
        for (int dh = 0; dh < 2; ++dh) {
            const bf16_t* q = vp + (size_t)dh * 32 * vpitch + 16 * j;
            const s16x4 lo = *(const s16x4*)q, hi4 = *(const s16x4*)(q + 8);
            const bf16x8 va = (bf16x8){lo[0], lo[1], lo[2], lo[3], hi4[0], hi4[1], hi4[2], hi4[3]};
            o[dh] = MFMA32(va, pb, o[dh]);
        }
    }
}
__device__ __forceinline__ void load_k64(bf16x8 (&kf)[8], const bf16_t* ktile, int lane) {
    const bf16_t* p = ktile + lane * 8;
#pragma unroll
    for (int i = 0; i < 8; ++i) kf[i] = *(const bf16x8*)(p + i * 512);
}
__device__ __forceinline__ void load_v64(bf16x8 (&vf)[8], const bf16_t* vtile, int lane) {
    const bf16_t* p = vtile + lane * 8;
#pragma unroll
    for (int i = 0; i < 8; ++i) vf[i] = *(const bf16x8*)(p + i * 512);
}
template <int MODE, bool MASKED>
__device__ __forceinline__ void softmax_pv(f32x16 (&o)[2], float& m, float& l, f32x16& p0, f32x16& p1, const bf16x8 (&vf)[8],
                                           int kb, int t, bool tsel, const float* F8, float Fq8, int hi) {
    if (MODE == 2) {
#pragma unroll
        for (int g = 0; g < 4; ++g) {
            const f32x4 fa = *(const f32x4*)(F8 + kb + 8 * g + 4 * hi), fbv = *(const f32x4*)(F8 + kb + 32 + 8 * g + 4 * hi);
#pragma unroll
            for (int i = 0; i < 4; ++i) { p0[4 * g + i] += Fq8 - fa[i]; p1[4 * g + i] += Fq8 - fbv[i]; }
        }
    }
    if (MASKED) {
#pragma unroll
        for (int r = 0; r < 16; ++r) {
            const int k0 = kb + crow(r, hi), k1 = k0 + 32;
            bool v0, v1;
            if (MODE == 0) { v0 = tsel && (k0 <= t); v1 = tsel && (k1 <= t); }
            else if (MODE == 1) { v0 = (k0 <= t) && (k0 > t - 512); v1 = (k1 <= t) && (k1 > t - 512); }
            else { v0 = (k0 <= t); v1 = (k1 <= t); }
            p0[r] = v0 ? p0[r] : NEG_INF; p1[r] = v1 ? p1[r] : NEG_INF;
        }
    }
    float mx = fmaxf(p0[0], p1[0]);
#pragma unroll
    for (int r = 1; r < 16; ++r) mx = fmaxf(mx, fmaxf(p0[r], p1[r]));
    mx = fmaxf(mx, __shfl_xor(mx, 32));
    const float mnew = fmaxf(m, mx);
    const float msafe = (mnew == NEG_INF) ? 0.f : mnew;
    const float alpha = fast_exp2((m - msafe) * QK_C2);
    const float nm = -msafe * QK_C2;
    float ps = 0.f;
#pragma unroll
    for (int r = 0; r < 16; ++r) { p0[r] = fast_exp2(__builtin_fmaf(p0[r], QK_C2, nm)); p1[r] = fast_exp2(__builtin_fmaf(p1[r], QK_C2, nm)); ps += p0[r] + p1[r]; }
    l = l * alpha + ps; m = mnew;
#pragma unroll
    for (int r = 0; r < 16; ++r) { o[0][r] *= alpha; o[1][r] *= alpha; }
#pragma unroll
    for (int hf = 0; hf < 2; ++hf)
#pragma unroll
        for (int j = 0; j < 2; ++j) {
            const f32x16& p = hf ? p1 : p0;
            u32x4 pw; pw.x = cvtpk(p[8 * j + 0], p[8 * j + 1]); pw.y = cvtpk(p[8 * j + 2], p[8 * j + 3]); pw.z = cvtpk(p[8 * j + 4], p[8 * j + 5]); pw.w = cvtpk(p[8 * j + 6], p[8 * j + 7]);
            const bf16x8 pb = __builtin_bit_cast(bf16x8, pw);
#pragma unroll
            for (int dh = 0; dh < 2; ++dh) o[dh] = MFMA32(vf[(hf * 2 + j) * 2 + dh], pb, o[dh]);
        }
}
template <int MODE, class Sel>
__device__ __forceinline__ void flash_loop(f32x16 (&o)[2], float& m, float& l, const bf16x8 (&qf)[4], const bf16_t* K, const bf16_t* Vt,
                                           int jlo, int jhi, int t, int tmin, int tmax, Sel sel, const float* F8, float Fq8, int lane) {
    const int hi = lane >> 5;
    int j = jlo;
    for (; j <= jhi; ++j) { if (__any(sel(j))) break; }
    bf16x8 kf[8], vf[8];
    if (j <= jhi) load_k64(kf, K + (size_t)j * 4096, lane);
    while (j <= jhi) {
        int jn = j + 1;
        for (; jn <= jhi; ++jn) { if (__any(sel(jn))) break; }
        load_v64(vf, Vt + (size_t)j * 4096, lane);
        f32x16 p0, p1;
#pragma unroll
        for (int r = 0; r < 16; ++r) { p0[r] = 0.f; p1[r] = 0.f; }
#pragma unroll
        for (int d0 = 0; d0 < 4; ++d0) { p0 = MFMA32(kf[d0], qf[d0], p0); p1 = MFMA32(kf[4 + d0], qf[d0], p1); }
        if (jn <= jhi) load_k64(kf, K + (size_t)jn * 4096, lane);
        const int kb = j * 64;
        bool full = (kb + 63 <= tmin);
        if (MODE == 0) full = full && __all(sel(j));
        if (MODE == 1) full = full && (kb > tmax - 512);
        if (full) softmax_pv<MODE, false>(o, m, l, p0, p1, vf, kb, t, true, F8, Fq8, hi);
        else softmax_pv<MODE, true>(o, m, l, p0, p1, vf, kb, t, sel(j), F8, Fq8, hi);
        j = jn;
    }
}
__device__ __forceinline__ void load_q(bf16x8 (&qf)[4], const bf16_t* qrow, int hi) {
#pragma unroll
    for (int d0 = 0; d0 < 4; ++d0) qf[d0] = *(const bf16x8*)(qrow + 16 * d0 + 8 * hi);
}
__device__ __forceinline__ void store_o(bf16_t* dst, const f32x16 (&o)[2], int hi) {
#pragma unroll
    for (int dh = 0; dh < 2; ++dh)
#pragma unroll
        for (int g = 0; g < 4; ++g) {
            u32x2 w; w.x = cvtpk(o[dh][4 * g + 0], o[dh][4 * g + 1]); w.y = cvtpk(o[dh][4 * g + 2], o[dh][4 * g + 3]);
            *(u32x2*)(dst + 32 * dh + 8 * g + 4 * hi) = w;
        }
}
__device__ __forceinline__ unsigned nsa_select(const float (&imp)[32], int t) {
    const int tb = t >> 6;
    unsigned sel = 1u | (1u << tb) | (1u << (tb > 0 ? tb - 1 : 0));
#pragma unroll
    for (int it = 0; it < 5; ++it) {
        float bv = NEG_INF; int bj = -1;
#pragma unroll
        for (int j = 1; j < 32; ++j) { const bool cand = (j <= tb - 2) && !((sel >> j) & 1u) && (imp[j] > bv); if (cand) { bv = imp[j]; bj = j; } }
        if (bj >= 0) sel |= 1u << bj;
    }
    if (tb <= 7) sel = (2u << tb) - 1u;
    return sel;
}

__device__ __forceinline__ void nsa_unit(unsigned char* ws, int b, int g, int qg, int lane, float* wl) {
    const int hi = lane >> 5, c = lane & 31;
    const int t = qg * 8 + (c >> 2), head = g * 4 + (c & 3), row = b * SEQ + t, bg = b * 2 + g;
    bf16x8 qf[4];
    load_q(qf, (const bf16_t*)(ws + WS_QNSA) + (size_t)row * 512 + head * 64, hi);
    const float* gp = (const float*)(ws + WS_GATES) + (size_t)row * 24 + head * 3;
    const float g0 = gp[0];
    f32x16 o[2];
    float* oa = wl + 256 + lane;
    {
        const bf16_t* Kc = (const bf16_t*)(ws + WS_KCMP) + (size_t)bg * 8192;
        const bf16_t* Vct = (const bf16_t*)(ws + WS_VCMPT) + (size_t)bg * 8192;
        f32x16 s[4];
        float mx = NEG_INF;
#pragma unroll
        for (int tile = 0; tile < 2; ++tile) {
            bf16x8 kf[8];
            load_k64(kf, Kc + tile * 4096, lane);
#pragma unroll
            for (int hf = 0; hf < 2; ++hf) {
                const int grp = tile * 2 + hf;
#pragma unroll
                for (int r = 0; r < 16; ++r) s[grp][r] = 0.f;
#pragma unroll
                for (int d0 = 0; d0 < 4; ++d0) s[grp] = MFMA32(kf[hf * 4 + d0], qf[d0], s[grp]);
#pragma unroll
                for (int r = 0; r < 16; ++r) {
                    const int key = 32 * grp + crow(r, hi);
                    const float v = (16 * key + 31 <= t) ? s[grp][r] * QK_C2 : NEG_INF;
                    s[grp][r] = v; mx = fmaxf(mx, v);
                }
            }
        }
        mx = fmaxf(mx, __shfl_xor(mx, 32));
        const float msafe = (mx == NEG_INF) ? 0.f : mx;
        float ps = 0.f;
#pragma unroll
        for (int grp = 0; grp < 4; ++grp)
#pragma unroll
            for (int r = 0; r < 16; ++r) { s[grp][r] = fast_exp2(s[grp][r] - msafe); ps += s[grp][r]; }
        ps += __shfl_xor(ps, 32);
        const float inv = 1.0f / fmaxf(ps, 1e-30f);
#pragma unroll
        for (int grp = 0; grp < 4; ++grp)
#pragma unroll
            for (int r = 0; r < 16; ++r) s[grp][r] *= inv;
#pragma unroll
        for (int r = 0; r < 16; ++r) { o[0][r] = 0.f; o[1][r] = 0.f; }
#pragma unroll
        for (int tile = 0; tile < 2; ++tile) {
            bf16x8 vf[8];
            load_v64(vf, Vct + tile * 4096, lane);
#pragma unroll
            for (int hf = 0; hf < 2; ++hf)
#pragma unroll
                for (int j = 0; j < 2; ++j) {
                    const f32x16& p = s[tile * 2 + hf];
                    u32x4 pw; pw.x = cvtpk(p[8 * j + 0], p[8 * j + 1]); pw.y = cvtpk(p[8 * j + 2], p[8 * j + 3]); pw.z = cvtpk(p[8 * j + 4], p[8 * j + 5]); pw.w = cvtpk(p[8 * j + 6], p[8 * j + 7]);
                    const bf16x8 pb = __builtin_bit_cast(bf16x8, pw);
#pragma unroll
                    for (int dh = 0; dh < 2; ++dh) o[dh] = MFMA32(vf[(hf * 2 + j) * 2 + dh], pb, o[dh]);
                }
        }
#pragma unroll
        for (int r = 0; r < 16; ++r) { oa[r * 64] = g0 * o[0][r]; oa[(16 + r) * 64] = g0 * o[1][r]; }
        float recv[4][4];
#pragma unroll
        for (int grp = 0; grp < 4; ++grp)
#pragma unroll
            for (int gq = 0; gq < 4; ++gq) recv[grp][gq] = __shfl_xor(s[grp][4 * gq + 3], 32);
#pragma unroll
        for (int grp = 0; grp < 4; ++grp)
#pragma unroll
            for (int gq = 0; gq < 4; ++gq) {
                const float own = (s[grp][4 * gq] + s[grp][4 * gq + 1]) + (s[grp][4 * gq + 2] + s[grp][4 * gq + 3]);
                const float plo = (gq > 0) ? recv[grp][gq > 0 ? gq - 1 : 0] : ((grp > 0) ? recv[grp > 0 ? grp - 1 : 0][3] : 0.f);
                const float prev = hi ? recv[grp][gq] : plo;
                float v = own + prev;
                v += __shfl_xor(v, 1); v += __shfl_xor(v, 2);
                if ((c & 3) == 0) wl[(c >> 2) * 32 + 8 * grp + 2 * gq + hi] = v;
            }
    }
    asm volatile("s_waitcnt lgkmcnt(0)" ::: "memory");
    float imp[32];
#pragma unroll
    for (int j4 = 0; j4 < 8; ++j4) { const f32x4 v = *(const f32x4*)(wl + (c >> 2) * 32 + 4 * j4); imp[4 * j4] = v[0]; imp[4 * j4 + 1] = v[1]; imp[4 * j4 + 2] = v[2]; imp[4 * j4 + 3] = v[3]; }
    asm volatile("s_waitcnt lgkmcnt(0)" ::: "memory");
    const unsigned sel = nsa_select(imp, t);
    const int jmax = (qg * 8 + 7) >> 6;
    {
        const bf16_t* Ks = (const bf16_t*)(ws + WS_KS) + (size_t)bg * SEQ * 64;
        const bf16_t* Vst = (const bf16_t*)(ws + WS_VST) + (size_t)bg * 64 * SEQ;
        float m = NEG_INF, l = 0.f;
#pragma unroll
        for (int r = 0; r < 16; ++r) { o[0][r] = 0.f; o[1][r] = 0.f; }
        flash_loop<0>(o, m, l, qf, Ks, Vst, 0, jmax, t, qg * 8, qg * 8 + 7, [&](int j) { return (bool)((sel >> j) & 1u); }, nullptr, 0.f, lane);
        l += __shfl_xor(l, 32);
        const float sc = gp[1] / fmaxf(l, 1e-30f);
#pragma unroll
        for (int r = 0; r < 16; ++r) { oa[r * 64] += sc * o[0][r]; oa[(16 + r) * 64] += sc * o[1][r]; }
        asm volatile("s_waitcnt lgkmcnt(0)" ::: "memory");
    }
    {
        const bf16_t* Kw = (const bf16_t*)(ws + WS_KW) + (size_t)bg * SEQ * 64;
        const bf16_t* Vwt = (const bf16_t*)(ws + WS_VWT) + (size_t)bg * 64 * SEQ;
        float m = NEG_INF, l = 0.f;
#pragma unroll
        for (int r = 0; r < 16; ++r) { o[0][r] = 0.f; o[1][r] = 0.f; }
        const int tl = qg * 8 - 511;
        const int jlo = (tl > 0 ? tl : 0) >> 6;
        flash_loop<1>(o, m, l, qf, Kw, Vwt, jlo, jmax, t, qg * 8, qg * 8 + 7, [&](int) { return true; }, nullptr, 0.f, lane);
        l += __shfl_xor(l, 32);
        const float sc = gp[2] / fmaxf(l, 1e-30f);
#pragma unroll
        for (int r = 0; r < 16; ++r) { o[0][r] = oa[r * 64] + sc * o[0][r]; o[1][r] = oa[(16 + r) * 64] + sc * o[1][r]; }
        asm volatile("s_waitcnt lgkmcnt(0)" ::: "memory");
    }
    store_o((bf16_t*)(ws + WS_H) + (size_t)row * DM + head * 64, o, hi);
}

__device__ __forceinline__ void fox_unit(unsigned char* ws, int bh, int qt, int lane) {
    const int hi = lane >> 5, c = lane & 31, b = bh >> 2, h = bh & 3;
    const int t = qt * 32 + c, row = b * SEQ + t;
    bf16x8 qf[4];
    load_q(qf, (const bf16_t*)(ws + WS_FOXQ) + (size_t)row * 256 + h * 64, hi);
    const bf16_t* K = (const bf16_t*)(ws + WS_FOXK) + (size_t)bh * SEQ * 64;
    const bf16_t* Vt = (const bf16_t*)(ws + WS_FOXVT) + (size_t)bh * 64 * SEQ;
    const float* F2 = (const float*)(ws + WS_FCUM) + (size_t)bh * SEQ;
    const float Fq2 = F2[t];
    f32x16 o[2]; float m = NEG_INF, l = 0.f;
#pragma unroll
    for (int r = 0; r < 16; ++r) { o[0][r] = 0.f; o[1][r] = 0.f; }
    const int jmax = (qt * 32 + 31) >> 6;
    flash_loop<2>(o, m, l, qf, K, Vt, 0, jmax, t, qt * 32, qt * 32 + 31, [&](int) { return true; }, F2, Fq2, lane);
    l += __shfl_xor(l, 32);
    const float sc = 1.0f / fmaxf(l, 1e-30f);
#pragma unroll
    for (int r = 0; r < 16; ++r) { o[0][r] *= sc; o[1][r] *= sc; }
    store_o((bf16_t*)(ws + WS_H) + (size_t)row * DM + 512 + h * 64, o, hi);
}

__device__ __forceinline__ void moba_unit(unsigned char* ws, int bh, int qt, int lane) {
    const int hi = lane >> 5, c = lane & 31, b = bh >> 2, h = bh & 3;
    const int t = qt * 32 + c, row = b * SEQ + t;
    bf16x8 qf[4];
    load_q(qf, (const bf16_t*)(ws + WS_MOBAQ) + (size_t)row * 256 + h * 64, hi);
    const bf16_t* K = (const bf16_t*)(ws + WS_MOBAK) + (size_t)bh * SEQ * 64;
    const bf16_t* Vt = (const bf16_t*)(ws + WS_MOBAVT) + (size_t)bh * 64 * SEQ;
    const int own = (qt * 32) >> 8;
    unsigned sel = 0u;
    {
        float gt[7];
        const float* km = (const float*)(ws + WS_KMEAN) + (size_t)bh * 8 * 64;
#pragma unroll
        for (int blk = 0; blk < 7; ++blk) {
            float a = 0.f;
            if (blk < own) {
#pragma unroll
                for (int d0 = 0; d0 < 4; ++d0) {
                    const f32x4 k0 = *(const f32x4*)(km + blk * 64 + 16 * d0 + 8 * hi), k1 = *(const f32x4*)(km + blk * 64 + 16 * d0 + 8 * hi + 4);
#pragma unroll
                    for (int i = 0; i < 4; ++i) { a += bf2f(qf[d0][i]) * k0[i]; a += bf2f(qf[d0][4 + i]) * k1[i]; }
                }
                a += __shfl_xor(a, 32);
            }
            gt[blk] = a;
        }
#pragma unroll
        for (int it = 0; it < 3; ++it) {
            float bv = NEG_INF; int bj = -1;
#pragma unroll
            for (int blk = 0; blk < 7; ++blk) { const bool cand = (blk < own) && !((sel >> blk) & 1u) && (gt[blk] > bv); if (cand) { bv = gt[blk]; bj = blk; } }
            if (bj >= 0) sel |= 1u << bj;
        }
    }
    f32x16 o[2]; float m = NEG_INF, l = 0.f;
#pragma unroll
    for (int r = 0; r < 16; ++r) { o[0][r] = 0.f; o[1][r] = 0.f; }
    const int jmax = (qt * 32 + 31) >> 6;
    flash_loop<0>(o, m, l, qf, K, Vt, 0, jmax, t, qt * 32, qt * 32 + 31, [&](int j) { const int blk = j >> 2; return (blk == own) || (bool)((sel >> blk) & 1u); }, nullptr, 0.f, lane);
    l += __shfl_xor(l, 32);
    const float sc = 1.0f / fmaxf(l, 1e-30f);
#pragma unroll
    for (int r = 0; r < 16; ++r) { o[0][r] *= sc; o[1][r] *= sc; }
    store_o((bf16_t*)(ws + WS_H) + (size_t)row * DM + 768 + h * 64, o, hi);
}


#define XB_TMO      128
#define XB_XCNT(j)  (256  + 64 * (j))
#define XB_XSUB(j)  (1280 + 64 * (j))
#define XB_XGEN(j)  (2304 + 64 * (j))
#define XB_TOP      3328
#define XB_TOPGEN   3392
#define XCD_BAR_WORDS 3456
#define XB_SPIN_CAP (1u << 22)
__device__ __forceinline__ unsigned xb_ld(unsigned* p)              { return __hip_atomic_load(p, __ATOMIC_RELAXED, __HIP_MEMORY_SCOPE_AGENT); }
__device__ __forceinline__ unsigned xb_add(unsigned* p, unsigned v) { return __hip_atomic_fetch_add(p, v, __ATOMIC_RELAXED, __HIP_MEMORY_SCOPE_AGENT); }
__device__ __forceinline__ unsigned xb_xcc_id() { return (unsigned)__builtin_amdgcn_s_getreg((3 << 11) | 20) & 0xFu; }
#define XB_SPIN(cond, bar) do { unsigned _sp = 0; while (cond) { __builtin_amdgcn_s_sleep(1); \
    if ((++_sp & 255u) == 0u) { if (xb_ld(&(bar)[XB_TMO])) break; if (_sp > XB_SPIN_CAP) { atomicAdd(&(bar)[XB_TMO], 1u); break; } } } } while (0)
__device__ __forceinline__ void xcd_barrier_post(unsigned* bar, unsigned x, volatile LAS unsigned* st) {
    if (threadIdx.x == 0) st[2] = xb_add(&bar[XB_XCNT(x)], 1u);
}
__device__ __forceinline__ void xcd_barrier_complete(unsigned* bar, unsigned x, unsigned& nloc, unsigned& nx) {
    const unsigned G = gridDim.x * gridDim.y * gridDim.z;
    unsigned sum, cnt, mine, sp = 0u;
    for (;;) {
        sum = 0u; cnt = 0u; mine = 0u;
#pragma unroll
        for (unsigned j = 0; j < 16; ++j) { const unsigned c = xb_ld(&bar[XB_XCNT(j)]); sum += c; cnt += (c > 0u) ? 1u : 0u; mine = (j == x) ? c : mine; }
        if (sum == G) break;
        __builtin_amdgcn_s_sleep(1);
        if ((++sp & 255u) == 0u) { if (xb_ld(&bar[XB_TMO])) break; if (sp > XB_SPIN_CAP) { atomicAdd(&bar[XB_TMO], 1u); break; } }
    }
    nloc = mine > 0u ? mine : 1u; nx = cnt > 0u ? cnt : 1u;
}
__device__ __forceinline__ void xcd_barrier(unsigned* bar_, unsigned x_, volatile LAS unsigned* st, bool leader) {
    asm volatile("s_waitcnt vmcnt(0)" ::: "memory");
    __syncthreads();
    if (leader) {
        size_t zo = 0; unsigned x = x_;
        asm volatile("" : "+s"(zo), "+s"(x));
        unsigned* bar = bar_ + zo;
        __builtin_amdgcn_s_waitcnt(0);
        unsigned nloc = st[0], nx = st[1];
        if (nloc == 0u) { xcd_barrier_complete(bar, x, nloc, nx); st[0] = nloc; st[1] = nx; }
        const unsigned old = xb_add(&bar[XB_XSUB(x)], 1u);
        const unsigned gen = old / nloc;
        if (old + 1u == (gen + 1u) * nloc) {
            __builtin_amdgcn_fence(__ATOMIC_RELEASE, "agent");
            asm volatile("s_waitcnt vmcnt(0)" ::: "memory");
            const unsigned og = xb_add(&bar[XB_TOP], 1u);
            const unsigned tg = og / nx;
            if (og + 1u == (tg + 1u) * nx) xb_add(&bar[XB_TOPGEN], 1u);
            else XB_SPIN(xb_ld(&bar[XB_TOPGEN]) == tg, bar);
            __builtin_amdgcn_fence(__ATOMIC_ACQUIRE, "agent");
            xb_add(&bar[XB_XGEN(x)], 1u);
            asm volatile("s_waitcnt vmcnt(0)" ::: "memory");
        } else {
            XB_SPIN(xb_ld(&bar[XB_XGEN(x)]) == gen, bar);
            __builtin_amdgcn_fence(__ATOMIC_ACQUIRE, "agent");
            asm volatile("s_waitcnt vmcnt(0)" ::: "memory");
        }
    }
    __syncthreads();
}

__device__ __forceinline__ int map_identity(int n) { return n; }
__device__ __forceinline__ int map_w13(int n) { const int tile = n >> 8, w = n & 255; return (w < 128) ? tile * 128 + w : FF + tile * 128 + (w - 128); }
__device__ __forceinline__ int map_win(int n) {
    if (n < 640) return n;
    if (n < 768) return n - 640 + 768;
    if (n < 896) return n - 768 + 1024;
    if (n < 1152) return n - 896 + 1304;
    if (n < 1408) return n - 1152 + 1560;
    if (n < 1664) return n - 1408 + 2076;
    if (n < 1920) return n - 1664 + 2332;
    if (n < 2048) return n - 1920 + 640;
    if (n < 2176) return n - 2048 + 896;
    if (n < 2304) return n - 2176 + 1152;
    if (n < 2560) return n - 2304 + 1816;
    if (n < 2816) return n - 2560 + 2588;
    if (n < 2840) return n - 2816 + 1280;
    if (n < 2844) return n - 2840 + 2072;
    return -1;
}
template <int MAP>
__device__ __forceinline__ void transpose_item(const float* W, int K, int Nsrc, int Ndst, bf16_t* WT, float* scr, int item, int lane) {
    const int nblk = Ndst / 64, kb = item / nblk, nb = item % nblk, k0 = 64 * kb, n0 = 64 * nb;
    const int nq = (lane & 15) * 4, nd = n0 + nq;
    const int src = (MAP == 0) ? map_identity(nd) : (MAP == 1) ? map_w13(nd) : map_win(nd);
    f32x4 v[16];
#pragma unroll
    for (int i = 0; i < 16; ++i) { const int kk = 4 * i + (lane >> 4); v[i] = (src >= 0) ? *(const f32x4*)(W + (size_t)(k0 + kk) * Nsrc + src) : (f32x4){0.f, 0.f, 0.f, 0.f}; }
#pragma unroll
    for (int i = 0; i < 16; ++i) { const int kk = 4 * i + (lane >> 4); float* d = scr + kk * 65 + nq; d[0] = v[i][0]; d[1] = v[i][1]; d[2] = v[i][2]; d[3] = v[i][3]; }
    asm volatile("s_waitcnt lgkmcnt(0)" ::: "memory");
    const int cc = lane & 7;
#pragma unroll
    for (int j = 0; j < 8; ++j) { const int n = (lane >> 3) + 8 * j; const float* sp = scr + (8 * cc) * 65 + n;
        u32x4 ov; ov.x = cvtpk(sp[0 * 65], sp[1 * 65]); ov.y = cvtpk(sp[2 * 65], sp[3 * 65]); ov.z = cvtpk(sp[4 * 65], sp[5 * 65]); ov.w = cvtpk(sp[6 * 65], sp[7 * 65]);
        *(u32x4*)(WT + (size_t)(n0 + n) * K + k0 + 8 * cc) = ov; }
    asm volatile("s_waitcnt lgkmcnt(0)" ::: "memory");
}
__device__ __forceinline__ void sincos_acc(float ang, float& sn, float& cs) {
    const double a = (double)ang;
    const double k = __builtin_rint(a * 0.15915494309189535);
    const double r = (a - k * 6.283185307179586) * 0.25;
    const double r2 = r * r;
    double s = r * (1.0 + r2 * (-1.0 / 6 + r2 * (1.0 / 120 + r2 * (-1.0 / 5040 + r2 * (1.0 / 362880 + r2 * (-1.0 / 39916800 + r2 * (1.0 / 6227020800.0)))))));
    double c = 1.0 + r2 * (-0.5 + r2 * (1.0 / 24 + r2 * (-1.0 / 720 + r2 * (1.0 / 40320 + r2 * (-1.0 / 3628800 + r2 * (1.0 / 479001600.0))))));
    double s2 = 2.0 * s * c, c2 = c * c - s * s;
    double s4 = 2.0 * s2 * c2, c4 = c2 * c2 - s2 * s2;
    sn = (float)s4; cs = (float)c4;
}

struct Params {
    const float* x; const float* c; const int* positions; const float* norm_g; const float* w_ada; const float* b_ada; const float* w_in; const float* fox_fbias;
    const float* cmp_pos; const float* cmp_w1; const float* cmp_w2; const float* w_out; const float* ffn_w13; const float* ffn_w2; const float* final_g;
    float* out; unsigned char* ws;
};

__device__ __forceinline__ void prologue(const Params& P, unsigned char* lds, int tid, int lane, int wave, int G) {
    unsigned char* ws = P.ws;
    float* cact = (float*)lds;
    float* part = (float*)(lds + 65536);
    for (int i = tid; i < NB * DM; i += 512) { const float v = P.c[i]; cact[i] = v / (1.0f + __expf(-v)); }
    __syncthreads();
    float* MOD = (float*)(ws + WS_MOD);
    for (int item = blockIdx.x; item < DEPTH * 64; item += G) {
        const int l = item >> 6, jb = (item & 63) * 144, j0 = jb + 4 * lane;
        const bool act = lane < 36;
        const float* wp = P.w_ada + (size_t)l * DM * NADA + (act ? j0 : jb);
        f32x4 acc4[16];
#pragma unroll
        for (int b = 0; b < 16; ++b) acc4[b] = (f32x4){0.f, 0.f, 0.f, 0.f};
        const int kbeg = wave * 128;
#pragma unroll 4
        for (int k = kbeg; k < kbeg + 128; ++k) {
            const f32x4 w = *(const f32x4*)(wp + (size_t)k * NADA);
#pragma unroll
            for (int b = 0; b < 16; ++b) acc4[b] += w * cact[b * DM + k];
        }
        if (act) {
#pragma unroll
            for (int b = 0; b < 16; ++b) *(f32x4*)(part + (wave * 16 + b) * 144 + 4 * lane) = acc4[b];
        }
        __syncthreads();
        for (int o = tid; o < 16 * 144; o += 512) {
            const int b = o / 144, col = o % 144;
            float sm = 0.f;
#pragma unroll
            for (int w = 0; w < 8; ++w) sm += part[(w * 16 + b) * 144 + col];
            const int j = jb + col;
            MOD[((size_t)l * NB + b) * NADA + j] = sm + P.b_ada[(size_t)l * NADA + j];
        }
        __syncthreads();
    }
    float* scr = (float*)(lds + wave * 16640);
    const int gw = blockIdx.x * NWAVES + wave, NGW = G * NWAVES;
    constexpr int I_WIN = 16 * 48, I_WOUT = 16 * 16, I_CW1 = 32 * 4, I_W13 = 16 * 88, I_W2 = 44 * 16, I_CW2 = 4 * 1;
    constexpr int T_WIN = 4 * I_WIN, T_WOUT = 4 * I_WOUT, T_CW1 = 8 * I_CW1, T_W13 = 8 * I_W13, T_W2 = 8 * I_W2, T_CW2 = 8 * I_CW2;
    constexpr int NITEMS = T_WIN + T_WOUT + T_CW1 + T_W13 + T_W2 + T_CW2;
    for (int it = gw; it < NITEMS; it += NGW) {
        int r = it;
        if (r < T_W13) { const int q = r / I_W13; transpose_item<1>(P.ffn_w13 + (size_t)q * DM * 2 * FF, DM, 2 * FF, 2 * FF, (bf16_t*)(ws + WS_W13) + (size_t)q * 2 * FF * DM, scr, r % I_W13, lane); continue; } r -= T_W13;
        if (r < T_W2) { const int q = r / I_W2; transpose_item<0>(P.ffn_w2 + (size_t)q * FF * DM, FF, DM, DM, (bf16_t*)(ws + WS_W2) + (size_t)q * DM * FF, scr, r % I_W2, lane); continue; } r -= T_W2;
        if (r < T_WIN) { const int q = r / I_WIN; transpose_item<2>(P.w_in + (size_t)q * DM * 2844, DM, 2844, NIN, (bf16_t*)(ws + WS_WIN) + (size_t)q * NIN * DM, scr, r % I_WIN, lane); continue; } r -= T_WIN;
        if (r < T_WOUT) { const int q = r / I_WOUT; transpose_item<0>(P.w_out + (size_t)q * DM * DM, DM, DM, DM, (bf16_t*)(ws + WS_WOUT) + (size_t)q * DM * DM, scr, r % I_WOUT, lane); continue; } r -= T_WOUT;
        if (r < T_CW1) { const int q = r / I_CW1; transpose_item<0>(P.cmp_w1 + (size_t)q * 2048 * 256, 2048, 256, 256, (bf16_t*)(ws + WS_CW1) + (size_t)q * 256 * 2048, scr, r % I_CW1, lane); continue; } r -= T_CW1;
        { const int q = r / I_CW2; transpose_item<0>(P.cmp_w2 + (size_t)q * 256 * 64, 256, 64, 64, (bf16_t*)(ws + WS_CW2T) + (size_t)q * 64 * 256, scr, r % I_CW2, lane); }
    }
    {
        float* cosT = (float*)(ws + WS_COS); float* sinT = (float*)(ws + WS_SIN);
        for (int e = blockIdx.x * 512 + tid; e < NTOK * 8; e += G * 512) {
            const int i = e & 7;
            const float inv = (i == 0) ? 1.0f : (i == 1) ? 0.1939227432012558f : (i == 2) ? 0.03760603070259094f : (i == 3) ? 0.007292664609849453f :
                              (i == 4) ? 0.0014142135623842478f : (i == 5) ? 0.00027424818836152554f : (i == 6) ? 5.318296098266728e-05f : 1.0313386155758053e-05f;
            const float ang = (float)P.positions[e >> 3] * inv;
            float sn, cs; sincos_acc(ang, sn, cs);
            cosT[e] = cs; sinT[e] = sn;
        }
    }
}

__device__ __forceinline__ void norm_phase(const float* xin, const float* g, const float* mod  , bf16_t* H, int lane, int wave, int G) {
    const int gw = blockIdx.x * NWAVES + wave, NGW = G * NWAVES;
    for (int row = gw; row < NTOK; row += NGW) {
        const int b = row >> 11;
        const f32x4* xr = (const f32x4*)(xin + (size_t)row * DM) + lane;
        f32x4 v[4]; float s = 0.f;
#pragma unroll
        for (int j = 0; j < 4; ++j) { v[j] = xr[64 * j]; s += (v[j].x * v[j].x + v[j].y * v[j].y) + (v[j].z * v[j].z + v[j].w * v[j].w); }
        const float rstd = 1.0f / sqrtf(wave_sum(s) * (1.0f / DM) + 1e-6f);
        const f32x4* gr = (const f32x4*)g + lane;
        const f32x4* sh = (const f32x4*)(mod + (size_t)b * NADA) + lane;
        const f32x4* sc = (const f32x4*)(mod + (size_t)b * NADA + DM) + lane;
        u32x2* o8 = (u32x2*)(H + (size_t)row * DM) + lane;
#pragma unroll
        for (int j = 0; j < 4; ++j) {
            const f32x4 gg = gr[64 * j], s1 = sc[64 * j] + 1.0f, s0 = sh[64 * j];
            const f32x4 y = v[j] * rstd * gg * s1 + s0;
            u32x2 w; w.x = cvtpk(y.x, y.y); w.y = cvtpk(y.z, y.w);
            o8[64 * j] = w;
        }
    }
}
__device__ __forceinline__ void final_norm(float* x, const float* g, int lane, int wave, int G) {
    const int gw = blockIdx.x * NWAVES + wave, NGW = G * NWAVES;
    for (int row = gw; row < NTOK; row += NGW) {
        f32x4* xr = (f32x4*)(x + (size_t)row * DM) + lane;
        f32x4 v[4]; float s = 0.f;
#pragma unroll
        for (int j = 0; j < 4; ++j) { v[j] = xr[64 * j]; s += (v[j].x * v[j].x + v[j].y * v[j].y) + (v[j].z * v[j].z + v[j].w * v[j].w); }
        const float rstd = 1.0f / sqrtf(wave_sum(s) * (1.0f / DM) + 1e-6f);
        const f32x4* gr = (const f32x4*)g + lane;
#pragma unroll
        for (int j = 0; j < 4; ++j) xr[64 * j] = v[j] * rstd * gr[64 * j];
    }
}

__global__ void __launch_bounds__(512, 2) fwd_megakernel(Params P) {
    extern __shared__ __attribute__((aligned(16))) unsigned char lds[];
    cg::grid_group grid = cg::this_grid();
    const int tid = threadIdx.x, lane = tid & 63, wave = __builtin_amdgcn_readfirstlane(tid >> 6), wave0 = wave;
    const int G = gridDim.x;
    unsigned char* ws = P.ws;
    LAS unsigned char* lds3 = (LAS unsigned char*)lds;
    const float* MOD = (const float*)(ws + WS_MOD);
    unsigned* ctl = (unsigned*)(ws + WS_CTL);

    volatile LAS unsigned* bst = (volatile LAS unsigned*)(lds3 + LDS_BYTES - 64);
    if (tid == 0) { bst[0] = 0u; bst[1] = 0u; }
    __syncthreads();
    const unsigned xcc = (unsigned)__builtin_amdgcn_readfirstlane((int)xb_xcc_id());
    xcd_barrier_post(ctl + 65536, xcc, bst);
    const bool leader = (tid == 0);
#define GRID_BAR() xcd_barrier((unsigned*)(P.ws + WS_CTL) + 65536, xcc, bst, leader)
    prologue(P, lds, tid, lane, wave, G);
    if (P.ws == nullptr) grid.sync();
    GRID_BAR();
    if (tid == 0) {
        bool ok = ((G & 7) == 0);
        for (unsigned j = 0; j < 16; ++j) { const unsigned cnt = xb_ld(ctl + 65536 + XB_XCNT(j)); ok = ok && (cnt == ((j < 8u) ? (unsigned)(G >> 3) : 0u)); }
        bst[3] = ok ? (bst[2] * 8u + xcc) : (unsigned)blockIdx.x;
    }
    __syncthreads();
    const int vbid = __builtin_amdgcn_readfirstlane((int)bst[3]);
#ifdef PROBE_SYNC20
    for (int i = 0; i < 20; ++i) GRID_BAR();
#endif
    {
        const int ln = fresh_lane(), wv = wave0;
        for (int it = blockIdx.x * NWAVES + wv; it < 8 * 256; it += G * NWAVES) {
            const int lm = it >> 8;
            const bf16_t* wr_ = (const bf16_t*)(ws + WS_CW1) + (size_t)it * 2048 + ln * 32;
            const float* pp = P.cmp_pos + (size_t)lm * 2048 + ln * 32;
            float a = 0.f;
#pragma unroll
            for (int j = 0; j < 4; ++j) {
                const bf16x8 wv8 = *(const bf16x8*)(wr_ + 8 * j);
                const f32x4 p0 = *(const f32x4*)(pp + 8 * j), p1 = *(const f32x4*)(pp + 8 * j + 4);
#pragma unroll
                for (int i = 0; i < 4; ++i) { a += p0[i] * bf2f(wv8[i]); a += p1[i] * bf2f(wv8[4 + i]); }
            }
            a = wave_sum(a);
            if (ln == 0) ((float*)(ws + WS_B1))[it] = a;
        }
    }

    const float* xin = P.x;
    for (int l = 0; l < DEPTH; ++l) {
        const float* modl = MOD + (size_t)l * NB * NADA;
        for (int sub = 0; sub < 3; ++sub) {
            unsigned char* ws = launder_p(P.ws);
            const int bid = launder_i(vbid);
            const int lane = fresh_lane(), wave = wave0;
            norm_phase(xin, P.norm_g + ((size_t)l * 3 + sub) * DM, modl + (size_t)sub * 3 * DM, (bf16_t*)(ws + WS_H), lane, wave, G);
            GRID_BAR();
            if (sub != 1) {
                const int s = (sub == 0) ? 0 : 1;
                {
                    pg8::Gemm g{(const bf16_t*)(ws + WS_H), (const bf16_t*)(ws + WS_W13) + (size_t)(l * 2 + s) * 2 * FF * DM, NTOK, 2 * FF, DM, DM};
                    pg8::StaticOrder S; S.init(NTOK, 2 * FF, G, bid);
                    EpiSwiglu E{(bf16_t*)(ws + WS_BIG)};
#ifndef NO_G1
                    pg8::gemm_phase<EpiSwiglu, true>(lds3, g, S, E, wave0);
#endif
#ifdef PROBE_G1X2
                    pg8::gemm_phase<EpiSwiglu, true>(lds3, g, S, E, wave0);
#endif
                }
                GRID_BAR();
                {
                    pg8::Gemm g{(const bf16_t*)(ws + WS_BIG), (const bf16_t*)(ws + WS_W2) + (size_t)(l * 2 + s) * DM * FF, NTOK, DM, FF, FF};
                    pg8::StaticOrder S; S.init(NTOK, DM, G, bid);
                    EpiResid E{xin, P.out, modl + (size_t)(sub * 3 + 2) * DM, 0.5f};
#ifndef NO_G2
                    pg8::gemm_phase<EpiResid, true>(lds3, g, S, E, wave0);
#endif
                }
                xin = P.out;
                GRID_BAR();
            } else {
                {
                    pg8::Gemm g{(const bf16_t*)(ws + WS_H), (const bf16_t*)(ws + WS_WIN) + (size_t)l * NIN * DM, NTOK, NIN, DM, DM};
                    pg8::StaticOrder S; S.init(NTOK, NIN, G, bid);
                    EpiInProj E{ws, P.fox_fbias + l * 4};
#ifndef NO_INPROJ
                    pg8::gemm_phase<EpiInProj, true>(lds3, g, S, E, wave0);
#endif
                }
                GRID_BAR();
                if (bid < 32) {
                    const int mat = bid >> 4;
                    pg8::Gemm g{(const bf16_t*)(ws + (mat ? WS_VC : WS_KC)), (const bf16_t*)(ws + WS_CW1) + (size_t)(l * 2 + mat) * 256 * 2048, 4096, 256, 2048, 1024};
                    pg8::StaticOrder S; S.init(4096, 256, 16, bid & 15);
                    EpiGelu E{(bf16_t*)(ws + WS_CMPHID) + (size_t)mat * 4096 * 256, (const float*)(ws + WS_B1) + (l * 2 + mat) * 256};
#ifndef NO_CMP1
                    pg8::gemm_phase<EpiGelu, true>(lds3, g, S, E, wave0);
#endif
                } else {
                    const int nw = (G - 32) * NWAVES;
                    for (int it = (bid - 32) * NWAVES + wave; it < 64 + 512; it += nw) {
                        if (it < 64) {
                            const float* src = (const float*)(ws + WS_FLOG) + (size_t)it * SEQ + lane * 32;
                            float v[32];
#pragma unroll
                            for (int j = 0; j < 8; ++j) { const f32x4 q = *(const f32x4*)(src + 4 * j); v[4 * j] = q.x; v[4 * j + 1] = q.y; v[4 * j + 2] = q.z; v[4 * j + 3] = q.w; }
#pragma unroll
                            for (int j = 1; j < 32; ++j) v[j] += v[j - 1];
                            float tot = v[31], inc = tot;
#pragma unroll
                            for (int o = 1; o < 64; o <<= 1) { const float n = __shfl_up(inc, o); if (lane >= o) inc += n; }
                            const float excl = inc - tot;
                            float* dst = (float*)(ws + WS_FCUM) + (size_t)it * SEQ + lane * 32;
#pragma unroll
                            for (int j = 0; j < 8; ++j) { f32x4 q; q.x = (v[4 * j] + excl) * 8.0f; q.y = (v[4 * j + 1] + excl) * 8.0f; q.z = (v[4 * j + 2] + excl) * 8.0f; q.w = (v[4 * j + 3] + excl) * 8.0f; *(f32x4*)(dst + 4 * j) = q; }
                        } else {
                            const int id = it - 64;
                            const bf16_t* kp = (const bf16_t*)(ws + WS_MOBAK) + (size_t)id * 256 * 64 + (((lane >> 4) * 64 + ((lane >> 3) & 1) * 32) * 8 + (lane & 7));
                            float a = 0.f;
#pragma unroll 8
                            for (int k = 0; k < 256; ++k) a += bf2f((short)kp[(size_t)(k >> 6) * 4096 + (((k >> 5) & 1) * 4 * 64 + (k & 31)) * 8]);
                            ((float*)(ws + WS_KMEAN))[(size_t)id * 64 + lane] = a * (1.0f / 256.0f);
                        }
                    }
                }
                GRID_BAR();
                for (int it = bid * NWAVES + wave; it < 256; it += G * NWAVES) {
                    const int mat = it >> 7, rt = it & 127, hi = lane >> 5, c = lane & 31;
                    const bf16_t* A = (const bf16_t*)(ws + WS_CMPHID) + ((size_t)mat * 4096 + rt * 32 + c) * 256 + 8 * hi;
                    const bf16_t* Bt = (const bf16_t*)(ws + WS_CW2T) + (size_t)(l * 2 + mat) * 64 * 256 + (size_t)c * 256 + 8 * hi;
                    f32x16 a0, a1;
#pragma unroll
                    for (int r = 0; r < 16; ++r) { a0[r] = 0.f; a1[r] = 0.f; }
#pragma unroll 4
                    for (int ks = 0; ks < 16; ++ks) {
                        const bf16x8 af = *(const bf16x8*)(A + 16 * ks);
                        const bf16x8 b0 = *(const bf16x8*)(Bt + 16 * ks), b1 = *(const bf16x8*)(Bt + 32 * 256 + 16 * ks);
                        a0 = MFMA32(af, b0, a0); a1 = MFMA32(af, b1, a1);
                    }
#pragma unroll
                    for (int r = 0; r < 16; ++r) {
                        const int row = rt * 32 + crow(r, hi), rl = row & 127, bg = row >> 7;
                        const float v0 = (rl == 127) ? 0.f : a0[r], v1 = (rl == 127) ? 0.f : a1[r];
                        const bf16_t h0 = (bf16_t)(cvtpk(v0, 0.f) & 0xffffu), h1 = (bf16_t)(cvtpk(v1, 0.f) & 0xffffu);
                        if (mat == 0) {
                            bf16_t* kc = (bf16_t*)(ws + WS_KCMP) + (size_t)bg * 8192 + (rl >> 6) * 4096 + ((((rl >> 5) & 1) * 4) * 64 + (rl & 31)) * 8;
                            const int o0 = ((c >> 4) * 64 + ((c >> 3) & 1) * 32) * 8 + (c & 7);
                            kc[o0] = h0; kc[o0 + 2 * 64 * 8] = h1;
                        } else {
                            const int tt = rl & 63;
                            bf16_t* vc = (bf16_t*)(ws + WS_VCMPT) + (size_t)bg * 8192 + (rl >> 6) * 4096
                                         + ((((tt >> 5) * 2 + ((tt >> 4) & 1)) * 2) * 64 + ((tt >> 2) & 1) * 32 + c) * 8 + ((tt >> 3) & 1) * 4 + (tt & 3);
                            vc[0] = h0; vc[64 * 8] = h1;
                        }
                    }
                }
                GRID_BAR();
                {
#ifdef PROBE_ATTN2
                  for (int rep = 0; rep < 2; ++rep)
#else
                  const int rep = 0;
#endif
                  {
                    float* wl = (float*)(lds + wave * 16384);
                    const int lane_ = lane;
                    const int myq = (int)(__builtin_amdgcn_s_getreg((3 << 11) | 20) & 7u);
                    for (int qi = 0; qi < 8; ++qi) {
                        const int q = (myq + qi) & 7;
                        unsigned* ctr = ctl + 64 * (1 + (l * 2 + rep) * 8 + q);
                        for (;;) {
                            unsigned u = 0;
                            if (lane_ == 0) u = atomicAdd(ctr, 1u);
                            u = (unsigned)__builtin_amdgcn_readfirstlane((int)u);
                            if (u >= 2048u) break;
                            const int lane = launder_v(lane_);
                            if (u < 1024u) {
                                const int pr = (int)(u >> 9), i = (int)(u & 511u), slot = 63 - (i >> 3), w = i & 7;
                                const int bg = 4 * q + 2 * pr + (w >> 2);
                                nsa_unit(ws, bg >> 1, bg & 1, slot * 4 + (w & 3), lane, wl);
                            } else if (u < 1536u) {
                                const int i = (int)(u - 1024u), hf = i >> 8, slot = 63 - ((i & 255) >> 2);
                                fox_unit(ws, 8 * q + 4 * hf + (i & 3), slot, lane);
                            } else {
                                const int i = (int)(u - 1536u), hf = i >> 8, slot = 63 - ((i & 255) >> 2);
                                moba_unit(ws, 8 * q + 4 * hf + (i & 3), slot, lane);
                            }
                        }
                    }
                  }
                }
                GRID_BAR();
                {
                    pg8::Gemm g{(const bf16_t*)(ws + WS_H), (const bf16_t*)(ws + WS_WOUT) + (size_t)l * DM * DM, NTOK, DM, DM, DM};
                    pg8::StaticOrder S; S.init(NTOK, DM, G, bid);
                    EpiResid E{xin, P.out, modl + (size_t)(1 * 3 + 2) * DM, 1.0f};
#ifndef NO_OUTPROJ
                    pg8::gemm_phase<EpiResid, true>(lds3, g, S, E, wave0);
#endif
                }
                GRID_BAR();
            }
        }
    }
    final_norm(P.out, P.final_g, fresh_lane(), wave0, G);
}

extern "C" void kernel_launch(void* const* d_in, const int* in_sizes, int n_in, void* d_out, int out_size, void* d_ws, size_t ws_size, hipStream_t stream) {
    static int grid_blocks = 0;
    if (grid_blocks == 0) {
        if (n_in != 15 || ws_size < WS_END) { fprintf(stderr, "kernel_launch: unexpected inputs (n_in %d, ws %zu)\n", n_in, ws_size); grid_blocks = -1; return; }
        int dev = 0, cus = 0, per_cu = 0;
        hipGetDevice(&dev);
        hipDeviceGetAttribute(&cus, hipDeviceAttributeMultiprocessorCount, dev);
        if (hipFuncSetAttribute((const void*)fwd_megakernel, hipFuncAttributeMaxDynamicSharedMemorySize, LDS_BYTES) != hipSuccess) fprintf(stderr, "kernel_launch: hipFuncSetAttribute failed\n");
        if (hipOccupancyMaxActiveBlocksPerMultiprocessor(&per_cu, (const void*)fwd_megakernel, 512, LDS_BYTES) != hipSuccess || per_cu < 1) { fprintf(stderr, "kernel_launch: occupancy query gave %d\n", per_cu); per_cu = 1; }
        (void)hipGetLastError();
        grid_blocks = cus * per_cu;
        if (grid_blocks > 256) grid_blocks = 256;
    }
    if (grid_blocks < 0) return;
    hipMemsetAsync((char*)d_ws + WS_CTL, 0, 1 * MiB, stream);
    Params p{};
    p.x = (const float*)d_in[0]; p.c = (const float*)d_in[1]; p.positions = (const int*)d_in[2]; p.norm_g = (const float*)d_in[3];
    p.w_ada = (const float*)d_in[4]; p.b_ada = (const float*)d_in[5]; p.w_in = (const float*)d_in[6]; p.fox_fbias = (const float*)d_in[7];
    p.cmp_pos = (const float*)d_in[8]; p.cmp_w1 = (const float*)d_in[9]; p.cmp_w2 = (const float*)d_in[10]; p.w_out = (const float*)d_in[11];
    p.ffn_w13 = (const float*)d_in[12]; p.ffn_w2 = (const float*)d_in[13]; p.final_g = (const float*)d_in[14];
    p.out = (float*)d_out; p.ws = (unsigned char*)d_ws;
    void* args[] = {&p};
    hipError_t e = hipLaunchCooperativeKernel((const void*)fwd_megakernel, dim3(grid_blocks), dim3(512), args, LDS_BYTES, stream);
    if (e != hipSuccess) fprintf(stderr, "kernel_launch: cooperative launch failed: %s (grid %d)\n", hipGetErrorString(e), grid_blocks);
}
```

```cpp
#include <hip/hip_runtime.h>
#include <hip/hip_cooperative_groups.h>
#include <cstdio>
#include <cstdint>
namespace cg = cooperative_groups;

#define LAS __attribute__((address_space(3)))
typedef unsigned short bf16_t;
typedef short bf16x8 __attribute__((ext_vector_type(8)));
typedef short s16x4 __attribute__((ext_vector_type(4)));
typedef float f32x4 __attribute__((ext_vector_type(4)));
typedef float f32x2 __attribute__((ext_vector_type(2)));
typedef float f32x16 __attribute__((ext_vector_type(16)));
typedef unsigned u32x4 __attribute__((ext_vector_type(4)));
typedef unsigned u32x2 __attribute__((ext_vector_type(2)));
typedef __bf16 bf16x2_t __attribute__((ext_vector_type(2)));

constexpr int NB = 16, SEQ = 2048, DM = 1024, NTOK = NB * SEQ, DEPTH = 4, FF = 2816, NIN = 3072, NADA = 9216;
constexpr float LOG2E = 1.4426950408889634f;
constexpr float QK_C2 = 0.125f * LOG2E;
constexpr float NEG_INF = -__builtin_inff();

constexpr size_t MiB = 1u << 20;
constexpr size_t WS_CTL = 0;
constexpr size_t WS_B1 = 4 * MiB;
constexpr size_t WS_MOD = 1 * MiB;
constexpr size_t WS_COS = 5 * MiB, WS_SIN = 6 * MiB;
constexpr size_t WS_CW2T = 7 * MiB;
constexpr size_t WS_WIN = 8 * MiB;
constexpr size_t WS_WOUT = 32 * MiB;
constexpr size_t WS_CW1 = 40 * MiB;
constexpr size_t WS_W13 = 48 * MiB;
constexpr size_t WS_W2 = 136 * MiB;
constexpr size_t WS_H = 180 * MiB;
constexpr size_t WS_BIG = 244 * MiB;
constexpr size_t WS_QNSA = 244 * MiB;
constexpr size_t WS_KC = 276 * MiB;
constexpr size_t WS_VC = 285 * MiB;
constexpr size_t WS_KS = 294 * MiB, WS_KW = 302 * MiB;
constexpr size_t WS_FOXQ = 310 * MiB;
constexpr size_t WS_FOXK = 326 * MiB;
constexpr size_t WS_MOBAQ = 342 * MiB, WS_MOBAK = 358 * MiB;
constexpr size_t WS_VST = 374 * MiB, WS_VWT = 382 * MiB;
constexpr size_t WS_FOXVT = 390 * MiB, WS_MOBAVT = 406 * MiB;
constexpr size_t WS_GATES = 422 * MiB;
constexpr size_t WS_FLOG = 425 * MiB;
constexpr size_t WS_FCUM = 426 * MiB;
constexpr size_t WS_KMEAN = 427 * MiB;
constexpr size_t WS_CMPHID = 428 * MiB;
constexpr size_t WS_KCMP = 432 * MiB;
constexpr size_t WS_VCMPT = 433 * MiB;
constexpr size_t WS_END = 436 * MiB;

constexpr int RING_BYTES = 131072;
constexpr int LDS_BYTES = 147456;
constexpr int NWAVES = 8;

__device__ __forceinline__ unsigned cvtpk(float lo, float hi) { f32x2 v = {lo, hi}; bf16x2_t b = __builtin_convertvector(v, bf16x2_t); return __builtin_bit_cast(unsigned, b); }
__device__ __forceinline__ float bf2f(short s) { return __uint_as_float(((unsigned)(unsigned short)s) << 16); }
__device__ __forceinline__ float fast_exp2(float x) { return __builtin_amdgcn_exp2f(x); }
__device__ __forceinline__ float fast_rcp(float x) { return __builtin_amdgcn_rcpf(x); }
__device__ __forceinline__ float silu_f(float a) { return a * fast_rcp(1.0f + fast_exp2(-a * LOG2E)); }
__device__ __forceinline__ float sigmoid_f(float a) { return 1.0f / (1.0f + __expf(-a)); }
__device__ __forceinline__ float gelu_tanh(float x) {
    const float u = 0.7978845608028654f * (x + 0.044715f * x * x * x);
    const float e = fast_exp2(2.0f * LOG2E * u);
    const float th = 1.0f - 2.0f * fast_rcp(e + 1.0f);
    return 0.5f * x * (1.0f + th);
}
__device__ __forceinline__ float wave_sum(float v) {
#pragma unroll
    for (int o = 1; o < 64; o <<= 1) v += __shfl_xor(v, o);
    return v;
}
__device__ __forceinline__ unsigned char* launder_p(unsigned char* p) { size_t z = 0; asm volatile("" : "+s"(z)); return p + z; }
__device__ __forceinline__ int launder_i(int v) { asm volatile("" : "+s"(v)); return v; }
__device__ __forceinline__ int launder_v(int v) { asm volatile("" : "+v"(v)); return v; }
__device__ __forceinline__ int fresh_lane() { unsigned m = ~0u; asm volatile("" : "+s"(m)); return (int)__builtin_amdgcn_mbcnt_hi(m, __builtin_amdgcn_mbcnt_lo(m, 0u)); }
__device__ __forceinline__ int crow(int r, int hi) { return (r & 3) + 8 * (r >> 2) + 4 * hi; }

namespace pg8 {
constexpr int BM = 256, BK = 64, HALF = 128, HTB = HALF * BK * 2, STAGE_BYTES = 8 * HTB, NXCD = 8, WGM = 8;
__host__ __device__ __forceinline__ int lds_byte(int r, int c) { const int st = (r >> 4) * 2 + (c >> 5), rr = r & 15, cc = c & 31, ob = rr * 64 + cc * 2; return st * 1024 + (ob ^ (((ob >> 9) & 1) << 5)); }
__host__ __device__ __forceinline__ void stage_rc(int b, int& R, int& C) { const int st = b / 1024, sb = b % 1024, swz = sb ^ (((sb >> 9) & 1) << 5); R = (st >> 1) * 16 + swz / 64; C = (st & 1) * 32 + (swz % 64) / 2; }
__host__ __device__ __forceinline__ int perm32(int rho) { const int n = rho >> 4, i = rho & 15; return 8 * (i >> 2) + 4 * n + (i & 3); }

struct Unit { int pm, pn; };
struct Gemm { const bf16_t* A; const bf16_t* Bt; int M, N, K, lda; };

struct StaticOrder {
    int nM, nN, nwg, G, c;
    __device__ void init(int M, int N, int G_, int c_) { nM = M / BM; nN = N / BM; nwg = nM * nN; G = G_; c = c_; }
    __device__ bool next(int i, Unit& u) const {
        const long L = (long)i * G + c; if (L >= nwg) return false;
        int wgid = (int)L; { const int q = nwg / NXCD, r = nwg % NXCD, xcd = wgid % NXCD, off = wgid / NXCD; wgid = (xcd < r ? xcd * (q + 1) : r * (q + 1) + (xcd - r) * q) + off; }
        const int nig = WGM * nN, gid = wgid / nig, fm = gid * WGM, gsz = (nM - fm) < WGM ? (nM - fm) : WGM;
        u.pm = fm + ((wgid % nig) % gsz); u.pn = (wgid % nig) / gsz; return true;
    }
};

template <class Epi, bool ALIGN_EPI>
__device__ __forceinline__ void gemm_phase(LAS unsigned char* lds, const Gemm g, const StaticOrder& S, const Epi& E, int wave0) {
    const int wid = wave0, lane = fresh_lane(), tid = wid * 64 + lane, wr = wid >> 2, wc = wid & 3, fr = lane & 15, fq = lane >> 4;
    const int K = g.K, nt = K / BK, lda = g.lda;
    unsigned voffA[2], voffB[2];
#pragma unroll
    for (int i = 0; i < 2; ++i) { int R, C; stage_rc(tid * 16 + i * 8192, R, C); const int Rb = Epi::PERM ? ((R & ~31) + perm32(R & 31)) : R;
        voffA[i] = (unsigned)(R * lda + C) * 2u; voffB[i] = (unsigned)(Rb * K + C) * 2u; }
    const size_t kstep = (size_t)(BK * 2);
    const size_t hstepA = (size_t)HALF * lda * 2, hstepB = (size_t)HALF * K * 2;
    const size_t tstepA = 2 * hstepA, tstepB = 2 * hstepB;
    const unsigned ldsw = (unsigned)wid * 1024u;
    const int aoff = lds_byte(wr * 64 + fr, fq * 8), boff = lds_byte(wc * 32 + fr, fq * 8);
#define PG8_SA(b, h) (((b) * 2 + (h)) * HTB)
#define PG8_SB(b, h) ((4 + (b) * 2 + (h)) * HTB)
#define PG8_STAGE(bufoff, gbase, voff) do { _Pragma("unroll") for (int _i = 0; _i < 2; ++_i) \
        __builtin_amdgcn_global_load_lds((const unsigned*)((const char*)(gbase) + (voff)[_i]), (LAS unsigned*)(lds + (bufoff) + ldsw + _i * 8192), 16, 0, 0); } while (0)
#define PG8_LDA(dst, b, h) do { _Pragma("unroll") for (int m = 0; m < 4; ++m) _Pragma("unroll") for (int k = 0; k < 2; ++k) dst[m][k] = *(const LAS bf16x8*)(lds + PG8_SA(b, h) + aoff + m * 2048 + k * 1024); } while (0)
#define PG8_LDB(dst, b, h) do { _Pragma("unroll") for (int n = 0; n < 2; ++n) _Pragma("unroll") for (int k = 0; k < 2; ++k) dst[n][k] = *(const LAS bf16x8*)(lds + PG8_SB(b, h) + boff + n * 2048 + k * 1024); } while (0)
#define PG8_MMA(ai, bj, At, Bt) do { __builtin_amdgcn_s_setprio(1); _Pragma("unroll") for (int m = 0; m < 4; ++m) _Pragma("unroll") for (int n = 0; n < 2; ++n) _Pragma("unroll") for (int k = 0; k < 2; ++k) \
        acc[ai][bj][m][n] = __builtin_amdgcn_mfma_f32_16x16x32_bf16(Bt[n][k], At[m][k], acc[ai][bj][m][n], 0, 0, 0); __builtin_amdgcn_s_setprio(0); } while (0)
#define PG8_WAIT_V(n) asm volatile("s_waitcnt vmcnt(" #n ")" ::: "memory")
#define PG8_WAIT_L(n) asm volatile("s_waitcnt lgkmcnt(" #n ")" ::: "memory")
#define PG8_BAR __builtin_amdgcn_s_barrier()
#define PG8_SCHED __builtin_amdgcn_sched_barrier(0)
    Unit cur, nxt; int ui = 0;
    if (!S.next(0, cur)) return;
    f32x4 acc[2][2][4][2];
#pragma unroll
    for (int a = 0; a < 2; ++a)
#pragma unroll
        for (int b = 0; b < 2; ++b)
#pragma unroll
            for (int m = 0; m < 4; ++m)
#pragma unroll
                for (int n = 0; n < 2; ++n) acc[a][b][m][n] = (f32x4){0.f, 0.f, 0.f, 0.f};
    bf16x8 At[4][2], B0[2][2], B1[2][2];
    const char* cA = (const char*)g.A + (size_t)cur.pm * tstepA; const char* cB = (const char*)g.Bt + (size_t)cur.pn * tstepB;
    PG8_STAGE(PG8_SB(0, 0), cB, voffB); PG8_STAGE(PG8_SB(0, 1), cB + hstepB, voffB); PG8_STAGE(PG8_SA(0, 0), cA, voffA); PG8_STAGE(PG8_SA(0, 1), cA + hstepA, voffA);
    if (wr == 1) PG8_BAR;
    PG8_WAIT_V(2); PG8_BAR;
    PG8_STAGE(PG8_SB(1, 0), cB + kstep, voffB); PG8_STAGE(PG8_SA(1, 0), cA + kstep, voffA); PG8_STAGE(PG8_SB(1, 1), cB + hstepB + kstep, voffB);
    PG8_WAIT_V(6); PG8_BAR;
    for (;;) {
        const bool has_next = S.next(ui + 1, nxt);
        const char* nA = has_next ? (const char*)g.A + (size_t)nxt.pm * tstepA : cA; const char* nB = has_next ? (const char*)g.Bt + (size_t)nxt.pn * tstepB : cB;
        for (int t = 0; t < nt; t += 2) {
            const bool last = (t == nt - 2);
            const char* a1 = cA + (size_t)(t + 1) * kstep;
            const char* a2 = last ? nA : cA + (size_t)(t + 2) * kstep; const char* b2 = last ? nB : cB + (size_t)(t + 2) * kstep;
            const char* a3 = a2 + kstep; const char* b3 = b2 + kstep;
            PG8_LDB(B0, 0, 0); PG8_LDB(B1, 0, 1); PG8_SCHED; PG8_LDA(At, 0, 0); PG8_STAGE(PG8_SA(1, 1), a1 + hstepA, voffA);
            PG8_WAIT_V(8); PG8_WAIT_L(0); PG8_BAR; PG8_MMA(0, 0, At, B0); PG8_MMA(0, 1, At, B1); PG8_BAR; PG8_SCHED;
            PG8_LDA(At, 0, 1); PG8_STAGE(PG8_SB(0, 0), b2, voffB); PG8_STAGE(PG8_SB(0, 1), b2 + hstepB, voffB); PG8_STAGE(PG8_SA(0, 0), a2, voffA);
            PG8_WAIT_V(8); PG8_WAIT_L(0); PG8_BAR; PG8_MMA(1, 0, At, B0); PG8_MMA(1, 1, At, B1); PG8_BAR; PG8_SCHED;
            PG8_LDB(B0, 1, 0); PG8_LDB(B1, 1, 1); PG8_SCHED; PG8_LDA(At, 1, 0); PG8_STAGE(PG8_SA(0, 1), a2 + hstepA, voffA);
            PG8_WAIT_V(8); PG8_WAIT_L(0); PG8_BAR; PG8_MMA(0, 0, At, B0); PG8_MMA(0, 1, At, B1); PG8_BAR; PG8_SCHED;
            PG8_LDA(At, 1, 1); PG8_STAGE(PG8_SB(1, 0), b3, voffB); PG8_STAGE(PG8_SB(1, 1), b3 + hstepB, voffB); PG8_STAGE(PG8_SA(1, 0), a3, voffA);
            PG8_WAIT_V(8); PG8_WAIT_L(0); PG8_BAR; PG8_MMA(1, 0, At, B0); PG8_MMA(1, 1, At, B1); PG8_BAR; PG8_SCHED;
        }
        if constexpr (ALIGN_EPI) { if (wr == 0) PG8_BAR; }
        { int efr = fr, efq = fq, ewr = wr, ewc = wc; asm volatile("" : "+v"(efr), "+v"(efq), "+s"(ewr), "+s"(ewc)); E(acc, cur, ewr, ewc, efr, efq); }
        if (!has_next) break;
#pragma unroll
        for (int a = 0; a < 2; ++a)
#pragma unroll
            for (int b = 0; b < 2; ++b)
#pragma unroll
                for (int m = 0; m < 4; ++m)
#pragma unroll
                    for (int n = 0; n < 2; ++n) acc[a][b][m][n] = (f32x4){0.f, 0.f, 0.f, 0.f};
        cur = nxt; cA = nA; cB = nB; ++ui;
        if constexpr (ALIGN_EPI) { if (wr == 1) PG8_BAR; }
    }
    PG8_WAIT_V(0);
    if constexpr (!ALIGN_EPI) { if (wr == 0) PG8_BAR; }
    PG8_BAR;
#undef PG8_SA
#undef PG8_SB
#undef PG8_STAGE
#undef PG8_LDA
#undef PG8_LDB
#undef PG8_MMA
#undef PG8_WAIT_V
#undef PG8_WAIT_L
#undef PG8_BAR
#undef PG8_SCHED
}
}

struct EpiSwiglu {
    static constexpr bool PERM = true;
    bf16_t* O;
    __device__ __forceinline__ void operator()(const f32x4 (&acc)[2][2][4][2], const pg8::Unit& u, int wr, int wc, int fr, int fq) const {
        const int row0 = u.pm * 256 + wr * 64 + fr, col0 = u.pn * 128 + wc * 32 + 8 * fq;
#pragma unroll
        for (int ai = 0; ai < 2; ++ai)
#pragma unroll
            for (int m = 0; m < 4; ++m) {
                bf16_t* rowp = O + (size_t)(row0 + ai * 128 + m * 16) * FF + col0;
                const f32x4 a0 = acc[ai][0][m][0], a1 = acc[ai][0][m][1], b0 = acc[ai][1][m][0], b1 = acc[ai][1][m][1];
                u32x4 w;
                w.x = cvtpk(silu_f(a0[0]) * b0[0], silu_f(a0[1]) * b0[1]); w.y = cvtpk(silu_f(a0[2]) * b0[2], silu_f(a0[3]) * b0[3]);
                w.z = cvtpk(silu_f(a1[0]) * b1[0], silu_f(a1[1]) * b1[1]); w.w = cvtpk(silu_f(a1[2]) * b1[2], silu_f(a1[3]) * b1[3]);
                *(u32x4*)rowp = w;
            }
    }
};
struct EpiResid {
    static constexpr bool PERM = false;
    const float* xin; float* xout; const float* gate; float coef;
    __device__ __forceinline__ void operator()(const f32x4 (&acc)[2][2][4][2], const pg8::Unit& u, int wr, int wc, int fr, int fq) const {
        const int b = (u.pm * 256) >> 11;
        const int row0 = u.pm * 256 + wr * 64 + fr;
#pragma unroll
        for (int bj = 0; bj < 2; ++bj)
#pragma unroll
            for (int n = 0; n < 2; ++n) {
                const int col = u.pn * 256 + bj * 128 + wc * 32 + n * 16 + 4 * fq;
                const f32x4 gv = *(const f32x4*)(gate + (size_t)b * NADA + col) * coef;
                f32x4 xv[2][4];
#pragma unroll
                for (int ai = 0; ai < 2; ++ai)
#pragma unroll
                    for (int m = 0; m < 4; ++m) xv[ai][m] = *(const f32x4*)(xin + (size_t)(row0 + ai * 128 + m * 16) * DM + col);
#pragma unroll
                for (int ai = 0; ai < 2; ++ai)
#pragma unroll
                    for (int m = 0; m < 4; ++m) {
                        const size_t off = (size_t)(row0 + ai * 128 + m * 16) * DM + col;
                        *(f32x4*)(xout + off) = xv[ai][m] + gv * acc[ai][bj][m][n];
                    }
            }
    }
};
struct EpiGelu {
    static constexpr bool PERM = true;
    bf16_t* O; const float* bias;
    __device__ __forceinline__ void operator()(const f32x4 (&acc)[2][2][4][2], const pg8::Unit& u, int wr, int wc, int fr, int fq) const {
        const int row0 = u.pm * 256 + wr * 64 + fr;
#pragma unroll
        for (int bj = 0; bj < 2; ++bj) {
            const int col0 = u.pn * 256 + bj * 128 + wc * 32 + 8 * fq;
            const f32x4 bv0 = *(const f32x4*)(bias + col0), bv1 = *(const f32x4*)(bias + col0 + 4);
#pragma unroll
            for (int ai = 0; ai < 2; ++ai)
#pragma unroll
                for (int m = 0; m < 4; ++m) {
                    const f32x4 v0 = acc[ai][bj][m][0] + bv0, v1 = acc[ai][bj][m][1] + bv1;
                    u32x4 w;
                    w.x = cvtpk(gelu_tanh(v0[0]), gelu_tanh(v0[1])); w.y = cvtpk(gelu_tanh(v0[2]), gelu_tanh(v0[3]));
                    w.z = cvtpk(gelu_tanh(v1[0]), gelu_tanh(v1[1])); w.w = cvtpk(gelu_tanh(v1[2]), gelu_tanh(v1[3]));
                    *(u32x4*)(O + (size_t)(row0 + ai * 128 + m * 16) * 256 + col0) = w;
                }
        }
    }
};
struct EpiInProj {
    static constexpr bool PERM = true;
    unsigned char* ws; const float* fbias;
    __device__ __forceinline__ void operator()(const f32x4 (&acc)[2][2][4][2], const pg8::Unit& u, int wr, int wc, int fr, int fq) const {
        part<0>(acc, u, wr, wc, fr, fq); part<1>(acc, u, wr, wc, fr, fq);
    }
    template <int bj>
    __device__ __forceinline__ void part(const f32x4 (&acc)[2][2][4][2], const pg8::Unit& u, int wr, int wc, int fr, int fq) const {
        const float* cosT = (const float*)(ws + WS_COS); const float* sinT = (const float*)(ws + WS_SIN);
        {
            const int cb = u.pn * 256 + bj * 128 + wc * 32;
            const int hg = cb >> 6, half = (cb >> 5) & 1;
            if (hg > 44) return;
            int mode, NH = 1, hd = 0, pitch = 0; bool rope = false; bf16_t* base = nullptr;
            if (hg < 8)       { mode = 0; base = (bf16_t*)(ws + WS_QNSA); pitch = 512; hd = hg; rope = true; }
            else if (hg < 10) { mode = 1; base = (bf16_t*)(ws + WS_KC); NH = 2; hd = hg - 8; rope = true; }
            else if (hg < 12) { mode = 4; base = (bf16_t*)(ws + WS_KS); NH = 2; hd = hg - 10; rope = true; }
            else if (hg < 14) { mode = 4; base = (bf16_t*)(ws + WS_KW); NH = 2; hd = hg - 12; rope = true; }
            else if (hg < 18) { mode = 0; base = (bf16_t*)(ws + WS_FOXQ); pitch = 256; hd = hg - 14; }
            else if (hg < 22) { mode = 4; base = (bf16_t*)(ws + WS_FOXK); NH = 4; hd = hg - 18; }
            else if (hg < 26) { mode = 0; base = (bf16_t*)(ws + WS_MOBAQ); pitch = 256; hd = hg - 22; rope = true; }
            else if (hg < 30) { mode = 4; base = (bf16_t*)(ws + WS_MOBAK); NH = 4; hd = hg - 26; rope = true; }
            else if (hg < 32) { mode = 1; base = (bf16_t*)(ws + WS_VC); NH = 2; hd = hg - 30; }
            else if (hg < 34) { mode = 2; base = (bf16_t*)(ws + WS_VST); NH = 2; hd = hg - 32; }
            else if (hg < 36) { mode = 2; base = (bf16_t*)(ws + WS_VWT); NH = 2; hd = hg - 34; }
            else if (hg < 40) { mode = 2; base = (bf16_t*)(ws + WS_FOXVT); NH = 4; hd = hg - 36; }
            else if (hg < 44) { mode = 2; base = (bf16_t*)(ws + WS_MOBAVT); NH = 4; hd = hg - 40; }
            else { mode = 3; if (half) return; }
            const bool do_rope = rope && (half == 0);
#pragma unroll
            for (int ai = 0; ai < 2; ++ai)
#pragma unroll
                for (int m = 0; m < 4; ++m) {
                    const int row = u.pm * 256 + ai * 128 + wr * 64 + m * 16 + fr;
                    const int b = row >> 11, t = row & 2047;
                    float v[8];
#pragma unroll
                    for (int i = 0; i < 4; ++i) { v[i] = acc[ai][bj][m][0][i]; v[4 + i] = acc[ai][bj][m][1][i]; }
                    if (do_rope) {
                        float pr[8];
#pragma unroll
                        for (int i = 0; i < 8; ++i) pr[i] = __shfl_xor(v[i], 16);
                        if (fq < 2) {
                            const f32x4 c0 = *(const f32x4*)(cosT + (size_t)row * 8), c1 = *(const f32x4*)(cosT + (size_t)row * 8 + 4);
                            const f32x4 s0 = *(const f32x4*)(sinT + (size_t)row * 8), s1 = *(const f32x4*)(sinT + (size_t)row * 8 + 4);
                            const float sg = (fq == 0) ? -1.0f : 1.0f;
#pragma unroll
                            for (int i = 0; i < 4; ++i) { v[i] = v[i] * c0[i] + sg * pr[i] * s0[i]; v[4 + i] = v[4 + i] * c1[i] + sg * pr[4 + i] * s1[i]; }
                        }
                    }
                    if (mode == 3) {
                        float* gates = (float*)(ws + WS_GATES); float* flog = (float*)(ws + WS_FLOG);
                        if (fq < 3) {
                            f32x4 g0, g1;
#pragma unroll
                            for (int i = 0; i < 4; ++i) { g0[i] = sigmoid_f(v[i]); g1[i] = sigmoid_f(v[4 + i]); }
                            *(f32x4*)(gates + (size_t)row * 24 + 8 * fq) = g0; *(f32x4*)(gates + (size_t)row * 24 + 8 * fq + 4) = g1;
                        } else {
#pragma unroll
                            for (int i = 0; i < 4; ++i) {
                                const float z = v[i] + fbias[i];
                                const float ls = (z > 0.f) ? -log1pf(__expf(-z)) : (z - log1pf(__expf(z)));
                                flog[(size_t)(b * 4 + i) * SEQ + t] = ls;
                            }
                        }
                    } else {
                        u32x4 w; w.x = cvtpk(v[0], v[1]); w.y = cvtpk(v[2], v[3]); w.z = cvtpk(v[4], v[5]); w.w = cvtpk(v[6], v[7]);
                        const int dcol = half * 32 + 8 * fq;
                        if (mode == 0) *(u32x4*)(base + (size_t)row * pitch + hd * 64 + dcol) = w;
                        else if (mode == 1) *(u32x4*)(base + ((size_t)(b * NH + hd) * SEQ + t) * 64 + dcol) = w;
                        else if (mode == 4) {
                            const int d0 = half * 2 + (fq >> 1), khi = fq & 1;
                            *(u32x4*)(base + (size_t)(b * NH + hd) * SEQ * 64 + (size_t)(t >> 6) * 4096 + ((((t >> 5) & 1) * 4 + d0) * 64 + khi * 32 + (t & 31)) * 8) = w;
                        } else {
                            const int tt = t & 63, hf = tt >> 5, jj = (tt >> 4) & 1, piece = (tt >> 3) & 1, vhi = (tt >> 2) & 1, e = tt & 3;
                            bf16_t* p = base + (size_t)(b * NH + hd) * SEQ * 64 + (size_t)(t >> 6) * 4096 + (((hf * 2 + jj) * 2 + half) * 64 + vhi * 32 + 8 * fq) * 8 + piece * 4 + e;
                            p[0 * 8] = (bf16_t)(w.x & 0xffffu); p[1 * 8] = (bf16_t)(w.x >> 16);
                            p[2 * 8] = (bf16_t)(w.y & 0xffffu); p[3 * 8] = (bf16_t)(w.y >> 16);
                            p[4 * 8] = (bf16_t)(w.z & 0xffffu); p[5 * 8] = (bf16_t)(w.z >> 16);
                            p[6 * 8] = (bf16_t)(w.w & 0xffffu); p[7 * 8] = (bf16_t)(w.w >> 16);
                        }
                    }
                }
        }
    }
};

#define MFMA32(a, b, c) __builtin_amdgcn_mfma_f32_32x32x16_bf16((a), (b), (c), 0, 0, 0)
__device__ __forceinline__ f32x16 qk32(const bf16_t* kp, const bf16x8 (&qf)[4]) {
    f32x16 p;
#pragma unroll
    for (int r = 0; r < 16; ++r) p[r] = 0.f;
#pragma unroll
    for (int d0 = 0; d0 < 4; ++d0) { const bf16x8 kf = *(const bf16x8*)(kp + 16 * d0); p = MFMA32(kf, qf[d0], p); }
    return p;
}
__device__ __forceinline__ void pv32(f32x16 (&o)[2], const bf16_t* vp, int vpitch, const f32x16& p) {
#pragma unroll
    for (int j = 0; j < 2; ++j) {
        u32x4 pw; pw.x = cvtpk(p[8 * j + 0], p[8 * j + 1]); pw.y = cvtpk(p[8 * j + 2], p[8 * j + 3]); pw.z = cvtpk(p[8 * j + 4], p[8 * j + 5]); pw.w = cvtpk(p[8 * j + 6], p[8 * j + 7]);
        const bf16x8 pb = __builtin_bit_cast(bf16x8, pw);
#pragma unroll
        for (int dh = 0; dh < 2; ++dh) {
            const bf16_t* q = vp + (size_t)dh * 32 * vpitch + 16 * j;
            const s16x4 lo = *(const s16x4*)q, hi4 = *(const s16x4*)(q + 8);
            const bf16x8 va = (bf16x8){lo[0], lo[1], lo[2], lo[3], hi4[0], hi4[1], hi4[2], hi4[3]};
            o[dh] = MFMA32(va, pb, o[dh]);
        }
    }
}
__device__ __forceinline__ void load_k64(bf16x8 (&kf)[8], const bf16_t* ktile, int lane) {
    const bf16_t* p = ktile + lane * 8;
#pragma unroll
    for (int i = 0; i < 8; ++i) kf[i] = *(const bf16x8*)(p + i * 512);
}
__device__ __forceinline__ void load_v64(bf16x8 (&vf)[8], const bf16_t* vtile, int lane) {
    const bf16_t* p = vtile + lane * 8;
#pragma unroll
    for (int i = 0; i < 8; ++i) vf[i] = *(const bf16x8*)(p + i * 512);
}
template <int MODE, bool MASKED>
__device__ __forceinline__ void softmax_pv(f32x16 (&o)[2], float& m, float& l, f32x16& p0, f32x16& p1, const bf16x8 (&vf)[8],
                                           int kb, int t, bool tsel, const float* F8, float Fq8, int hi) {
    if (MASKED) {
#pragma unroll
        for (int r = 0; r < 16; ++r) {
            const int k0 = kb + crow(r, hi), k1 = k0 + 32;
            bool v0, v1;
            if (MODE == 0) { v0 = tsel && (k0 <= t); v1 = tsel && (k1 <= t); }
            else if (MODE == 1) { v0 = (k0 <= t) && (k0 > t - 512); v1 = (k1 <= t) && (k1 > t - 512); }
            else { v0 = (k0 <= t); v1 = (k1 <= t); }
            p0[r] = v0 ? p0[r] : NEG_INF; p1[r] = v1 ? p1[r] : NEG_INF;
        }
    }
    float mx = fmaxf(p0[0], p1[0]);
#pragma unroll
    for (int r = 1; r < 16; ++r) mx = fmaxf(mx, fmaxf(p0[r], p1[r]));
    mx = fmaxf(mx, __shfl_xor(mx, 32));
    const float mnew = fmaxf(m, mx);
    const float msafe = (mnew == NEG_INF) ? 0.f : mnew;
    const float alpha = fast_exp2((m - msafe) * QK_C2);
    const float nm = -msafe * QK_C2;
    float ps = 0.f;
#pragma unroll
    for (int r = 0; r < 16; ++r) { p0[r] = fast_exp2(__builtin_fmaf(p0[r], QK_C2, nm)); p1[r] = fast_exp2(__builtin_fmaf(p1[r], QK_C2, nm)); ps += p0[r] + p1[r]; }
    l = l * alpha + ps; m = mnew;
#pragma unroll
    for (int r = 0; r < 16; ++r) { o[0][r] *= alpha; o[1][r] *= alpha; }
#pragma unroll
    for (int hf = 0; hf < 2; ++hf)
#pragma unroll
        for (int j = 0; j < 2; ++j) {
            const f32x16& p = hf ? p1 : p0;
            u32x4 pw; pw.x = cvtpk(p[8 * j + 0], p[8 * j + 1]); pw.y = cvtpk(p[8 * j + 2], p[8 * j + 3]); pw.z = cvtpk(p[8 * j + 4], p[8 * j + 5]); pw.w = cvtpk(p[8 * j + 6], p[8 * j + 7]);
            const bf16x8 pb = __builtin_bit_cast(bf16x8, pw);
#pragma unroll
            for (int dh = 0; dh < 2; ++dh) o[dh] = MFMA32(vf[(hf * 2 + j) * 2 + dh], pb, o[dh]);
        }
}
template <int MODE, class Sel>
__device__ __forceinline__ void flash_loop(f32x16 (&o)[2], float& m, float& l, const bf16x8 (&qf)[4], const bf16_t* K, const bf16_t* Vt,
                                           int jlo, int jhi, int t, int tmin, int tmax, Sel sel, const float* F8, float Fq8, int lane) {
    const int hi = lane >> 5;
    int j = jlo;
    for (; j <= jhi; ++j) { if (__any(sel(j))) break; }
    bf16x8 kf[8], vf[8];
    if (j <= jhi) load_k64(kf, K + (size_t)j * 4096, lane);
    while (j <= jhi) {
        int jn = j + 1;
        for (; jn <= jhi; ++jn) { if (__any(sel(jn))) break; }
        load_v64(vf, Vt + (size_t)j * 4096, lane);
        f32x16 p0, p1;
        const int kb = j * 64;
        if (MODE == 2) {
#pragma unroll
            for (int g = 0; g < 4; ++g) {
                const f32x4 fa = *(const f32x4*)(F8 + kb + 8 * g + 4 * hi), fbv = *(const f32x4*)(F8 + kb + 32 + 8 * g + 4 * hi);
#pragma unroll
                for (int i = 0; i < 4; ++i) { p0[4 * g + i] = fa[i]; p1[4 * g + i] = fbv[i]; }
            }
        } else {
#pragma unroll
            for (int r = 0; r < 16; ++r) { p0[r] = 0.f; p1[r] = 0.f; }
        }
#pragma unroll
        for (int d0 = 0; d0 < 4; ++d0) { p0 = MFMA32(kf[d0], qf[d0], p0); p1 = MFMA32(kf[4 + d0], qf[d0], p1); }
        if (jn <= jhi) load_k64(kf, K + (size_t)jn * 4096, lane);
        bool full = (kb + 63 <= tmin);
        if (MODE == 0) full = full && __all(sel(j));
        if (MODE == 1) full = full && (kb > tmax - 512);
        if (full) softmax_pv<MODE, false>(o, m, l, p0, p1, vf, kb, t, true, F8, Fq8, hi);
        else softmax_pv<MODE, true>(o, m, l, p0, p1, vf, kb, t, sel(j), F8, Fq8, hi);
        j = jn;
    }
}
__device__ __forceinline__ void load_q(bf16x8 (&qf)[4], const bf16_t* qrow, int hi) {
#pragma unroll
    for (int d0 = 0; d0 < 4; ++d0) qf[d0] = *(const bf16x8*)(qrow + 16 * d0 + 8 * hi);
}
__device__ __forceinline__ void store_o(bf16_t* dst, const f32x16 (&o)[2], int hi) {
#pragma unroll
    for (int dh = 0; dh < 2; ++dh)
#pragma unroll
        for (int g = 0; g < 4; ++g) {
            u32x2 w; w.x = cvtpk(o[dh][4 * g + 0], o[dh][4 * g + 1]); w.y = cvtpk(o[dh][4 * g + 2], o[dh][4 * g + 3]);
            *(u32x2*)(dst + 32 * dh + 8 * g + 4 * hi) = w;
        }
}
__device__ __forceinline__ unsigned nsa_select(const float (&imp)[32], int t) {
    const int tb = t >> 6;
    unsigned sel = 1u | (1u << tb) | (1u << (tb > 0 ? tb - 1 : 0));
#pragma unroll
    for (int it = 0; it < 5; ++it) {
        float bv = NEG_INF; int bj = -1;
#pragma unroll
        for (int j = 1; j < 32; ++j) { const bool cand = (j <= tb - 2) && !((sel >> j) & 1u) && (imp[j] > bv); if (cand) { bv = imp[j]; bj = j; } }
        if (bj >= 0) sel |= 1u << bj;
    }
    if (tb <= 7) sel = (2u << tb) - 1u;
    return sel;
}

__device__ __forceinline__ void nsa_unit(unsigned char* ws, int b, int g, int qg, int lane, float* wl) {
    const int hi = lane >> 5, c = lane & 31;
    const int t = qg * 8 + (c >> 2), head = g * 4 + (c & 3), row = b * SEQ + t, bg = b * 2 + g;
    bf16x8 qf[4];
    load_q(qf, (const bf16_t*)(ws + WS_QNSA) + (size_t)row * 512 + head * 64, hi);
    const float* gp = (const float*)(ws + WS_GATES) + (size_t)row * 24 + head * 3;
    const float g0 = gp[0];
    f32x16 o[2];
    float* oa = wl + 256 + lane;
    {
        const bf16_t* Kc = (const bf16_t*)(ws + WS_KCMP) + (size_t)bg * 8192;
        const bf16_t* Vct = (const bf16_t*)(ws + WS_VCMPT) + (size_t)bg * 8192;
        f32x16 s[4];
        float mx = NEG_INF;
#pragma unroll
        for (int tile = 0; tile < 2; ++tile) {
            bf16x8 kf[8];
            load_k64(kf, Kc + tile * 4096, lane);
#pragma unroll
            for (int hf = 0; hf < 2; ++hf) {
                const int grp = tile * 2 + hf;
#pragma unroll
                for (int r = 0; r < 16; ++r) s[grp][r] = 0.f;
#pragma unroll
                for (int d0 = 0; d0 < 4; ++d0) s[grp] = MFMA32(kf[hf * 4 + d0], qf[d0], s[grp]);
#pragma unroll
                for (int r = 0; r < 16; ++r) {
                    const int key = 32 * grp + crow(r, hi);
                    const float v = (16 * key + 31 <= t) ? s[grp][r] * QK_C2 : NEG_INF;
                    s[grp][r] = v; mx = fmaxf(mx, v);
                }
            }
        }
        mx = fmaxf(mx, __shfl_xor(mx, 32));
        const float msafe = (mx == NEG_INF) ? 0.f : mx;
        float ps = 0.f;
#pragma unroll
        for (int grp = 0; grp < 4; ++grp)
#pragma unroll
            for (int r = 0; r < 16; ++r) { s[grp][r] = fast_exp2(s[grp][r] - msafe); ps += s[grp][r]; }
        ps += __shfl_xor(ps, 32);
        const float inv = 1.0f / fmaxf(ps, 1e-30f);
#pragma unroll
        for (int grp = 0; grp < 4; ++grp)
#pragma unroll
            for (int r = 0; r < 16; ++r) s[grp][r] *= inv;
#pragma unroll
        for (int r = 0; r < 16; ++r) { o[0][r] = 0.f; o[1][r] = 0.f; }
#pragma unroll
        for (int tile = 0; tile < 2; ++tile) {
            bf16x8 vf[8];
            load_v64(vf, Vct + tile * 4096, lane);
#pragma unroll
            for (int hf = 0; hf < 2; ++hf)
#pragma unroll
                for (int j = 0; j < 2; ++j) {
                    const f32x16& p = s[tile * 2 + hf];
                    u32x4 pw; pw.x = cvtpk(p[8 * j + 0], p[8 * j + 1]); pw.y = cvtpk(p[8 * j + 2], p[8 * j + 3]); pw.z = cvtpk(p[8 * j + 4], p[8 * j + 5]); pw.w = cvtpk(p[8 * j + 6], p[8 * j + 7]);
                    const bf16x8 pb = __builtin_bit_cast(bf16x8, pw);
#pragma unroll
                    for (int dh = 0; dh < 2; ++dh) o[dh] = MFMA32(vf[(hf * 2 + j) * 2 + dh], pb, o[dh]);
                }
        }
#pragma unroll
        for (int r = 0; r < 16; ++r) { oa[r * 64] = g0 * o[0][r]; oa[(16 + r) * 64] = g0 * o[1][r]; }
        float recv[4][4];
#pragma unroll
        for (int grp = 0; grp < 4; ++grp)
#pragma unroll
            for (int gq = 0; gq < 4; ++gq) recv[grp][gq] = __shfl_xor(s[grp][4 * gq + 3], 32);
#pragma unroll
        for (int grp = 0; grp < 4; ++grp)
#pragma unroll
            for (int gq = 0; gq < 4; ++gq) {
                const float own = (s[grp][4 * gq] + s[grp][4 * gq + 1]) + (s[grp][4 * gq + 2] + s[grp][4 * gq + 3]);
                const float plo = (gq > 0) ? recv[grp][gq > 0 ? gq - 1 : 0] : ((grp > 0) ? recv[grp > 0 ? grp - 1 : 0][3] : 0.f);
                const float prev = hi ? recv[grp][gq] : plo;
                float v = own + prev;
                v += __shfl_xor(v, 1); v += __shfl_xor(v, 2);
                if ((c & 3) == 0) wl[(c >> 2) * 32 + 8 * grp + 2 * gq + hi] = v;
            }
    }
    asm volatile("s_waitcnt lgkmcnt(0)" ::: "memory");
    float imp[32];
#pragma unroll
    for (int j4 = 0; j4 < 8; ++j4) { const f32x4 v = *(const f32x4*)(wl + (c >> 2) * 32 + 4 * j4); imp[4 * j4] = v[0]; imp[4 * j4 + 1] = v[1]; imp[4 * j4 + 2] = v[2]; imp[4 * j4 + 3] = v[3]; }
    asm volatile("s_waitcnt lgkmcnt(0)" ::: "memory");
    const unsigned sel = nsa_select(imp, t);
    const int jmax = (qg * 8 + 7) >> 6;
    {
        const bf16_t* Ks = (const bf16_t*)(ws + WS_KS) + (size_t)bg * SEQ * 64;
        const bf16_t* Vst = (const bf16_t*)(ws + WS_VST) + (size_t)bg * 64 * SEQ;
        float m = NEG_INF, l = 0.f;
#pragma unroll
        for (int r = 0; r < 16; ++r) { o[0][r] = 0.f; o[1][r] = 0.f; }
        flash_loop<0>(o, m, l, qf, Ks, Vst, 0, jmax, t, qg * 8, qg * 8 + 7, [&](int j) { return (bool)((sel >> j) & 1u); }, nullptr, 0.f, lane);
        l += __shfl_xor(l, 32);
        const float sc = gp[1] / fmaxf(l, 1e-30f);
#pragma unroll
        for (int r = 0; r < 16; ++r) { oa[r * 64] += sc * o[0][r]; oa[(16 + r) * 64] += sc * o[1][r]; }
        asm volatile("s_waitcnt lgkmcnt(0)" ::: "memory");
    }
    {
        const bf16_t* Kw = (const bf16_t*)(ws + WS_KW) + (size_t)bg * SEQ * 64;
        const bf16_t* Vwt = (const bf16_t*)(ws + WS_VWT) + (size_t)bg * 64 * SEQ;
        float m = NEG_INF, l = 0.f;
#pragma unroll
        for (int r = 0; r < 16; ++r) { o[0][r] = 0.f; o[1][r] = 0.f; }
        const int tl = qg * 8 - 511;
        const int jlo = (tl > 0 ? tl : 0) >> 6;
        flash_loop<1>(o, m, l, qf, Kw, Vwt, jlo, jmax, t, qg * 8, qg * 8 + 7, [&](int) { return true; }, nullptr, 0.f, lane);
        l += __shfl_xor(l, 32);
        const float sc = gp[2] / fmaxf(l, 1e-30f);
#pragma unroll
        for (int r = 0; r < 16; ++r) { o[0][r] = oa[r * 64] + sc * o[0][r]; o[1][r] = oa[(16 + r) * 64] + sc * o[1][r]; }
        asm volatile("s_waitcnt lgkmcnt(0)" ::: "memory");
    }
    store_o((bf16_t*)(ws + WS_H) + (size_t)row * DM + head * 64, o, hi);
}

__device__ __forceinline__ void fox_unit(unsigned char* ws, int bh, int qt, int lane) {
    const int hi = lane >> 5, c = lane & 31, b = bh >> 2, h = bh & 3;
    const int t = qt * 32 + c, row = b * SEQ + t;
    bf16x8 qf[4];
    load_q(qf, (const bf16_t*)(ws + WS_FOXQ) + (size_t)row * 256 + h * 64, hi);
    const bf16_t* K = (const bf16_t*)(ws + WS_FOXK) + (size_t)bh * SEQ * 64;
    const bf16_t* Vt = (const bf16_t*)(ws + WS_FOXVT) + (size_t)bh * 64 * SEQ;
    const float* F2 = (const float*)(ws + WS_FCUM) + (size_t)bh * SEQ;
    const float Fq2 = F2[t];
    f32x16 o[2]; float m = NEG_INF, l = 0.f;
#pragma unroll
    for (int r = 0; r < 16; ++r) { o[0][r] = 0.f; o[1][r] = 0.f; }
    const int jmax = (qt * 32 + 31) >> 6;
    flash_loop<2>(o, m, l, qf, K, Vt, 0, jmax, t, qt * 32, qt * 32 + 31, [&](int) { return true; }, F2, Fq2, lane);
    l += __shfl_xor(l, 32);
    const float sc = 1.0f / fmaxf(l, 1e-30f);
#pragma unroll
    for (int r = 0; r < 16; ++r) { o[0][r] *= sc; o[1][r] *= sc; }
    store_o((bf16_t*)(ws + WS_H) + (size_t)row * DM + 512 + h * 64, o, hi);
}

__device__ __forceinline__ void moba_unit(unsigned char* ws, int bh, int qt, int lane) {
    const int hi = lane >> 5, c = lane & 31, b = bh >> 2, h = bh & 3;
    const int t = qt * 32 + c, row = b * SEQ + t;
    bf16x8 qf[4];
    load_q(qf, (const bf16_t*)(ws + WS_MOBAQ) + (size_t)row * 256 + h * 64, hi);
    const bf16_t* K = (const bf16_t*)(ws + WS_MOBAK) + (size_t)bh * SEQ * 64;
    const bf16_t* Vt = (const bf16_t*)(ws + WS_MOBAVT) + (size_t)bh * 64 * SEQ;
    const int own = (qt * 32) >> 8;
    unsigned sel = 0u;
    {
        float gt[7];
        const float* km = (const float*)(ws + WS_KMEAN) + (size_t)bh * 8 * 64;
#pragma unroll
        for (int blk = 0; blk < 7; ++blk) {
            float a = 0.f;
            if (blk < own) {
#pragma unroll
                for (int d0 = 0; d0 < 4; ++d0) {
                    const f32x4 k0 = *(const f32x4*)(km + blk * 64 + 16 * d0 + 8 * hi), k1 = *(const f32x4*)(km + blk * 64 + 16 * d0 + 8 * hi + 4);
#pragma unroll
                    for (int i = 0; i < 4; ++i) { a += bf2f(qf[d0][i]) * k0[i]; a += bf2f(qf[d0][4 + i]) * k1[i]; }
                }
                a += __shfl_xor(a, 32);
            }
            gt[blk] = a;
        }
#pragma unroll
        for (int it = 0; it < 3; ++it) {
            float bv = NEG_INF; int bj = -1;
#pragma unroll
            for (int blk = 0; blk < 7; ++blk) { const bool cand = (blk < own) && !((sel >> blk) & 1u) && (gt[blk] > bv); if (cand) { bv = gt[blk]; bj = blk; } }
            if (bj >= 0) sel |= 1u << bj;
        }
    }
    f32x16 o[2]; float m = NEG_INF, l = 0.f;
#pragma unroll
    for (int r = 0; r < 16; ++r) { o[0][r] = 0.f; o[1][r] = 0.f; }
    const int jmax = (qt * 32 + 31) >> 6;
    flash_loop<0>(o, m, l, qf, K, Vt, 0, jmax, t, qt * 32, qt * 32 + 31, [&](int j) { const int blk = j >> 2; return (blk == own) || (bool)((sel >> blk) & 1u); }, nullptr, 0.f, lane);
    l += __shfl_xor(l, 32);
    const float sc = 1.0f / fmaxf(l, 1e-30f);
#pragma unroll
    for (int r = 0; r < 16; ++r) { o[0][r] *= sc; o[1][r] *= sc; }
    store_o((bf16_t*)(ws + WS_H) + (size_t)row * DM + 768 + h * 64, o, hi);
}


#define XB_TMO      128
#define XB_XCNT(j)  (256  + 64 * (j))
#define XB_XSUB(j)  (1280 + 64 * (j))
#define XB_XGEN(j)  (2304 + 64 * (j))
#define XB_TOP      3328
#define XB_TOPGEN   3392
#define XCD_BAR_WORDS 3456
#define XB_SPIN_CAP (1u << 22)
__device__ __forceinline__ unsigned xb_ld(unsigned* p)              { return __hip_atomic_load(p, __ATOMIC_RELAXED, __HIP_MEMORY_SCOPE_AGENT); }
__device__ __forceinline__ unsigned xb_add(unsigned* p, unsigned v) { return __hip_atomic_fetch_add(p, v, __ATOMIC_RELAXED, __HIP_MEMORY_SCOPE_AGENT); }
__device__ __forceinline__ unsigned xb_xcc_id() { return (unsigned)__builtin_amdgcn_s_getreg((3 << 11) | 20) & 0xFu; }
#define XB_SPIN(cond, bar) do { unsigned _sp = 0; while (cond) { __builtin_amdgcn_s_sleep(1); \
    if ((++_sp & 255u) == 0u) { if (xb_ld(&(bar)[XB_TMO])) break; if (_sp > XB_SPIN_CAP) { atomicAdd(&(bar)[XB_TMO], 1u); break; } } } } while (0)
__device__ __forceinline__ void xcd_barrier_post(unsigned* bar, unsigned x, volatile LAS unsigned* st) {
    if (threadIdx.x == 0) st[2] = xb_add(&bar[XB_XCNT(x)], 1u);
}
__device__ __forceinline__ void xcd_barrier_complete(unsigned* bar, unsigned x, unsigned& nloc, unsigned& nx) {
    const unsigned G = gridDim.x * gridDim.y * gridDim.z;
    unsigned sum, cnt, mine, sp = 0u;
    for (;;) {
        sum = 0u; cnt = 0u; mine = 0u;
#pragma unroll
        for (unsigned j = 0; j < 16; ++j) { const unsigned c = xb_ld(&bar[XB_XCNT(j)]); sum += c; cnt += (c > 0u) ? 1u : 0u; mine = (j == x) ? c : mine; }
        if (sum == G) break;
        __builtin_amdgcn_s_sleep(1);
        if ((++sp & 255u) == 0u) { if (xb_ld(&bar[XB_TMO])) break; if (sp > XB_SPIN_CAP) { atomicAdd(&bar[XB_TMO], 1u); break; } }
    }
    nloc = mine > 0u ? mine : 1u; nx = cnt > 0u ? cnt : 1u;
}
__device__ __forceinline__ void xcd_barrier(unsigned* bar_, unsigned x_, volatile LAS unsigned* st, bool leader) {
    asm volatile("s_waitcnt vmcnt(0)" ::: "memory");
    __syncthreads();
    if (leader) {
        size_t zo = 0; unsigned x = x_;
        asm volatile("" : "+s"(zo), "+s"(x));
        unsigned* bar = bar_ + zo;
        __builtin_amdgcn_s_waitcnt(0);
        unsigned nloc = st[0], nx = st[1];
        if (nloc == 0u) { xcd_barrier_complete(bar, x, nloc, nx); st[0] = nloc; st[1] = nx; }
        const unsigned old = xb_add(&bar[XB_XSUB(x)], 1u);
        const unsigned gen = old / nloc;
        if (old + 1u == (gen + 1u) * nloc) {
            __builtin_amdgcn_fence(__ATOMIC_RELEASE, "agent");
            asm volatile("s_waitcnt vmcnt(0)" ::: "memory");
            const unsigned og = xb_add(&bar[XB_TOP], 1u);
            const unsigned tg = og / nx;
            if (og + 1u == (tg + 1u) * nx) xb_add(&bar[XB_TOPGEN], 1u);
            else XB_SPIN(xb_ld(&bar[XB_TOPGEN]) == tg, bar);
            __builtin_amdgcn_fence(__ATOMIC_ACQUIRE, "agent");
            xb_add(&bar[XB_XGEN(x)], 1u);
            asm volatile("s_waitcnt vmcnt(0)" ::: "memory");
        } else {
            XB_SPIN(xb_ld(&bar[XB_XGEN(x)]) == gen, bar);
            __builtin_amdgcn_fence(__ATOMIC_ACQUIRE, "agent");
            asm volatile("s_waitcnt vmcnt(0)" ::: "memory");
        }
    }
    __syncthreads();
}

__device__ __forceinline__ int map_identity(int n) { return n; }
__device__ __forceinline__ int map_w13(int n) { const int tile = n >> 8, w = n & 255; return (w < 128) ? tile * 128 + w : FF + tile * 128 + (w - 128); }
__device__ __forceinline__ int map_win(int n) {
    if (n < 640) return n;
    if (n < 768) return n - 640 + 768;
    if (n < 896) return n - 768 + 1024;
    if (n < 1152) return n - 896 + 1304;
    if (n < 1408) return n - 1152 + 1560;
    if (n < 1664) return n - 1408 + 2076;
    if (n < 1920) return n - 1664 + 2332;
    if (n < 2048) return n - 1920 + 640;
    if (n < 2176) return n - 2048 + 896;
    if (n < 2304) return n - 2176 + 1152;
    if (n < 2560) return n - 2304 + 1816;
    if (n < 2816) return n - 2560 + 2588;
    if (n < 2840) return n - 2816 + 1280;
    if (n < 2844) return n - 2840 + 2072;
    return -1;
}
template <int MAP>
__device__ __forceinline__ void transpose_item(const float* W, int K, int Nsrc, int Ndst, bf16_t* WT, float* scr, int item, int lane) {
    const int nblk = Ndst / 64, kb = item / nblk, nb = item % nblk, k0 = 64 * kb, n0 = 64 * nb;
    const int nq = (lane & 15) * 4, nd = n0 + nq;
    const int src = (MAP == 0) ? map_identity(nd) : (MAP == 1) ? map_w13(nd) : map_win(nd);
    f32x4 v[16];
#pragma unroll
    for (int i = 0; i < 16; ++i) { const int kk = 4 * i + (lane >> 4); v[i] = (src >= 0) ? *(const f32x4*)(W + (size_t)(k0 + kk) * Nsrc + src) : (f32x4){0.f, 0.f, 0.f, 0.f}; }
#pragma unroll
    for (int i = 0; i < 16; ++i) { const int kk = 4 * i + (lane >> 4); float* d = scr + kk * 65 + nq; d[0] = v[i][0]; d[1] = v[i][1]; d[2] = v[i][2]; d[3] = v[i][3]; }
    asm volatile("s_waitcnt lgkmcnt(0)" ::: "memory");
    const int cc = lane & 7;
#pragma unroll
    for (int j = 0; j < 8; ++j) { const int n = (lane >> 3) + 8 * j; const float* sp = scr + (8 * cc) * 65 + n;
        u32x4 ov; ov.x = cvtpk(sp[0 * 65], sp[1 * 65]); ov.y = cvtpk(sp[2 * 65], sp[3 * 65]); ov.z = cvtpk(sp[4 * 65], sp[5 * 65]); ov.w = cvtpk(sp[6 * 65], sp[7 * 65]);
        *(u32x4*)(WT + (size_t)(n0 + n) * K + k0 + 8 * cc) = ov; }
    asm volatile("s_waitcnt lgkmcnt(0)" ::: "memory");
}
__device__ __forceinline__ void sincos_acc(float ang, float& sn, float& cs) {
    const double a = (double)ang;
    const double k = __builtin_rint(a * 0.15915494309189535);
    const double r = (a - k * 6.283185307179586) * 0.25;
    const double r2 = r * r;
    double s = r * (1.0 + r2 * (-1.0 / 6 + r2 * (1.0 / 120 + r2 * (-1.0 / 5040 + r2 * (1.0 / 362880 + r2 * (-1.0 / 39916800 + r2 * (1.0 / 6227020800.0)))))));
    double c = 1.0 + r2 * (-0.5 + r2 * (1.0 / 24 + r2 * (-1.0 / 720 + r2 * (1.0 / 40320 + r2 * (-1.0 / 3628800 + r2 * (1.0 / 479001600.0))))));
    double s2 = 2.0 * s * c, c2 = c * c - s * s;
    double s4 = 2.0 * s2 * c2, c4 = c2 * c2 - s2 * s2;
    sn = (float)s4; cs = (float)c4;
}

struct Params {
    const float* x; const float* c; const int* positions; const float* norm_g; const float* w_ada; const float* b_ada; const float* w_in; const float* fox_fbias;
    const float* cmp_pos; const float* cmp_w1; const float* cmp_w2; const float* w_out; const float* ffn_w13; const float* ffn_w2; const float* final_g;
    float* out; unsigned char* ws;
};

__device__ __forceinline__ void prologue(const Params& P, unsigned char* lds, int tid, int lane, int wave, int G) {
    unsigned char* ws = P.ws;
    float* cact = (float*)lds;
    float* part = (float*)(lds + 65536);
    for (int i = tid; i < NB * DM; i += 512) { const float v = P.c[i]; cact[i] = v / (1.0f + __expf(-v)); }
    __syncthreads();
    float* MOD = (float*)(ws + WS_MOD);
    for (int item = blockIdx.x; item < DEPTH * 64; item += G) {
        const int l = item >> 6, jb = (item & 63) * 144, j0 = jb + 4 * lane;
        const bool act = lane < 36;
        const float* wp = P.w_ada + (size_t)l * DM * NADA + (act ? j0 : jb);
        f32x4 acc4[16];
#pragma unroll
        for (int b = 0; b < 16; ++b) acc4[b] = (f32x4){0.f, 0.f, 0.f, 0.f};
        const int kbeg = wave * 128;
#pragma unroll 4
        for (int k = kbeg; k < kbeg + 128; ++k) {
            const f32x4 w = *(const f32x4*)(wp + (size_t)k * NADA);
#pragma unroll
            for (int b = 0; b < 16; ++b) acc4[b] += w * cact[b * DM + k];
        }
        if (act) {
#pragma unroll
            for (int b = 0; b < 16; ++b) *(f32x4*)(part + (wave * 16 + b) * 144 + 4 * lane) = acc4[b];
        }
        __syncthreads();
        for (int o = tid; o < 16 * 144; o += 512) {
            const int b = o / 144, col = o % 144;
            float sm = 0.f;
#pragma unroll
            for (int w = 0; w < 8; ++w) sm += part[(w * 16 + b) * 144 + col];
            const int j = jb + col;
            MOD[((size_t)l * NB + b) * NADA + j] = sm + P.b_ada[(size_t)l * NADA + j];
        }
        __syncthreads();
    }
    float* scr = (float*)(lds + wave * 16640);
    const int gw = blockIdx.x * NWAVES + wave, NGW = G * NWAVES;
    constexpr int I_WIN = 16 * 48, I_WOUT = 16 * 16, I_CW1 = 32 * 4, I_W13 = 16 * 88, I_W2 = 44 * 16, I_CW2 = 4 * 1;
    constexpr int T_WIN = 4 * I_WIN, T_WOUT = 4 * I_WOUT, T_CW1 = 8 * I_CW1, T_W13 = 8 * I_W13, T_W2 = 8 * I_W2, T_CW2 = 8 * I_CW2;
    constexpr int NITEMS = T_WIN + T_WOUT + T_CW1 + T_W13 + T_W2 + T_CW2;
    for (int it = gw; it < NITEMS; it += NGW) {
        int r = it;
        if (r < T_W13) { const int q = r / I_W13; transpose_item<1>(P.ffn_w13 + (size_t)q * DM * 2 * FF, DM, 2 * FF, 2 * FF, (bf16_t*)(ws + WS_W13) + (size_t)q * 2 * FF * DM, scr, r % I_W13, lane); continue; } r -= T_W13;
        if (r < T_W2) { const int q = r / I_W2; transpose_item<0>(P.ffn_w2 + (size_t)q * FF * DM, FF, DM, DM, (bf16_t*)(ws + WS_W2) + (size_t)q * DM * FF, scr, r % I_W2, lane); continue; } r -= T_W2;
        if (r < T_WIN) { const int q = r / I_WIN; transpose_item<2>(P.w_in + (size_t)q * DM * 2844, DM, 2844, NIN, (bf16_t*)(ws + WS_WIN) + (size_t)q * NIN * DM, scr, r % I_WIN, lane); continue; } r -= T_WIN;
        if (r < T_WOUT) { const int q = r / I_WOUT; transpose_item<0>(P.w_out + (size_t)q * DM * DM, DM, DM, DM, (bf16_t*)(ws + WS_WOUT) + (size_t)q * DM * DM, scr, r % I_WOUT, lane); continue; } r -= T_WOUT;
        if (r < T_CW1) { const int q = r / I_CW1; transpose_item<0>(P.cmp_w1 + (size_t)q * 2048 * 256, 2048, 256, 256, (bf16_t*)(ws + WS_CW1) + (size_t)q * 256 * 2048, scr, r % I_CW1, lane); continue; } r -= T_CW1;
        { const int q = r / I_CW2; transpose_item<0>(P.cmp_w2 + (size_t)q * 256 * 64, 256, 64, 64, (bf16_t*)(ws + WS_CW2T) + (size_t)q * 64 * 256, scr, r % I_CW2, lane); }
    }
    {
        float* cosT = (float*)(ws + WS_COS); float* sinT = (float*)(ws + WS_SIN);
        for (int e = blockIdx.x * 512 + tid; e < NTOK * 8; e += G * 512) {
            const int i = e & 7;
            const float inv = (i == 0) ? 1.0f : (i == 1) ? 0.1939227432012558f : (i == 2) ? 0.03760603070259094f : (i == 3) ? 0.007292664609849453f :
                              (i == 4) ? 0.0014142135623842478f : (i == 5) ? 0.00027424818836152554f : (i == 6) ? 5.318296098266728e-05f : 1.0313386155758053e-05f;
            const float ang = (float)P.positions[e >> 3] * inv;
            float sn, cs; sincos_acc(ang, sn, cs);
            cosT[e] = cs; sinT[e] = sn;
        }
    }
}

__device__ __forceinline__ void norm_phase(const float* xin, const float* g, const float* mod  , bf16_t* H, int lane, int wave, int G) {
    const int gw = blockIdx.x * NWAVES + wave, NGW = G * NWAVES;
    for (int row = gw; row < NTOK; row += NGW) {
        const int b = row >> 11;
        const f32x4* xr = (const f32x4*)(xin + (size_t)row * DM) + lane;
        f32x4 v[4]; float s = 0.f;
#pragma unroll
        for (int j = 0; j < 4; ++j) { v[j] = xr[64 * j]; s += (v[j].x * v[j].x + v[j].y * v[j].y) + (v[j].z * v[j].z + v[j].w * v[j].w); }
        const float rstd = 1.0f / sqrtf(wave_sum(s) * (1.0f / DM) + 1e-6f);
        const f32x4* gr = (const f32x4*)g + lane;
        const f32x4* sh = (const f32x4*)(mod + (size_t)b * NADA) + lane;
        const f32x4* sc = (const f32x4*)(mod + (size_t)b * NADA + DM) + lane;
        u32x2* o8 = (u32x2*)(H + (size_t)row * DM) + lane;
#pragma unroll
        for (int j = 0; j < 4; ++j) {
            const f32x4 gg = gr[64 * j], s1 = sc[64 * j] + 1.0f, s0 = sh[64 * j];
            const f32x4 y = v[j] * rstd * gg * s1 + s0;
            u32x2 w; w.x = cvtpk(y.x, y.y); w.y = cvtpk(y.z, y.w);
            o8[64 * j] = w;
        }
    }
}
__device__ __forceinline__ void final_norm(float* x, const float* g, int lane, int wave, int G) {
    const int gw = blockIdx.x * NWAVES + wave, NGW = G * NWAVES;
    for (int row = gw; row < NTOK; row += NGW) {
        f32x4* xr = (f32x4*)(x + (size_t)row * DM) + lane;
        f32x4 v[4]; float s = 0.f;
#pragma unroll
        for (int j = 0; j < 4; ++j) { v[j] = xr[64 * j]; s += (v[j].x * v[j].x + v[j].y * v[j].y) + (v[j].z * v[j].z + v[j].w * v[j].w); }
        const float rstd = 1.0f / sqrtf(wave_sum(s) * (1.0f / DM) + 1e-6f);
        const f32x4* gr = (const f32x4*)g + lane;
#pragma unroll
        for (int j = 0; j < 4; ++j) xr[64 * j] = v[j] * rstd * gr[64 * j];
    }
}

__global__ void __launch_bounds__(512, 2) fwd_megakernel(Params P) {
    extern __shared__ __attribute__((aligned(16))) unsigned char lds[];
    cg::grid_group grid = cg::this_grid();
    const int tid = threadIdx.x, lane = tid & 63, wave = __builtin_amdgcn_readfirstlane(tid >> 6), wave0 = wave;
    const int G = gridDim.x;
    unsigned char* ws = P.ws;
    LAS unsigned char* lds3 = (LAS unsigned char*)lds;
    const float* MOD = (const float*)(ws + WS_MOD);
    unsigned* ctl = (unsigned*)(ws + WS_CTL);

    volatile LAS unsigned* bst = (volatile LAS unsigned*)(lds3 + LDS_BYTES - 64);
    if (tid == 0) { bst[0] = 0u; bst[1] = 0u; }
    __syncthreads();
    const unsigned xcc = (unsigned)__builtin_amdgcn_readfirstlane((int)xb_xcc_id());
    xcd_barrier_post(ctl + 65536, xcc, bst);
    const bool leader = (tid == 0);
#define GRID_BAR() xcd_barrier((unsigned*)(P.ws + WS_CTL) + 65536, xcc, bst, leader)
    prologue(P, lds, tid, lane, wave, G);
    if (P.ws == nullptr) grid.sync();
    GRID_BAR();
    if (tid == 0) {
        bool ok = ((G & 7) == 0);
        for (unsigned j = 0; j < 16; ++j) { const unsigned cnt = xb_ld(ctl + 65536 + XB_XCNT(j)); ok = ok && (cnt == ((j < 8u) ? (unsigned)(G >> 3) : 0u)); }
        bst[3] = ok ? (bst[2] * 8u + xcc) : (unsigned)blockIdx.x;
    }
    __syncthreads();
    const int vbid = __builtin_amdgcn_readfirstlane((int)bst[3]);
#ifdef PROBE_SYNC20
    for (int i = 0; i < 20; ++i) GRID_BAR();
#endif
    {
        const int ln = fresh_lane(), wv = wave0;
        for (int it = blockIdx.x * NWAVES + wv; it < 8 * 256; it += G * NWAVES) {
            const int lm = it >> 8;
            const bf16_t* wr_ = (const bf16_t*)(ws + WS_CW1) + (size_t)it * 2048 + ln * 32;
            const float* pp = P.cmp_pos + (size_t)lm * 2048 + ln * 32;
            float a = 0.f;
#pragma unroll
            for (int j = 0; j < 4; ++j) {
                const bf16x8 wv8 = *(const bf16x8*)(wr_ + 8 * j);
                const f32x4 p0 = *(const f32x4*)(pp + 8 * j), p1 = *(const f32x4*)(pp + 8 * j + 4);
#pragma unroll
                for (int i = 0; i < 4; ++i) { a += p0[i] * bf2f(wv8[i]); a += p1[i] * bf2f(wv8[4 + i]); }
            }
            a = wave_sum(a);
            if (ln == 0) ((float*)(ws + WS_B1))[it] = a;
        }
    }

    const float* xin = P.x;
    for (int l = 0; l < DEPTH; ++l) {
        const float* modl = MOD + (size_t)l * NB * NADA;
        for (int sub = 0; sub < 3; ++sub) {
            unsigned char* ws = launder_p(P.ws);
            const int bid = launder_i(vbid);
            const int lane = fresh_lane(), wave = wave0;
            norm_phase(xin, P.norm_g + ((size_t)l * 3 + sub) * DM, modl + (size_t)sub * 3 * DM, (bf16_t*)(ws + WS_H), lane, wave, G);
            GRID_BAR();
            if (sub != 1) {
                const int s = (sub == 0) ? 0 : 1;
                {
                    pg8::Gemm g{(const bf16_t*)(ws + WS_H), (const bf16_t*)(ws + WS_W13) + (size_t)(l * 2 + s) * 2 * FF * DM, NTOK, 2 * FF, DM, DM};
                    pg8::StaticOrder S; S.init(NTOK, 2 * FF, G, bid);
                    EpiSwiglu E{(bf16_t*)(ws + WS_BIG)};
#ifndef NO_G1
                    pg8::gemm_phase<EpiSwiglu, true>(lds3, g, S, E, wave0);
#endif
#ifdef PROBE_G1X2
                    pg8::gemm_phase<EpiSwiglu, true>(lds3, g, S, E, wave0);
#endif
                }
                GRID_BAR();
                {
                    pg8::Gemm g{(const bf16_t*)(ws + WS_BIG), (const bf16_t*)(ws + WS_W2) + (size_t)(l * 2 + s) * DM * FF, NTOK, DM, FF, FF};
                    pg8::StaticOrder S; S.init(NTOK, DM, G, bid);
                    EpiResid E{xin, P.out, modl + (size_t)(sub * 3 + 2) * DM, 0.5f};
#ifndef NO_G2
                    pg8::gemm_phase<EpiResid, true>(lds3, g, S, E, wave0);
#endif
                }
                xin = P.out;
                GRID_BAR();
            } else {
                {
                    pg8::Gemm g{(const bf16_t*)(ws + WS_H), (const bf16_t*)(ws + WS_WIN) + (size_t)l * NIN * DM, NTOK, NIN, DM, DM};
                    pg8::StaticOrder S; S.init(NTOK, NIN, G, bid);
                    EpiInProj E{ws, P.fox_fbias + l * 4};
#ifndef NO_INPROJ
                    pg8::gemm_phase<EpiInProj, true>(lds3, g, S, E, wave0);
#endif
                }
                GRID_BAR();
                if (bid < 32) {
                    const int mat = bid >> 4;
                    pg8::Gemm g{(const bf16_t*)(ws + (mat ? WS_VC : WS_KC)), (const bf16_t*)(ws + WS_CW1) + (size_t)(l * 2 + mat) * 256 * 2048, 4096, 256, 2048, 1024};
                    pg8::StaticOrder S; S.init(4096, 256, 16, bid & 15);
                    EpiGelu E{(bf16_t*)(ws + WS_CMPHID) + (size_t)mat * 4096 * 256, (const float*)(ws + WS_B1) + (l * 2 + mat) * 256};
#ifndef NO_CMP1
                    pg8::gemm_phase<EpiGelu, true>(lds3, g, S, E, wave0);
#endif
                } else {
                    const int nw = (G - 32) * NWAVES;
                    for (int it = (bid - 32) * NWAVES + wave; it < 64 + 512; it += nw) {
                        if (it < 64) {
                            const float* src = (const float*)(ws + WS_FLOG) + (size_t)it * SEQ + lane * 32;
                            float v[32];
#pragma unroll
                            for (int j = 0; j < 8; ++j) { const f32x4 q = *(const f32x4*)(src + 4 * j); v[4 * j] = q.x; v[4 * j + 1] = q.y; v[4 * j + 2] = q.z; v[4 * j + 3] = q.w; }
#pragma unroll
                            for (int j = 1; j < 32; ++j) v[j] += v[j - 1];
                            float tot = v[31], inc = tot;
#pragma unroll
                            for (int o = 1; o < 64; o <<= 1) { const float n = __shfl_up(inc, o); if (lane >= o) inc += n; }
                            const float excl = inc - tot;
                            float* dst = (float*)(ws + WS_FCUM) + (size_t)it * SEQ + lane * 32;
#pragma unroll
                            for (int j = 0; j < 8; ++j) { f32x4 q; q.x = (v[4 * j] + excl) * -8.0f; q.y = (v[4 * j + 1] + excl) * -8.0f; q.z = (v[4 * j + 2] + excl) * -8.0f; q.w = (v[4 * j + 3] + excl) * -8.0f; *(f32x4*)(dst + 4 * j) = q; }
                        } else {
                            const int id = it - 64;
                            const bf16_t* kp = (const bf16_t*)(ws + WS_MOBAK) + (size_t)id * 256 * 64 + (((lane >> 4) * 64 + ((lane >> 3) & 1) * 32) * 8 + (lane & 7));
                            float a = 0.f;
#pragma unroll 8
                            for (int k = 0; k < 256; ++k) a += bf2f((short)kp[(size_t)(k >> 6) * 4096 + (((k >> 5) & 1) * 4 * 64 + (k & 31)) * 8]);
                            ((float*)(ws + WS_KMEAN))[(size_t)id * 64 + lane] = a * (1.0f / 256.0f);
                        }
                    }
                }
                GRID_BAR();
                for (int it = bid * NWAVES + wave; it < 256; it += G * NWAVES) {
                    const int mat = it >> 7, rt = it & 127, hi = lane >> 5, c = lane & 31;
                    const bf16_t* A = (const bf16_t*)(ws + WS_CMPHID) + ((size_t)mat * 4096 + rt * 32 + c) * 256 + 8 * hi;
                    const bf16_t* Bt = (const bf16_t*)(ws + WS_CW2T) + (size_t)(l * 2 + mat) * 64 * 256 + (size_t)c * 256 + 8 * hi;
                    f32x16 a0, a1;
#pragma unroll
                    for (int r = 0; r < 16; ++r) { a0[r] = 0.f; a1[r] = 0.f; }
#pragma unroll 4
                    for (int ks = 0; ks < 16; ++ks) {
                        const bf16x8 af = *(const bf16x8*)(A + 16 * ks);
                        const bf16x8 b0 = *(const bf16x8*)(Bt + 16 * ks), b1 = *(const bf16x8*)(Bt + 32 * 256 + 16 * ks);
                        a0 = MFMA32(af, b0, a0); a1 = MFMA32(af, b1, a1);
                    }
#pragma unroll
                    for (int r = 0; r < 16; ++r) {
                        const int row = rt * 32 + crow(r, hi), rl = row & 127, bg = row >> 7;
                        const float v0 = (rl == 127) ? 0.f : a0[r], v1 = (rl == 127) ? 0.f : a1[r];
                        const bf16_t h0 = (bf16_t)(cvtpk(v0, 0.f) & 0xffffu), h1 = (bf16_t)(cvtpk(v1, 0.f) & 0xffffu);
                        if (mat == 0) {
                            bf16_t* kc = (bf16_t*)(ws + WS_KCMP) + (size_t)bg * 8192 + (rl >> 6) * 4096 + ((((rl >> 5) & 1) * 4) * 64 + (rl & 31)) * 8;
                            const int o0 = ((c >> 4) * 64 + ((c >> 3) & 1) * 32) * 8 + (c & 7);
                            kc[o0] = h0; kc[o0 + 2 * 64 * 8] = h1;
                        } else {
                            const int tt = rl & 63;
                            bf16_t* vc = (bf16_t*)(ws + WS_VCMPT) + (size_t)bg * 8192 + (rl >> 6) * 4096
                                         + ((((tt >> 5) * 2 + ((tt >> 4) & 1)) * 2) * 64 + ((tt >> 2) & 1) * 32 + c) * 8 + ((tt >> 3) & 1) * 4 + (tt & 3);
                            vc[0] = h0; vc[64 * 8] = h1;
                        }
                    }
                }
                GRID_BAR();
                {
#ifdef PROBE_ATTN2
                  for (int rep = 0; rep < 2; ++rep)
#else
                  const int rep = 0;
#endif
                  {
                    float* wl = (float*)(lds + wave * 16384);
                    const int lane_ = lane;
                    const int myq = (int)(__builtin_amdgcn_s_getreg((3 << 11) | 20) & 7u);
                    for (int qi = 0; qi < 8; ++qi) {
                        const int q = (myq + qi) & 7;
                        unsigned* ctr = ctl + 64 * (1 + (l * 2 + rep) * 8 + q);
                        for (;;) {
                            unsigned u = 0;
                            if (lane_ == 0) u = atomicAdd(ctr, 1u);
                            u = (unsigned)__builtin_amdgcn_readfirstlane((int)u);
                            if (u >= 2048u) break;
                            const int lane = launder_v(lane_);
                            if (u < 1024u) {
                                const int pr = (int)(u >> 9), i = (int)(u & 511u), slot = 63 - (i >> 3), w = i & 7;
                                const int bg = 4 * q + 2 * pr + (w >> 2);
                                nsa_unit(ws, bg >> 1, bg & 1, slot * 4 + (w & 3), lane, wl);
                            } else if (u < 1536u) {
                                const int i = (int)(u - 1024u), hf = i >> 8, slot = 63 - ((i & 255) >> 2);
                                fox_unit(ws, 8 * q + 4 * hf + (i & 3), slot, lane);
                            } else {
                                const int i = (int)(u - 1536u), hf = i >> 8, slot = 63 - ((i & 255) >> 2);
                                moba_unit(ws, 8 * q + 4 * hf + (i & 3), slot, lane);
                            }
                        }
                    }
                  }
                }
                GRID_BAR();
                {
                    pg8::Gemm g{(const bf16_t*)(ws + WS_H), (const bf16_t*)(ws + WS_WOUT) + (size_t)l * DM * DM, NTOK, DM, DM, DM};
                    pg8::StaticOrder S; S.init(NTOK, DM, G, bid);
                    EpiResid E{xin, P.out, modl + (size_t)(1 * 3 + 2) * DM, 1.0f};
#ifndef NO_OUTPROJ
                    pg8::gemm_phase<EpiResid, true>(lds3, g, S, E, wave0);
#endif
                }
                GRID_BAR();
            }
        }
    }
    final_norm(P.out, P.final_g, fresh_lane(), wave0, G);
}

extern "C" void kernel_launch(void* const* d_in, const int* in_sizes, int n_in, void* d_out, int out_size, void* d_ws, size_t ws_size, hipStream_t stream) {
    static int grid_blocks = 0;
    if (grid_blocks == 0) {
        if (n_in != 15 || ws_size < WS_END) { fprintf(stderr, "kernel_launch: unexpected inputs (n_in %d, ws %zu)\n", n_in, ws_size); grid_blocks = -1; return; }
        int dev = 0, cus = 0, per_cu = 0;
        hipGetDevice(&dev);
        hipDeviceGetAttribute(&cus, hipDeviceAttributeMultiprocessorCount, dev);
        if (hipFuncSetAttribute((const void*)fwd_megakernel, hipFuncAttributeMaxDynamicSharedMemorySize, LDS_BYTES) != hipSuccess) fprintf(stderr, "kernel_launch: hipFuncSetAttribute failed\n");
        if (hipOccupancyMaxActiveBlocksPerMultiprocessor(&per_cu, (const void*)fwd_megakernel, 512, LDS_BYTES) != hipSuccess || per_cu < 1) { fprintf(stderr, "kernel_launch: occupancy query gave %d\n", per_cu); per_cu = 1; }
        (void)hipGetLastError();
        grid_blocks = cus * per_cu;
        if (grid_blocks > 256) grid_blocks = 256;
    }
    if (grid_blocks < 0) return;
    hipMemsetAsync((char*)d_ws + WS_CTL, 0, 1 * MiB, stream);
    Params p{};
    p.x = (const float*)d_in[0]; p.c = (const float*)d_in[1]; p.positions = (const int*)d_in[2]; p.norm_g = (const float*)d_in[3];
    p.w_ada = (const float*)d_in[4]; p.b_ada = (const float*)d_in[5]; p.w_in = (const float*)d_in[6]; p.fox_fbias = (const float*)d_in[7];
    p.cmp_pos = (const float*)d_in[8]; p.cmp_w1 = (const float*)d_in[9]; p.cmp_w2 = (const float*)d_in[10]; p.w_out = (const float*)d_in[11];
    p.ffn_w13 = (const float*)d_in[12]; p.ffn_w2 = (const float*)d_in[13]; p.final_g = (const float*)d_in[14];
    p.out = (float*)d_out; p.ws = (unsigned char*)d_ws;
    void* args[] = {&p};
    hipError_t e = hipLaunchCooperativeKernel((const void*)fwd_megakernel, dim3(grid_blocks), dim3(512), args, LDS_BYTES, stream);
    if (e != hipSuccess) fprintf(stderr, "kernel_launch: cooperative launch failed: %s (grid %d)\n", hipGetErrorString(e), grid_blocks);
}
```

```cpp
#include <hip/hip_runtime.h>
#include <hip/hip_cooperative_groups.h>
#include <cstdio>
#include <cstdint>
namespace cg = cooperative_groups;

#define LAS __attribute__((address_space(3)))
typedef unsigned short bf16_t;
typedef short bf16x8 __attribute__((ext_vector_type(8)));
typedef short s16x4 __attribute__((ext_vector_type(4)));
typedef float f32x4 __attribute__((ext_vector_type(4)));
typedef float f32x2 __attribute__((ext_vector_type(2)));
typedef float f32x16 __attribute__((ext_vector_type(16)));
typedef unsigned u32x4 __attribute__((ext_vector_type(4)));
typedef unsigned u32x2 __attribute__((ext_vector_type(2)));
typedef __bf16 bf16x2_t __attribute__((ext_vector_type(2)));

constexpr int NB = 16, SEQ = 2048, DM = 1024, NTOK = NB * SEQ, DEPTH = 4, FF = 2816, NIN = 3072, NADA = 9216;
constexpr float LOG2E = 1.4426950408889634f;
constexpr float QK_C2 = 0.125f * LOG2E;
constexpr float NEG_INF = -__builtin_inff();

constexpr size_t MiB = 1u << 20;
constexpr size_t WS_CTL = 0;
constexpr size_t WS_B1 = 4 * MiB;
constexpr size_t WS_MOD = 1 * MiB;
constexpr size_t WS_COS = 5 * MiB, WS_SIN = 6 * MiB;
constexpr size_t WS_CW2T = 7 * MiB;
constexpr size_t WS_WIN = 8 * MiB;
constexpr size_t WS_WOUT = 32 * MiB;
constexpr size_t WS_CW1 = 40 * MiB;
constexpr size_t WS_W13 = 48 * MiB;
constexpr size_t WS_W2 = 136 * MiB;
constexpr size_t WS_H = 180 * MiB;
constexpr size_t WS_BIG = 244 * MiB;
constexpr size_t WS_QNSA = 244 * MiB;
constexpr size_t WS_KC = 276 * MiB;
constexpr size_t WS_VC = 285 * MiB;
constexpr size_t WS_KS = 294 * MiB, WS_KW = 302 * MiB;
constexpr size_t WS_FOXQ = 310 * MiB;
constexpr size_t WS_FOXK = 326 * MiB;
constexpr size_t WS_MOBAQ = 342 * MiB, WS_MOBAK = 358 * MiB;
constexpr size_t WS_VST = 374 * MiB, WS_VWT = 382 * MiB;
constexpr size_t WS_FOXVT = 390 * MiB, WS_MOBAVT = 406 * MiB;
constexpr size_t WS_GATES = 422 * MiB;
constexpr size_t WS_FLOG = 425 * MiB;
constexpr size_t WS_FCUM = 426 * MiB;
constexpr size_t WS_KMEAN = 427 * MiB;
constexpr size_t WS_CMPHID = 428 * MiB;
constexpr size_t WS_KCMP = 432 * MiB;
constexpr size_t WS_VCMPT = 433 * MiB;
constexpr size_t WS_END = 436 * MiB;

constexpr int RING_BYTES = 131072;
constexpr int LDS_BYTES = 147456;
constexpr int NWAVES = 8;

__device__ __forceinline__ unsigned cvtpk(float lo, float hi) { f32x2 v = {lo, hi}; bf16x2_t b = __builtin_convertvector(v, bf16x2_t); return __builtin_bit_cast(unsigned, b); }
__device__ __forceinline__ float bf2f(short s) { return __uint_as_float(((unsigned)(unsigned short)s) << 16); }
__device__ __forceinline__ float fast_exp2(float x) { return __builtin_amdgcn_exp2f(x); }
__device__ __forceinline__ float fast_rcp(float x) { return __builtin_amdgcn_rcpf(x); }
__device__ __forceinline__ float silu_f(float a) { return a * fast_rcp(1.0f + fast_exp2(-a * LOG2E)); }
__device__ __forceinline__ float sigmoid_f(float a) { return 1.0f / (1.0f + __expf(-a)); }
__device__ __forceinline__ float gelu_tanh(float x) {
    const float u = 0.7978845608028654f * (x + 0.044715f * x * x * x);
    const float e = fast_exp2(2.0f * LOG2E * u);
    const float th = 1.0f - 2.0f * fast_rcp(e + 1.0f);
    return 0.5f * x * (1.0f + th);
}
__device__ __forceinline__ float wave_sum(float v) {
#pragma unroll
    for (int o = 1; o < 64; o <<= 1) v += __shfl_xor(v, o);
    return v;
}
__device__ __forceinline__ unsigned char* launder_p(unsigned char* p) { size_t z = 0; asm volatile("" : "+s"(z)); return p + z; }
__device__ __forceinline__ int launder_i(int v) { asm volatile("" : "+s"(v)); return v; }
__device__ __forceinline__ int launder_v(int v) { asm volatile("" : "+v"(v)); return v; }
__device__ __forceinline__ int fresh_lane() { unsigned m = ~0u; asm volatile("" : "+s"(m)); return (int)__builtin_amdgcn_mbcnt_hi(m, __builtin_amdgcn_mbcnt_lo(m, 0u)); }
__device__ __forceinline__ int crow(int r, int hi) { return (r & 3) + 8 * (r >> 2) + 4 * hi; }

namespace pg8 {
constexpr int BM = 256, BK = 64, HALF = 128, HTB = HALF * BK * 2, STAGE_BYTES = 8 * HTB, NXCD = 8, WGM = 8;
__host__ __device__ __forceinline__ int lds_byte(int r, int c) { const int st = (r >> 4) * 2 + (c >> 5), rr = r & 15, cc = c & 31, ob = rr * 64 + cc * 2; return st * 1024 + (ob ^ (((ob >> 9) & 1) << 5)); }
__host__ __device__ __forceinline__ void stage_rc(int b, int& R, int& C) { const int st = b / 1024, sb = b % 1024, swz = sb ^ (((sb >> 9) & 1) << 5); R = (st >> 1) * 16 + swz / 64; C = (st & 1) * 32 + (swz % 64) / 2; }
__host__ __device__ __forceinline__ int perm32(int rho) { const int n = rho >> 4, i = rho & 15; return 8 * (i >> 2) + 4 * n + (i & 3); }

struct Unit { int pm, pn; };
struct Gemm { const bf16_t* A; const bf16_t* Bt; int M, N, K, lda; };

struct StaticOrder {
    int nM, nN, nwg, G, c;
    __device__ void init(int M, int N, int G_, int c_) { nM = M / BM; nN = N / BM; nwg = nM * nN; G = G_; c = c_; }
    __device__ bool next(int i, Unit& u) const {
        const long L = (long)i * G + c; if (L >= nwg) return false;
        int wgid = (int)L; { const int q = nwg / NXCD, r = nwg % NXCD, xcd = wgid % NXCD, off = wgid / NXCD; wgid = (xcd < r ? xcd * (q + 1) : r * (q + 1) + (xcd - r) * q) + off; }
        const int nig = WGM * nN, gid = wgid / nig, fm = gid * WGM, gsz = (nM - fm) < WGM ? (nM - fm) : WGM;
        u.pm = fm + ((wgid % nig) % gsz); u.pn = (wgid % nig) / gsz; return true;
    }
};

template <class Epi, bool ALIGN_EPI>
__device__ __forceinline__ void gemm_phase(LAS unsigned char* lds, const Gemm g, const StaticOrder& S, const Epi& E, int wave0) {
    const int wid = wave0, lane = fresh_lane(), tid = wid * 64 + lane, wr = wid >> 2, wc = wid & 3, fr = lane & 15, fq = lane >> 4;
    const int K = g.K, nt = K / BK, lda = g.lda;
    unsigned voffA[2], voffB[2];
#pragma unroll
    for (int i = 0; i < 2; ++i) { int R, C; stage_rc(tid * 16 + i * 8192, R, C); const int Rb = Epi::PERM ? ((R & ~31) + perm32(R & 31)) : R;
        voffA[i] = (unsigned)(R * lda + C) * 2u; voffB[i] = (unsigned)(Rb * K + C) * 2u; }
    const size_t kstep = (size_t)(BK * 2);
    const size_t hstepA = (size_t)HALF * lda * 2, hstepB = (size_t)HALF * K * 2;
    const size_t tstepA = 2 * hstepA, tstepB = 2 * hstepB;
    const unsigned ldsw = (unsigned)wid * 1024u;
    const int aoff = lds_byte(wr * 64 + fr, fq * 8), boff = lds_byte(wc * 32 + fr, fq * 8);
#define PG8_SA(b, h) (((b) * 2 + (h)) * HTB)
#define PG8_SB(b, h) ((4 + (b) * 2 + (h)) * HTB)
#define PG8_STAGE(bufoff, gbase, voff) do { _Pragma("unroll") for (int _i = 0; _i < 2; ++_i) \
        __builtin_amdgcn_global_load_lds((const unsigned*)((const char*)(gbase) + (voff)[_i]), (LAS unsigned*)(lds + (bufoff) + ldsw + _i * 8192), 16, 0, 0); } while (0)
#define PG8_LDA(dst, b, h) do { _Pragma("unroll") for (int m = 0; m < 4; ++m) _Pragma("unroll") for (int k = 0; k < 2; ++k) dst[m][k] = *(const LAS bf16x8*)(lds + PG8_SA(b, h) + aoff + m * 2048 + k * 1024); } while (0)
#define PG8_LDB(dst, b, h) do { _Pragma("unroll") for (int n = 0; n < 2; ++n) _Pragma("unroll") for (int k = 0; k < 2; ++k) dst[n][k] = *(const LAS bf16x8*)(lds + PG8_SB(b, h) + boff + n * 2048 + k * 1024); } while (0)
#define PG8_MMA(ai, bj, At, Bt) do { __builtin_amdgcn_s_setprio(1); _Pragma("unroll") for (int m = 0; m < 4; ++m) _Pragma("unroll") for (int n = 0; n < 2; ++n) _Pragma("unroll") for (int k = 0; k < 2; ++k) \
        acc[ai][bj][m][n] = __builtin_amdgcn_mfma_f32_16x16x32_bf16(Bt[n][k], At[m][k], acc[ai][bj][m][n], 0, 0, 0); __builtin_amdgcn_s_setprio(0); } while (0)
#define PG8_WAIT_V(n) asm volatile("s_waitcnt vmcnt(" #n ")" ::: "memory")
#define PG8_WAIT_L(n) asm volatile("s_waitcnt lgkmcnt(" #n ")" ::: "memory")
#define PG8_BAR __builtin_amdgcn_s_barrier()
#define PG8_SCHED __builtin_amdgcn_sched_barrier(0)
    Unit cur, nxt; int ui = 0;
    if (!S.next(0, cur)) return;
    f32x4 acc[2][2][4][2];
#pragma unroll
    for (int a = 0; a < 2; ++a)
#pragma unroll
        for (int b = 0; b < 2; ++b)
#pragma unroll
            for (int m = 0; m < 4; ++m)
#pragma unroll
                for (int n = 0; n < 2; ++n) acc[a][b][m][n] = (f32x4){0.f, 0.f, 0.f, 0.f};
    bf16x8 At[4][2], B0[2][2], B1[2][2];
    const char* cA = (const char*)g.A + (size_t)cur.pm * tstepA; const char* cB = (const char*)g.Bt + (size_t)cur.pn * tstepB;
    PG8_STAGE(PG8_SB(0, 0), cB, voffB); PG8_STAGE(PG8_SB(0, 1), cB + hstepB, voffB); PG8_STAGE(PG8_SA(0, 0), cA, voffA); PG8_STAGE(PG8_SA(0, 1), cA + hstepA, voffA);
    if (wr == 1) PG8_BAR;
    PG8_WAIT_V(2); PG8_BAR;
    PG8_STAGE(PG8_SB(1, 0), cB + kstep, voffB); PG8_STAGE(PG8_SA(1, 0), cA + kstep, voffA); PG8_STAGE(PG8_SB(1, 1), cB + hstepB + kstep, voffB);
    PG8_WAIT_V(6); PG8_BAR;
    for (;;) {
        const bool has_next = S.next(ui + 1, nxt);
        const char* nA = has_next ? (const char*)g.A + (size_t)nxt.pm * tstepA : cA; const char* nB = has_next ? (const char*)g.Bt + (size_t)nxt.pn * tstepB : cB;
        for (int t = 0; t < nt; t += 2) {
            const bool last = (t == nt - 2);
            const char* a1 = cA + (size_t)(t + 1) * kstep;
            const char* a2 = last ? nA : cA + (size_t)(t + 2) * kstep; const char* b2 = last ? nB : cB + (size_t)(t + 2) * kstep;
            const char* a3 = a2 + kstep; const char* b3 = b2 + kstep;
            PG8_LDB(B0, 0, 0); PG8_LDB(B1, 0, 1); PG8_SCHED; PG8_LDA(At, 0, 0); PG8_STAGE(PG8_SA(1, 1), a1 + hstepA, voffA);
            PG8_WAIT_V(8); PG8_WAIT_L(0); PG8_BAR; PG8_MMA(0, 0, At, B0); PG8_MMA(0, 1, At, B1); PG8_BAR; PG8_SCHED;
            PG8_LDA(At, 0, 1); PG8_STAGE(PG8_SB(0, 0), b2, voffB); PG8_STAGE(PG8_SB(0, 1), b2 + hstepB, voffB); PG8_STAGE(PG8_SA(0, 0), a2, voffA);
            PG8_WAIT_V(8); PG8_WAIT_L(0); PG8_BAR; PG8_MMA(1, 0, At, B0); PG8_MMA(1, 1, At, B1); PG8_BAR; PG8_SCHED;
            PG8_LDB(B0, 1, 0); PG8_LDB(B1, 1, 1); PG8_SCHED; PG8_LDA(At, 1, 0); PG8_STAGE(PG8_SA(0, 1), a2 + hstepA, voffA);
            PG8_WAIT_V(8); PG8_WAIT_L(0); PG8_BAR; PG8_MMA(0, 0, At, B0); PG8_MMA(0, 1, At, B1); PG8_BAR; PG8_SCHED;
            PG8_LDA(At, 1, 1); PG8_STAGE(PG8_SB(1, 0), b3, voffB); PG8_STAGE(PG8_SB(1, 1), b3 + hstepB, voffB); PG8_STAGE(PG8_SA(1, 0), a3, voffA);
            PG8_WAIT_V(8); PG8_WAIT_L(0); PG8_BAR; PG8_MMA(1, 0, At, B0); PG8_MMA(1, 1, At, B1); PG8_BAR; PG8_SCHED;
        }
        if constexpr (ALIGN_EPI) { if (wr == 0) PG8_BAR; }
        { int efr = fr, efq = fq, ewr = wr, ewc = wc; asm volatile("" : "+v"(efr), "+v"(efq), "+s"(ewr), "+s"(ewc)); E(acc, cur, ewr, ewc, efr, efq); }
        if (!has_next) break;
#pragma unroll
        for (int a = 0; a < 2; ++a)
#pragma unroll
            for (int b = 0; b < 2; ++b)
#pragma unroll
                for (int m = 0; m < 4; ++m)
#pragma unroll
                    for (int n = 0; n < 2; ++n) acc[a][b][m][n] = (f32x4){0.f, 0.f, 0.f, 0.f};
        cur = nxt; cA = nA; cB = nB; ++ui;
        if constexpr (ALIGN_EPI) { if (wr == 1) PG8_BAR; }
    }
    PG8_WAIT_V(0);
    if constexpr (!ALIGN_EPI) { if (wr == 0) PG8_BAR; }
    PG8_BAR;
#undef PG8_SA
#undef PG8_SB
#undef PG8_STAGE
#undef PG8_LDA
#undef PG8_LDB
#undef PG8_MMA
#undef PG8_WAIT_V
#undef PG8_WAIT_L
#undef PG8_BAR
#undef PG8_SCHED
}
}

struct EpiSwiglu {
    static constexpr bool PERM = true;
    bf16_t* O;
    __device__ __forceinline__ void operator()(const f32x4 (&acc)[2][2][4][2], const pg8::Unit& u, int wr, int wc, int fr, int fq) const {
        const int row0 = u.pm * 256 + wr * 64 + fr, col0 = u.pn * 128 + wc * 32 + 8 * fq;
#pragma unroll
        for (int ai = 0; ai < 2; ++ai)
#pragma unroll
            for (int m = 0; m < 4; ++m) {
                bf16_t* rowp = O + (size_t)(row0 + ai * 128 + m * 16) * FF + col0;
                const f32x4 a0 = acc[ai][0][m][0], a1 = acc[ai][0][m][1], b0 = acc[ai][1][m][0], b1 = acc[ai][1][m][1];
                u32x4 w;
                w.x = cvtpk(silu_f(a0[0]) * b0[0], silu_f(a0[1]) * b0[1]); w.y = cvtpk(silu_f(a0[2]) * b0[2], silu_f(a0[3]) * b0[3]);
                w.z = cvtpk(silu_f(a1[0]) * b1[0], silu_f(a1[1]) * b1[1]); w.w = cvtpk(silu_f(a1[2]) * b1[2], silu_f(a1[3]) * b1[3]);
                *(u32x4*)rowp = w;
            }
    }
};
struct EpiResid {
    static constexpr bool PERM = false;
    const float* xin; float* xout; const float* gate; float coef;
    __device__ __forceinline__ void operator()(const f32x4 (&acc)[2][2][4][2], const pg8::Unit& u, int wr, int wc, int fr, int fq) const {
        const int b = (u.pm * 256) >> 11;
        const int row0 = u.pm * 256 + wr * 64 + fr;
#pragma unroll
        for (int bj = 0; bj < 2; ++bj)
#pragma unroll
            for (int n = 0; n < 2; ++n) {
                const int col = u.pn * 256 + bj * 128 + wc * 32 + n * 16 + 4 * fq;
                const f32x4 gv = *(const f32x4*)(gate + (size_t)b * NADA + col) * coef;
                f32x4 xv[2][4];
#pragma unroll
                for (int ai = 0; ai < 2; ++ai)
#pragma unroll
                    for (int m = 0; m < 4; ++m) xv[ai][m] = *(const f32x4*)(xin + (size_t)(row0 + ai * 128 + m * 16) * DM + col);
#pragma unroll
                for (int ai = 0; ai < 2; ++ai)
#pragma unroll
                    for (int m = 0; m < 4; ++m) {
                        const size_t off = (size_t)(row0 + ai * 128 + m * 16) * DM + col;
                        *(f32x4*)(xout + off) = xv[ai][m] + gv * acc[ai][bj][m][n];
                    }
            }
    }
};
struct EpiGelu {
    static constexpr bool PERM = true;
    bf16_t* O; const float* bias;
    __device__ __forceinline__ void operator()(const f32x4 (&acc)[2][2][4][2], const pg8::Unit& u, int wr, int wc, int fr, int fq) const {
        const int row0 = u.pm * 256 + wr * 64 + fr;
#pragma unroll
        for (int bj = 0; bj < 2; ++bj) {
            const int col0 = u.pn * 256 + bj * 128 + wc * 32 + 8 * fq;
            const f32x4 bv0 = *(const f32x4*)(bias + col0), bv1 = *(const f32x4*)(bias + col0 + 4);
#pragma unroll
            for (int ai = 0; ai < 2; ++ai)
#pragma unroll
                for (int m = 0; m < 4; ++m) {
                    const f32x4 v0 = acc[ai][bj][m][0] + bv0, v1 = acc[ai][bj][m][1] + bv1;
                    u32x4 w;
                    w.x = cvtpk(gelu_tanh(v0[0]), gelu_tanh(v0[1])); w.y = cvtpk(gelu_tanh(v0[2]), gelu_tanh(v0[3]));
                    w.z = cvtpk(gelu_tanh(v1[0]), gelu_tanh(v1[1])); w.w = cvtpk(gelu_tanh(v1[2]), gelu_tanh(v1[3]));
                    *(u32x4*)(O + (size_t)(row0 + ai * 128 + m * 16) * 256 + col0) = w;
                }
        }
    }
};
struct EpiInProj {
    static constexpr bool PERM = true;
    unsigned char* ws; const float* fbias;
    __device__ __forceinline__ void operator()(const f32x4 (&acc)[2][2][4][2], const pg8::Unit& u, int wr, int wc, int fr, int fq) const {
        part<0>(acc, u, wr, wc, fr, fq); part<1>(acc, u, wr, wc, fr, fq);
    }
    template <int bj>
    __device__ __forceinline__ void part(const f32x4 (&acc)[2][2][4][2], const pg8::Unit& u, int wr, int wc, int fr, int fq) const {
        const float* cosT = (const float*)(ws + WS_COS); const float* sinT = (const float*)(ws + WS_SIN);
        {
            const int cb = u.pn * 256 + bj * 128 + wc * 32;
            const int hg = cb >> 6, half = (cb >> 5) & 1;
            if (hg > 44) return;
            int mode, NH = 1, hd = 0, pitch = 0; bool rope = false; bf16_t* base = nullptr;
            if (hg < 8)       { mode = 0; base = (bf16_t*)(ws + WS_QNSA); pitch = 512; hd = hg; rope = true; }
            else if (hg < 10) { mode = 1; base = (bf16_t*)(ws + WS_KC); NH = 2; hd = hg - 8; rope = true; }
            else if (hg < 12) { mode = 4; base = (bf16_t*)(ws + WS_KS); NH = 2; hd = hg - 10; rope = true; }
            else if (hg < 14) { mode = 4; base = (bf16_t*)(ws + WS_KW); NH = 2; hd = hg - 12; rope = true; }
            else if (hg < 18) { mode = 0; base = (bf16_t*)(ws + WS_FOXQ); pitch = 256; hd = hg - 14; }
            else if (hg < 22) { mode = 4; base = (bf16_t*)(ws + WS_FOXK); NH = 4; hd = hg - 18; }
            else if (hg < 26) { mode = 0; base = (bf16_t*)(ws + WS_MOBAQ); pitch = 256; hd = hg - 22; rope = true; }
            else if (hg < 30) { mode = 4; base = (bf16_t*)(ws + WS_MOBAK); NH = 4; hd = hg - 26; rope = true; }
            else if (hg < 32) { mode = 1; base = (bf16_t*)(ws + WS_VC); NH = 2; hd = hg - 30; }
            else if (hg < 34) { mode = 2; base = (bf16_t*)(ws + WS_VST); NH = 2; hd = hg - 32; }
            else if (hg < 36) { mode = 2; base = (bf16_t*)(ws + WS_VWT); NH = 2; hd = hg - 34; }
            else if (hg < 40) { mode = 2; base = (bf16_t*)(ws + WS_FOXVT); NH = 4; hd = hg - 36; }
            else if (hg < 44) { mode = 2; base = (bf16_t*)(ws + WS_MOBAVT); NH = 4; hd = hg - 40; }
            else { mode = 3; if (half) return; }
            const bool do_rope = rope && (half == 0);
#pragma unroll
            for (int ai = 0; ai < 2; ++ai)
#pragma unroll
                for (int m = 0; m < 4; ++m) {
                    const int row = u.pm * 256 + ai * 128 + wr * 64 + m * 16 + fr;
                    const int b = row >> 11, t = row & 2047;
                    float v[8];
#pragma unroll
                    for (int i = 0; i < 4; ++i) { v[i] = acc[ai][bj][m][0][i]; v[4 + i] = acc[ai][bj][m][1][i]; }
                    if (do_rope) {
                        float pr[8];
#pragma unroll
                        for (int i = 0; i < 8; ++i) pr[i] = __shfl_xor(v[i], 16);
                        if (fq < 2) {
                            const f32x4 c0 = *(const f32x4*)(cosT + (size_t)row * 8), c1 = *(const f32x4*)(cosT + (size_t)row * 8 + 4);
                            const f32x4 s0 = *(const f32x4*)(sinT + (size_t)row * 8), s1 = *(const f32x4*)(sinT + (size_t)row * 8 + 4);
                            const float sg = (fq == 0) ? -1.0f : 1.0f;
#pragma unroll
                            for (int i = 0; i < 4; ++i) { v[i] = v[i] * c0[i] + sg * pr[i] * s0[i]; v[4 + i] = v[4 + i] * c1[i] + sg * pr[4 + i] * s1[i]; }
                        }
                    }
                    if (mode == 3) {
                        float* gates = (float*)(ws + WS_GATES); float* flog = (float*)(ws + WS_FLOG);
                        if (fq < 3) {
                            f32x4 g0, g1;
#pragma unroll
                            for (int i = 0; i < 4; ++i) { g0[i] = sigmoid_f(v[i]); g1[i] = sigmoid_f(v[4 + i]); }
                            *(f32x4*)(gates + (size_t)row * 24 + 8 * fq) = g0; *(f32x4*)(gates + (size_t)row * 24 + 8 * fq + 4) = g1;
                        } else {
#pragma unroll
                            for (int i = 0; i < 4; ++i) {
                                const float z = v[i] + fbias[i];
                                const float ls = (z > 0.f) ? -log1pf(__expf(-z)) : (z - log1pf(__expf(z)));
                                flog[(size_t)(b * 4 + i) * SEQ + t] = ls;
                            }
                        }
                    } else {
                        u32x4 w; w.x = cvtpk(v[0], v[1]); w.y = cvtpk(v[2], v[3]); w.z = cvtpk(v[4], v[5]); w.w = cvtpk(v[6], v[7]);
                        const int dcol = half * 32 + 8 * fq;
                        if (mode == 0) *(u32x4*)(base + (size_t)row * pitch + hd * 64 + dcol) = w;
                        else if (mode == 1) *(u32x4*)(base + ((size_t)(b * NH + hd) * SEQ + t) * 64 + dcol) = w;
                        else if (mode == 4) {
                            const int d0 = half * 2 + (fq >> 1), khi = fq & 1;
                            *(u32x4*)(base + (size_t)(b * NH + hd) * SEQ * 64 + (size_t)(t >> 6) * 4096 + ((((t >> 5) & 1) * 4 + d0) * 64 + khi * 32 + (t & 31)) * 8) = w;
                        } else {
                            const int tt = t & 63, hf = tt >> 5, jj = (tt >> 4) & 1, piece = (tt >> 3) & 1, vhi = (tt >> 2) & 1, e = tt & 3;
                            bf16_t* p = base + (size_t)(b * NH + hd) * SEQ * 64 + (size_t)(t >> 6) * 4096 + (((hf * 2 + jj) * 2 + half) * 64 + vhi * 32 + 8 * fq) * 8 + piece * 4 + e;
                            p[0 * 8] = (bf16_t)(w.x & 0xffffu); p[1 * 8] = (bf16_t)(w.x >> 16);
                            p[2 * 8] = (bf16_t)(w.y & 0xffffu); p[3 * 8] = (bf16_t)(w.y >> 16);
                            p[4 * 8] = (bf16_t)(w.z & 0xffffu); p[5 * 8] = (bf16_t)(w.z >> 16);
                            p[6 * 8] = (bf16_t)(w.w & 0xffffu); p[7 * 8] = (bf16_t)(w.w >> 16);
                        }
                    }
                }
        }
    }
};

#define MFMA32(a, b, c) __builtin_amdgcn_mfma_f32_32x32x16_bf16((a), (b), (c), 0, 0, 0)
__device__ __forceinline__ f32x16 qk32(const bf16_t* kp, const bf16x8 (&qf)[4]) {
    f32x16 p;
#pragma unroll
    for (int r = 0; r < 16; ++r) p[r] = 0.f;
#pragma unroll
    for (int d0 = 0; d0 < 4; ++d0) { const bf16x8 kf = *(const bf16x8*)(kp + 16 * d0); p = MFMA32(kf, qf[d0], p); }
    return p;
}
__device__ __forceinline__ void pv32(f32x16 (&o)[2], const bf16_t* vp, int vpitch, const f32x16& p) {
#pragma unroll
    for (int j = 0; j < 2; ++j) {
        u32x4 pw; pw.x = cvtpk(p[8 * j + 0], p[8 * j + 1]); pw.y = cvtpk(p[8 * j + 2], p[8 * j + 3]); pw.z = cvtpk(p[8 * j + 4], p[8 * j + 5]); pw.w = cvtpk(p[8 * j + 6], p[8 * j + 7]);
        const bf16x8 pb = __builtin_bit_cast(bf16x8, pw);
#pragma unroll
        for (int dh = 0; dh < 2; ++dh) {
            const bf16_t* q = vp + (size_t)dh * 32 * vpitch + 16 * j;
            const s16x4 lo = *(const s16x4*)q, hi4 = *(const s16x4*)(q + 8);
            const bf16x8 va = (bf16x8){lo[0], lo[1], lo[2], lo[3], hi4[0], hi4[1], hi4[2], hi4[3]};
            o[dh] = MFMA32(va, pb, o[dh]);
        }
    }
}
__device__ __forceinline__ void load_k64(bf16x8 (&kf)[8], const bf16_t* ktile, int lane) {
    const bf16_t* p = ktile + lane * 8;
#pragma unroll
    for (int i = 0; i < 8; ++i) kf[i] = *(const bf16x8*)(p + i * 512);
}
__device__ __forceinline__ void load_v64(bf16x8 (&vf)[8], const bf16_t* vtile, int lane) {
    const bf16_t* p = vtile + lane * 8;
#pragma unroll
    for (int i = 0; i < 8; ++i) vf[i] = *(const bf16x8*)(p + i * 512);
}
template <int MODE, int MK>
__device__ __forceinline__ void softmax_pv(f32x16 (&o)[2], float& m, float& l, f32x16& p0, f32x16& p1, const bf16x8 (&vf)[8],
                                           int kb, int t, bool tsel, const float* F8, float Fq8, int hi) {
    if (MK == 2) {
#pragma unroll
        for (int r = 0; r < 16; ++r) {
            const int k0 = kb + crow(r, hi), k1 = k0 + 32;
            bool v0, v1;
            if (MODE == 0) { v0 = tsel && (k0 <= t); v1 = tsel && (k1 <= t); }
            else if (MODE == 1) { v0 = (k0 <= t) && (k0 > t - 512); v1 = (k1 <= t) && (k1 > t - 512); }
            else { v0 = (k0 <= t); v1 = (k1 <= t); }
            p0[r] = v0 ? p0[r] : NEG_INF; p1[r] = v1 ? p1[r] : NEG_INF;
        }
    }
    float mx = fmaxf(p0[0], p1[0]);
#pragma unroll
    for (int r = 1; r < 16; ++r) mx = fmaxf(mx, fmaxf(p0[r], p1[r]));
    if (MK == 1) mx = tsel ? mx : NEG_INF;
    mx = fmaxf(mx, __shfl_xor(mx, 32));
    const float mnew = fmaxf(m, mx);
    const float msafe = (mnew == NEG_INF) ? 0.f : mnew;
    const float alpha = fast_exp2((m - msafe) * QK_C2);
    float nm = -msafe * QK_C2;
    if (MK == 1) nm = tsel ? nm : NEG_INF;
    float ps = 0.f;
#pragma unroll
    for (int r = 0; r < 16; ++r) { p0[r] = fast_exp2(__builtin_fmaf(p0[r], QK_C2, nm)); p1[r] = fast_exp2(__builtin_fmaf(p1[r], QK_C2, nm)); ps += p0[r] + p1[r]; }
    l = l * alpha + ps; m = mnew;
#pragma unroll
    for (int r = 0; r < 16; ++r) { o[0][r] *= alpha; o[1][r] *= alpha; }
#pragma unroll
    for (int hf = 0; hf < 2; ++hf)
#pragma unroll
        for (int j = 0; j < 2; ++j) {
            const f32x16& p = hf ? p1 : p0;
            u32x4 pw; pw.x = cvtpk(p[8 * j + 0], p[8 * j + 1]); pw.y = cvtpk(p[8 * j + 2], p[8 * j + 3]); pw.z = cvtpk(p[8 * j + 4], p[8 * j + 5]); pw.w = cvtpk(p[8 * j + 6], p[8 * j + 7]);
            const bf16x8 pb = __builtin_bit_cast(bf16x8, pw);
#pragma unroll
            for (int dh = 0; dh < 2; ++dh) o[dh] = MFMA32(vf[(hf * 2 + j) * 2 + dh], pb, o[dh]);
        }
}
template <int MODE, class Sel>
__device__ __forceinline__ void flash_loop(f32x16 (&o)[2], float& m, float& l, const bf16x8 (&qf)[4], const bf16_t* K, const bf16_t* Vt,
                                           int jlo, int jhi, int t, int tmin, int tmax, Sel sel, const float* F8, float Fq8, int lane) {
    const int hi = lane >> 5;
    int j = jlo;
    for (; j <= jhi; ++j) { if (__any(sel(j))) break; }
    bf16x8 kf[8], vf[8];
    if (j <= jhi) load_k64(kf, K + (size_t)j * 4096, lane);
    while (j <= jhi) {
        int jn = j + 1;
        for (; jn <= jhi; ++jn) { if (__any(sel(jn))) break; }
        load_v64(vf, Vt + (size_t)j * 4096, lane);
        f32x16 p0, p1;
        const int kb = j * 64;
        if (MODE == 2) {
#pragma unroll
            for (int g = 0; g < 4; ++g) {
                const f32x4 fa = *(const f32x4*)(F8 + kb + 8 * g + 4 * hi), fbv = *(const f32x4*)(F8 + kb + 32 + 8 * g + 4 * hi);
#pragma unroll
                for (int i = 0; i < 4; ++i) { p0[4 * g + i] = fa[i]; p1[4 * g + i] = fbv[i]; }
            }
        } else {
#pragma unroll
            for (int r = 0; r < 16; ++r) { p0[r] = 0.f; p1[r] = 0.f; }
        }
#pragma unroll
        for (int d0 = 0; d0 < 4; ++d0) { p0 = MFMA32(kf[d0], qf[d0], p0); p1 = MFMA32(kf[4 + d0], qf[d0], p1); }
        if (jn <= jhi) load_k64(kf, K + (size_t)jn * 4096, lane);
        bool full = (kb + 63 <= tmin);
        if (MODE == 1) full = full && (kb > tmax - 512);
        if (full) {
            if (MODE == 0 && !__all(sel(j))) softmax_pv<MODE, 1>(o, m, l, p0, p1, vf, kb, t, sel(j), F8, Fq8, hi);
            else softmax_pv<MODE, 0>(o, m, l, p0, p1, vf, kb, t, true, F8, Fq8, hi);
        } else softmax_pv<MODE, 2>(o, m, l, p0, p1, vf, kb, t, sel(j), F8, Fq8, hi);
        j = jn;
    }
}
__device__ __forceinline__ void load_q(bf16x8 (&qf)[4], const bf16_t* qrow, int hi) {
#pragma unroll
    for (int d0 = 0; d0 < 4; ++d0) qf[d0] = *(const bf16x8*)(qrow + 16 * d0 + 8 * hi);
}
__device__ __forceinline__ void store_o(bf16_t* dst, const f32x16 (&o)[2], int hi) {
#pragma unroll
    for (int dh = 0; dh < 2; ++dh)
#pragma unroll
        for (int g = 0; g < 4; ++g) {
            u32x2 w; w.x = cvtpk(o[dh][4 * g + 0], o[dh][4 * g + 1]); w.y = cvtpk(o[dh][4 * g + 2], o[dh][4 * g + 3]);
            *(u32x2*)(dst + 32 * dh + 8 * g + 4 * hi) = w;
        }
}
__device__ __forceinline__ unsigned nsa_select(const float (&imp)[32], int t) {
    const int tb = t >> 6;
    unsigned sel = 1u | (1u << tb) | (1u << (tb > 0 ? tb - 1 : 0));
#pragma unroll
    for (int it = 0; it < 5; ++it) {
        float bv = NEG_INF; int bj = -1;
#pragma unroll
        for (int j = 1; j < 32; ++j) { const bool cand = (j <= tb - 2) && !((sel >> j) & 1u) && (imp[j] > bv); if (cand) { bv = imp[j]; bj = j; } }
        if (bj >= 0) sel |= 1u << bj;
    }
    if (tb <= 7) sel = (2u << tb) - 1u;
    return sel;
}

__device__ __forceinline__ void nsa_unit(unsigned char* ws, int b, int g, int qg, int lane, float* wl) {
    const int hi = lane >> 5, c = lane & 31;
    const int t = qg * 8 + (c >> 2), head = g * 4 + (c & 3), row = b * SEQ + t, bg = b * 2 + g;
    bf16x8 qf[4];
    load_q(qf, (const bf16_t*)(ws + WS_QNSA) + (size_t)row * 512 + head * 64, hi);
    const float* gp = (const float*)(ws + WS_GATES) + (size_t)row * 24 + head * 3;
    const float g0 = gp[0];
    f32x16 o[2];
    float* oa = wl + 256 + lane;
    {
        const bf16_t* Kc = (const bf16_t*)(ws + WS_KCMP) + (size_t)bg * 8192;
        const bf16_t* Vct = (const bf16_t*)(ws + WS_VCMPT) + (size_t)bg * 8192;
        f32x16 s[4];
        float mx = NEG_INF;
#pragma unroll
        for (int tile = 0; tile < 2; ++tile) {
            bf16x8 kf[8];
            load_k64(kf, Kc + tile * 4096, lane);
#pragma unroll
            for (int hf = 0; hf < 2; ++hf) {
                const int grp = tile * 2 + hf;
#pragma unroll
                for (int r = 0; r < 16; ++r) s[grp][r] = 0.f;
#pragma unroll
                for (int d0 = 0; d0 < 4; ++d0) s[grp] = MFMA32(kf[hf * 4 + d0], qf[d0], s[grp]);
#pragma unroll
                for (int r = 0; r < 16; ++r) {
                    const int key = 32 * grp + crow(r, hi);
                    const float v = (16 * key + 31 <= t) ? s[grp][r] * QK_C2 : NEG_INF;
                    s[grp][r] = v; mx = fmaxf(mx, v);
                }
            }
        }
        mx = fmaxf(mx, __shfl_xor(mx, 32));
        const float msafe = (mx == NEG_INF) ? 0.f : mx;
        float ps = 0.f;
#pragma unroll
        for (int grp = 0; grp < 4; ++grp)
#pragma unroll
            for (int r = 0; r < 16; ++r) { s[grp][r] = fast_exp2(s[grp][r] - msafe); ps += s[grp][r]; }
        ps += __shfl_xor(ps, 32);
        const float inv = 1.0f / fmaxf(ps, 1e-30f);
#pragma unroll
        for (int grp = 0; grp < 4; ++grp)
#pragma unroll
            for (int r = 0; r < 16; ++r) s[grp][r] *= inv;
#pragma unroll
        for (int r = 0; r < 16; ++r) { o[0][r] = 0.f; o[1][r] = 0.f; }
#pragma unroll
        for (int tile = 0; tile < 2; ++tile) {
            bf16x8 vf[8];
            load_v64(vf, Vct + tile * 4096, lane);
#pragma unroll
            for (int hf = 0; hf < 2; ++hf)
#pragma unroll
                for (int j = 0; j < 2; ++j) {
                    const f32x16& p = s[tile * 2 + hf];
                    u32x4 pw; pw.x = cvtpk(p[8 * j + 0], p[8 * j + 1]); pw.y = cvtpk(p[8 * j + 2], p[8 * j + 3]); pw.z = cvtpk(p[8 * j + 4], p[8 * j + 5]); pw.w = cvtpk(p[8 * j + 6], p[8 * j + 7]);
                    const bf16x8 pb = __builtin_bit_cast(bf16x8, pw);
#pragma unroll
                    for (int dh = 0; dh < 2; ++dh) o[dh] = MFMA32(vf[(hf * 2 + j) * 2 + dh], pb, o[dh]);
                }
        }
#pragma unroll
        for (int r = 0; r < 16; ++r) { oa[r * 64] = g0 * o[0][r]; oa[(16 + r) * 64] = g0 * o[1][r]; }
        float recv[4][4];
#pragma unroll
        for (int grp = 0; grp < 4; ++grp)
#pragma unroll
            for (int gq = 0; gq < 4; ++gq) recv[grp][gq] = __shfl_xor(s[grp][4 * gq + 3], 32);
#pragma unroll
        for (int grp = 0; grp < 4; ++grp)
#pragma unroll
            for (int gq = 0; gq < 4; ++gq) {
                const float own = (s[grp][4 * gq] + s[grp][4 * gq + 1]) + (s[grp][4 * gq + 2] + s[grp][4 * gq + 3]);
                const float plo = (gq > 0) ? recv[grp][gq > 0 ? gq - 1 : 0] : ((grp > 0) ? recv[grp > 0 ? grp - 1 : 0][3] : 0.f);
                const float prev = hi ? recv[grp][gq] : plo;
                float v = own + prev;
                v += __shfl_xor(v, 1); v += __shfl_xor(v, 2);
                if ((c & 3) == 0) wl[(c >> 2) * 32 + 8 * grp + 2 * gq + hi] = v;
            }
    }
    asm volatile("s_waitcnt lgkmcnt(0)" ::: "memory");
    float imp[32];
#pragma unroll
    for (int j4 = 0; j4 < 8; ++j4) { const f32x4 v = *(const f32x4*)(wl + (c >> 2) * 32 + 4 * j4); imp[4 * j4] = v[0]; imp[4 * j4 + 1] = v[1]; imp[4 * j4 + 2] = v[2]; imp[4 * j4 + 3] = v[3]; }
    asm volatile("s_waitcnt lgkmcnt(0)" ::: "memory");
    const unsigned sel = nsa_select(imp, t);
    const int jmax = (qg * 8 + 7) >> 6;
    {
        const bf16_t* Ks = (const bf16_t*)(ws + WS_KS) + (size_t)bg * SEQ * 64;
        const bf16_t* Vst = (const bf16_t*)(ws + WS_VST) + (size_t)bg * 64 * SEQ;
        float m = NEG_INF, l = 0.f;
#pragma unroll
        for (int r = 0; r < 16; ++r) { o[0][r] = 0.f; o[1][r] = 0.f; }
        flash_loop<0>(o, m, l, qf, Ks, Vst, 0, jmax, t, qg * 8, qg * 8 + 7, [&](int j) { return (bool)((sel >> j) & 1u); }, nullptr, 0.f, lane);
        l += __shfl_xor(l, 32);
        const float sc = gp[1] / fmaxf(l, 1e-30f);
#pragma unroll
        for (int r = 0; r < 16; ++r) { oa[r * 64] += sc * o[0][r]; oa[(16 + r) * 64] += sc * o[1][r]; }
        asm volatile("s_waitcnt lgkmcnt(0)" ::: "memory");
    }
    {
        const bf16_t* Kw = (const bf16_t*)(ws + WS_KW) + (size_t)bg * SEQ * 64;
        const bf16_t* Vwt = (const bf16_t*)(ws + WS_VWT) + (size_t)bg * 64 * SEQ;
        float m = NEG_INF, l = 0.f;
#pragma unroll
        for (int r = 0; r < 16; ++r) { o[0][r] = 0.f; o[1][r] = 0.f; }
        const int tl = qg * 8 - 511;
        const int jlo = (tl > 0 ? tl : 0) >> 6;
        flash_loop<1>(o, m, l, qf, Kw, Vwt, jlo, jmax, t, qg * 8, qg * 8 + 7, [&](int) { return true; }, nullptr, 0.f, lane);
        l += __shfl_xor(l, 32);
        const float sc = gp[2] / fmaxf(l, 1e-30f);
#pragma unroll
        for (int r = 0; r < 16; ++r) { o[0][r] = oa[r * 64] + sc * o[0][r]; o[1][r] = oa[(16 + r) * 64] + sc * o[1][r]; }
        asm volatile("s_waitcnt lgkmcnt(0)" ::: "memory");
    }
    store_o((bf16_t*)(ws + WS_H) + (size_t)row * DM + head * 64, o, hi);
}

__device__ __forceinline__ void fox_unit(unsigned char* ws, int bh, int qt, int lane) {
    const int hi = lane >> 5, c = lane & 31, b = bh >> 2, h = bh & 3;
    const int t = qt * 32 + c, row = b * SEQ + t;
    bf16x8 qf[4];
    load_q(qf, (const bf16_t*)(ws + WS_FOXQ) + (size_t)row * 256 + h * 64, hi);
    const bf16_t* K = (const bf16_t*)(ws + WS_FOXK) + (size_t)bh * SEQ * 64;
    const bf16_t* Vt = (const bf16_t*)(ws + WS_FOXVT) + (size_t)bh * 64 * SEQ;
    const float* F2 = (const float*)(ws + WS_FCUM) + (size_t)bh * SEQ;
    const float Fq2 = F2[t];
    f32x16 o[2]; float m = NEG_INF, l = 0.f;
#pragma unroll
    for (int r = 0; r < 16; ++r) { o[0][r] = 0.f; o[1][r] = 0.f; }
    const int jmax = (qt * 32 + 31) >> 6;
    flash_loop<2>(o, m, l, qf, K, Vt, 0, jmax, t, qt * 32, qt * 32 + 31, [&](int) { return true; }, F2, Fq2, lane);
    l += __shfl_xor(l, 32);
    const float sc = 1.0f / fmaxf(l, 1e-30f);
#pragma unroll
    for (int r = 0; r < 16; ++r) { o[0][r] *= sc; o[1][r] *= sc; }
    store_o((bf16_t*)(ws + WS_H) + (size_t)row * DM + 512 + h * 64, o, hi);
}

__device__ __forceinline__ void moba_unit(unsigned char* ws, int bh, int qt, int lane) {
    const int hi = lane >> 5, c = lane & 31, b = bh >> 2, h = bh & 3;
    const int t = qt * 32 + c, row = b * SEQ + t;
    bf16x8 qf[4];
    load_q(qf, (const bf16_t*)(ws + WS_MOBAQ) + (size_t)row * 256 + h * 64, hi);
    const bf16_t* K = (const bf16_t*)(ws + WS_MOBAK) + (size_t)bh * SEQ * 64;
    const bf16_t* Vt = (const bf16_t*)(ws + WS_MOBAVT) + (size_t)bh * 64 * SEQ;
    const int own = (qt * 32) >> 8;
    unsigned sel = 0u;
    {
        float gt[7];
        const float* km = (const float*)(ws + WS_KMEAN) + (size_t)bh * 8 * 64;
#pragma unroll
        for (int blk = 0; blk < 7; ++blk) {
            float a = 0.f;
            if (blk < own) {
#pragma unroll
                for (int d0 = 0; d0 < 4; ++d0) {
                    const f32x4 k0 = *(const f32x4*)(km + blk * 64 + 16 * d0 + 8 * hi), k1 = *(const f32x4*)(km + blk * 64 + 16 * d0 + 8 * hi + 4);
#pragma unroll
                    for (int i = 0; i < 4; ++i) { a += bf2f(qf[d0][i]) * k0[i]; a += bf2f(qf[d0][4 + i]) * k1[i]; }
                }
                a += __shfl_xor(a, 32);
            }
            gt[blk] = a;
        }
#pragma unroll
        for (int it = 0; it < 3; ++it) {
            float bv = NEG_INF; int bj = -1;
#pragma unroll
            for (int blk = 0; blk < 7; ++blk) { const bool cand = (blk < own) && !((sel >> blk) & 1u) && (gt[blk] > bv); if (cand) { bv = gt[blk]; bj = blk; } }
            if (bj >= 0) sel |= 1u << bj;
        }
    }
    f32x16 o[2]; float m = NEG_INF, l = 0.f;
#pragma unroll
    for (int r = 0; r < 16; ++r) { o[0][r] = 0.f; o[1][r] = 0.f; }
    const int jmax = (qt * 32 + 31) >> 6;
    flash_loop<0>(o, m, l, qf, K, Vt, 0, jmax, t, qt * 32, qt * 32 + 31, [&](int j) { const int blk = j >> 2; return (blk == own) || (bool)((sel >> blk) & 1u); }, nullptr, 0.f, lane);
    l += __shfl_xor(l, 32);
    const float sc = 1.0f / fmaxf(l, 1e-30f);
#pragma unroll
    for (int r = 0; r < 16; ++r) { o[0][r] *= sc; o[1][r] *= sc; }
    store_o((bf16_t*)(ws + WS_H) + (size_t)row * DM + 768 + h * 64, o, hi);
}


#define XB_TMO      128
#define XB_XCNT(j)  (256  + 64 * (j))
#define XB_XSUB(j)  (1280 + 64 * (j))
#define XB_XGEN(j)  (2304 + 64 * (j))
#define XB_TOP      3328
#define XB_TOPGEN   3392
#define XCD_BAR_WORDS 3456
#define XB_SPIN_CAP (1u << 22)
__device__ __forceinline__ unsigned xb_ld(unsigned* p)              { return __hip_atomic_load(p, __ATOMIC_RELAXED, __HIP_MEMORY_SCOPE_AGENT); }
__device__ __forceinline__ unsigned xb_add(unsigned* p, unsigned v) { return __hip_atomic_fetch_add(p, v, __ATOMIC_RELAXED, __HIP_MEMORY_SCOPE_AGENT); }
__device__ __forceinline__ unsigned xb_xcc_id() { return (unsigned)__builtin_amdgcn_s_getreg((3 << 11) | 20) & 0xFu; }
#define XB_SPIN(cond, bar) do { unsigned _sp = 0; while (cond) { __builtin_amdgcn_s_sleep(1); \
    if ((++_sp & 255u) == 0u) { if (xb_ld(&(bar)[XB_TMO])) break; if (_sp > XB_SPIN_CAP) { atomicAdd(&(bar)[XB_TMO], 1u); break; } } } } while (0)
__device__ __forceinline__ void xcd_barrier_post(unsigned* bar, unsigned x, volatile LAS unsigned* st) {
    if (threadIdx.x == 0) st[2] = xb_add(&bar[XB_XCNT(x)], 1u);
}
__device__ __forceinline__ void xcd_barrier_complete(unsigned* bar, unsigned x, unsigned& nloc, unsigned& nx) {
    const unsigned G = gridDim.x * gridDim.y * gridDim.z;
    unsigned sum, cnt, mine, sp = 0u;
    for (;;) {
        sum = 0u; cnt = 0u; mine = 0u;
#pragma unroll
        for (unsigned j = 0; j < 16; ++j) { const unsigned c = xb_ld(&bar[XB_XCNT(j)]); sum += c; cnt += (c > 0u) ? 1u : 0u; mine = (j == x) ? c : mine; }
        if (sum == G) break;
        __builtin_amdgcn_s_sleep(1);
        if ((++sp & 255u) == 0u) { if (xb_ld(&bar[XB_TMO])) break; if (sp > XB_SPIN_CAP) { atomicAdd(&bar[XB_TMO], 1u); break; } }
    }
    nloc = mine > 0u ? mine : 1u; nx = cnt > 0u ? cnt : 1u;
}
__device__ __forceinline__ void xcd_barrier(unsigned* bar_, unsigned x_, volatile LAS unsigned* st, bool leader) {
    asm volatile("s_waitcnt vmcnt(0)" ::: "memory");
    __syncthreads();
    if (leader) {
        size_t zo = 0; unsigned x = x_;
        asm volatile("" : "+s"(zo), "+s"(x));
        unsigned* bar = bar_ + zo;
        __builtin_amdgcn_s_waitcnt(0);
        unsigned nloc = st[0], nx = st[1];
        if (nloc == 0u) { xcd_barrier_complete(bar, x, nloc, nx); st[0] = nloc; st[1] = nx; }
        const unsigned old = xb_add(&bar[XB_XSUB(x)], 1u);
        const unsigned gen = old / nloc;
        if (old + 1u == (gen + 1u) * nloc) {
            __builtin_amdgcn_fence(__ATOMIC_RELEASE, "agent");
            asm volatile("s_waitcnt vmcnt(0)" ::: "memory");
            const unsigned og = xb_add(&bar[XB_TOP], 1u);
            const unsigned tg = og / nx;
            if (og + 1u == (tg + 1u) * nx) xb_add(&bar[XB_TOPGEN], 1u);
            else XB_SPIN(xb_ld(&bar[XB_TOPGEN]) == tg, bar);
            __builtin_amdgcn_fence(__ATOMIC_ACQUIRE, "agent");
            xb_add(&bar[XB_XGEN(x)], 1u);
            asm volatile("s_waitcnt vmcnt(0)" ::: "memory");
        } else {
            XB_SPIN(xb_ld(&bar[XB_XGEN(x)]) == gen, bar);
            __builtin_amdgcn_fence(__ATOMIC_ACQUIRE, "agent");
            asm volatile("s_waitcnt vmcnt(0)" ::: "memory");
        }
    }
    __syncthreads();
}

__device__ __forceinline__ int map_identity(int n) { return n; }
__device__ __forceinline__ int map_w13(int n) { const int tile = n >> 8, w = n & 255; return (w < 128) ? tile * 128 + w : FF + tile * 128 + (w - 128); }
__device__ __forceinline__ int map_win(int n) {
    if (n < 640) return n;
    if (n < 768) return n - 640 + 768;
    if (n < 896) return n - 768 + 1024;
    if (n < 1152) return n - 896 + 1304;
    if (n < 1408) return n - 1152 + 1560;
    if (n < 1664) return n - 1408 + 2076;
    if (n < 1920) return n - 1664 + 2332;
    if (n < 2048) return n - 1920 + 640;
    if (n < 2176) return n - 2048 + 896;
    if (n < 2304) return n - 2176 + 1152;
    if (n < 2560) return n - 2304 + 1816;
    if (n < 2816) return n - 2560 + 2588;
    if (n < 2840) return n - 2816 + 1280;
    if (n < 2844) return n - 2840 + 2072;
    return -1;
}
template <int MAP>
__device__ __forceinline__ void transpose_item(const float* W, int K, int Nsrc, int Ndst, bf16_t* WT, float* scr, int item, int lane) {
    const int nblk = Ndst / 64, kb = item / nblk, nb = item % nblk, k0 = 64 * kb, n0 = 64 * nb;
    const int nq = (lane & 15) * 4, nd = n0 + nq;
    const int src = (MAP == 0) ? map_identity(nd) : (MAP == 1) ? map_w13(nd) : map_win(nd);
    f32x4 v[16];
#pragma unroll
    for (int i = 0; i < 16; ++i) { const int kk = 4 * i + (lane >> 4); v[i] = (src >= 0) ? *(const f32x4*)(W + (size_t)(k0 + kk) * Nsrc + src) : (f32x4){0.f, 0.f, 0.f, 0.f}; }
#pragma unroll
    for (int i = 0; i < 16; ++i) { const int kk = 4 * i + (lane >> 4); float* d = scr + kk * 65 + nq; d[0] = v[i][0]; d[1] = v[i][1]; d[2] = v[i][2]; d[3] = v[i][3]; }
    asm volatile("s_waitcnt lgkmcnt(0)" ::: "memory");
    const int cc = lane & 7;
#pragma unroll
    for (int j = 0; j < 8; ++j) { const int n = (lane >> 3) + 8 * j; const float* sp = scr + (8 * cc) * 65 + n;
        u32x4 ov; ov.x = cvtpk(sp[0 * 65], sp[1 * 65]); ov.y = cvtpk(sp[2 * 65], sp[3 * 65]); ov.z = cvtpk(sp[4 * 65], sp[5 * 65]); ov.w = cvtpk(sp[6 * 65], sp[7 * 65]);
        *(u32x4*)(WT + (size_t)(n0 + n) * K + k0 + 8 * cc) = ov; }
    asm volatile("s_waitcnt lgkmcnt(0)" ::: "memory");
}
__device__ __forceinline__ void sincos_acc(float ang, float& sn, float& cs) {
    const double a = (double)ang;
    const double k = __builtin_rint(a * 0.15915494309189535);
    const double r = (a - k * 6.283185307179586) * 0.25;
    const double r2 = r * r;
    double s = r * (1.0 + r2 * (-1.0 / 6 + r2 * (1.0 / 120 + r2 * (-1.0 / 5040 + r2 * (1.0 / 362880 + r2 * (-1.0 / 39916800 + r2 * (1.0 / 6227020800.0)))))));
    double c = 1.0 + r2 * (-0.5 + r2 * (1.0 / 24 + r2 * (-1.0 / 720 + r2 * (1.0 / 40320 + r2 * (-1.0 / 3628800 + r2 * (1.0 / 479001600.0))))));
    double s2 = 2.0 * s * c, c2 = c * c - s * s;
    double s4 = 2.0 * s2 * c2, c4 = c2 * c2 - s2 * s2;
    sn = (float)s4; cs = (float)c4;
}

struct Params {
    const float* x; const float* c; const int* positions; const float* norm_g; const float* w_ada; const float* b_ada; const float* w_in; const float* fox_fbias;
    const float* cmp_pos; const float* cmp_w1; const float* cmp_w2; const float* w_out; const float* ffn_w13; const float* ffn_w2; const float* final_g;
    float* out; unsigned char* ws;
};

__device__ __forceinline__ void prologue(const Params& P, unsigned char* lds, int tid, int lane, int wave, int G) {
    unsigned char* ws = P.ws;
    float* cact = (float*)lds;
    float* part = (float*)(lds + 65536);
    for (int i = tid; i < NB * DM; i += 512) { const float v = P.c[i]; cact[i] = v / (1.0f + __expf(-v)); }
    __syncthreads();
    float* MOD = (float*)(ws + WS_MOD);
    for (int item = blockIdx.x; item < DEPTH * 64; item += G) {
        const int l = item >> 6, jb = (item & 63) * 144, j0 = jb + 4 * lane;
        const bool act = lane < 36;
        const float* wp = P.w_ada + (size_t)l * DM * NADA + (act ? j0 : jb);
        f32x4 acc4[16];
#pragma unroll
        for (int b = 0; b < 16; ++b) acc4[b] = (f32x4){0.f, 0.f, 0.f, 0.f};
        const int kbeg = wave * 128;
#pragma unroll 4
        for (int k = kbeg; k < kbeg + 128; ++k) {
            const f32x4 w = *(const f32x4*)(wp + (size_t)k * NADA);
#pragma unroll
            for (int b = 0; b < 16; ++b) acc4[b] += w * cact[b * DM + k];
        }
        if (act) {
#pragma unroll
            for (int b = 0; b < 16; ++b) *(f32x4*)(part + (wave * 16 + b) * 144 + 4 * lane) = acc4[b];
        }
        __syncthreads();
        for (int o = tid; o < 16 * 144; o += 512) {
            const int b = o / 144, col = o % 144;
            float sm = 0.f;
#pragma unroll
            for (int w = 0; w < 8; ++w) sm += part[(w * 16 + b) * 144 + col];
            const int j = jb + col;
            MOD[((size_t)l * NB + b) * NADA + j] = sm + P.b_ada[(size_t)l * NADA + j];
        }
        __syncthreads();
    }
    float* scr = (float*)(lds + wave * 16640);
    const int gw = blockIdx.x * NWAVES + wave, NGW = G * NWAVES;
    constexpr int I_WIN = 16 * 48, I_WOUT = 16 * 16, I_CW1 = 32 * 4, I_W13 = 16 * 88, I_W2 = 44 * 16, I_CW2 = 4 * 1;
    constexpr int T_WIN = 4 * I_WIN, T_WOUT = 4 * I_WOUT, T_CW1 = 8 * I_CW1, T_W13 = 8 * I_W13, T_W2 = 8 * I_W2, T_CW2 = 8 * I_CW2;
    constexpr int NITEMS = T_WIN + T_WOUT + T_CW1 + T_W13 + T_W2 + T_CW2;
    for (int it = gw; it < NITEMS; it += NGW) {
        int r = it;
        if (r < T_W13) { const int q = r / I_W13; transpose_item<1>(P.ffn_w13 + (size_t)q * DM * 2 * FF, DM, 2 * FF, 2 * FF, (bf16_t*)(ws + WS_W13) + (size_t)q * 2 * FF * DM, scr, r % I_W13, lane); continue; } r -= T_W13;
        if (r < T_W2) { const int q = r / I_W2; transpose_item<0>(P.ffn_w2 + (size_t)q * FF * DM, FF, DM, DM, (bf16_t*)(ws + WS_W2) + (size_t)q * DM * FF, scr, r % I_W2, lane); continue; } r -= T_W2;
        if (r < T_WIN) { const int q = r / I_WIN; transpose_item<2>(P.w_in + (size_t)q * DM * 2844, DM, 2844, NIN, (bf16_t*)(ws + WS_WIN) + (size_t)q * NIN * DM, scr, r % I_WIN, lane); continue; } r -= T_WIN;
        if (r < T_WOUT) { const int q = r / I_WOUT; transpose_item<0>(P.w_out + (size_t)q * DM * DM, DM, DM, DM, (bf16_t*)(ws + WS_WOUT) + (size_t)q * DM * DM, scr, r % I_WOUT, lane); continue; } r -= T_WOUT;
        if (r < T_CW1) { const int q = r / I_CW1; transpose_item<0>(P.cmp_w1 + (size_t)q * 2048 * 256, 2048, 256, 256, (bf16_t*)(ws + WS_CW1) + (size_t)q * 256 * 2048, scr, r % I_CW1, lane); continue; } r -= T_CW1;
        { const int q = r / I_CW2; transpose_item<0>(P.cmp_w2 + (size_t)q * 256 * 64, 256, 64, 64, (bf16_t*)(ws + WS_CW2T) + (size_t)q * 64 * 256, scr, r % I_CW2, lane); }
    }
    {
        float* cosT = (float*)(ws + WS_COS); float* sinT = (float*)(ws + WS_SIN);
        for (int e = blockIdx.x * 512 + tid; e < NTOK * 8; e += G * 512) {
            const int i = e & 7;
            const float inv = (i == 0) ? 1.0f : (i == 1) ? 0.1939227432012558f : (i == 2) ? 0.03760603070259094f : (i == 3) ? 0.007292664609849453f :
                              (i == 4) ? 0.0014142135623842478f : (i == 5) ? 0.00027424818836152554f : (i == 6) ? 5.318296098266728e-05f : 1.0313386155758053e-05f;
            const float ang = (float)P.positions[e >> 3] * inv;
            float sn, cs; sincos_acc(ang, sn, cs);
            cosT[e] = cs; sinT[e] = sn;
        }
    }
}

__device__ __forceinline__ void norm_phase(const float* xin, const float* g, const float* mod  , bf16_t* H, int lane, int wave, int G) {
    const int gw = blockIdx.x * NWAVES + wave, NGW = G * NWAVES;
    for (int row = gw; row < NTOK; row += NGW) {
        const int b = row >> 11;
        const f32x4* xr = (const f32x4*)(xin + (size_t)row * DM) + lane;
        f32x4 v[4]; float s = 0.f;
#pragma unroll
        for (int j = 0; j < 4; ++j) { v[j] = xr[64 * j]; s += (v[j].x * v[j].x + v[j].y * v[j].y) + (v[j].z * v[j].z + v[j].w * v[j].w); }
        const float rstd = 1.0f / sqrtf(wave_sum(s) * (1.0f / DM) + 1e-6f);
        const f32x4* gr = (const f32x4*)g + lane;
        const f32x4* sh = (const f32x4*)(mod + (size_t)b * NADA) + lane;
        const f32x4* sc = (const f32x4*)(mod + (size_t)b * NADA + DM) + lane;
        u32x2* o8 = (u32x2*)(H + (size_t)row * DM) + lane;
#pragma unroll
        for (int j = 0; j < 4; ++j) {
            const f32x4 gg = gr[64 * j], s1 = sc[64 * j] + 1.0f, s0 = sh[64 * j];
            const f32x4 y = v[j] * rstd * gg * s1 + s0;
            u32x2 w; w.x = cvtpk(y.x, y.y); w.y = cvtpk(y.z, y.w);
            o8[64 * j] = w;
        }
    }
}
__device__ __forceinline__ void final_norm(float* x, const float* g, int lane, int wave, int G) {
    const int gw = blockIdx.x * NWAVES + wave, NGW = G * NWAVES;
    for (int row = gw; row < NTOK; row += NGW) {
        f32x4* xr = (f32x4*)(x + (size_t)row * DM) + lane;
        f32x4 v[4]; float s = 0.f;
#pragma unroll
        for (int j = 0; j < 4; ++j) { v[j] = xr[64 * j]; s += (v[j].x * v[j].x + v[j].y * v[j].y) + (v[j].z * v[j].z + v[j].w * v[j].w); }
        const float rstd = 1.0f / sqrtf(wave_sum(s) * (1.0f / DM) + 1e-6f);
        const f32x4* gr = (const f32x4*)g + lane;
#pragma unroll
        for (int j = 0; j < 4; ++j) xr[64 * j] = v[j] * rstd * gr[64 * j];
    }
}

__global__ void __launch_bounds__(512, 2) fwd_megakernel(Params P) {
    extern __shared__ __attribute__((aligned(16))) unsigned char lds[];
    cg::grid_group grid = cg::this_grid();
    const int tid = threadIdx.x, lane = tid & 63, wave = __builtin_amdgcn_readfirstlane(tid >> 6), wave0 = wave;
    const int G = gridDim.x;
    unsigned char* ws = P.ws;
    LAS unsigned char* lds3 = (LAS unsigned char*)lds;
    const float* MOD = (const float*)(ws + WS_MOD);
    unsigned* ctl = (unsigned*)(ws + WS_CTL);

    volatile LAS unsigned* bst = (volatile LAS unsigned*)(lds3 + LDS_BYTES - 64);
    if (tid == 0) { bst[0] = 0u; bst[1] = 0u; }
    __syncthreads();
    const unsigned xcc = (unsigned)__builtin_amdgcn_readfirstlane((int)xb_xcc_id());
    xcd_barrier_post(ctl + 65536, xcc, bst);
    const bool leader = (tid == 0);
#define GRID_BAR() xcd_barrier((unsigned*)(P.ws + WS_CTL) + 65536, xcc, bst, leader)
    prologue(P, lds, tid, lane, wave, G);
    if (P.ws == nullptr) grid.sync();
    GRID_BAR();
    if (tid == 0) {
        bool ok = ((G & 7) == 0);
        for (unsigned j = 0; j < 16; ++j) { const unsigned cnt = xb_ld(ctl + 65536 + XB_XCNT(j)); ok = ok && (cnt == ((j < 8u) ? (unsigned)(G >> 3) : 0u)); }
        bst[3] = ok ? (bst[2] * 8u + xcc) : (unsigned)blockIdx.x;
    }
    __syncthreads();
    const int vbid = __builtin_amdgcn_readfirstlane((int)bst[3]);
#ifdef PROBE_SYNC20
    for (int i = 0; i < 20; ++i) GRID_BAR();
#endif
    {
        const int ln = fresh_lane(), wv = wave0;
        for (int it = blockIdx.x * NWAVES + wv; it < 8 * 256; it += G * NWAVES) {
            const int lm = it >> 8;
            const bf16_t* wr_ = (const bf16_t*)(ws + WS_CW1) + (size_t)it * 2048 + ln * 32;
            const float* pp = P.cmp_pos + (size_t)lm * 2048 + ln * 32;
            float a = 0.f;
#pragma unroll
            for (int j = 0; j < 4; ++j) {
                const bf16x8 wv8 = *(const bf16x8*)(wr_ + 8 * j);
                const f32x4 p0 = *(const f32x4*)(pp + 8 * j), p1 = *(const f32x4*)(pp + 8 * j + 4);
#pragma unroll
                for (int i = 0; i < 4; ++i) { a += p0[i] * bf2f(wv8[i]); a += p1[i] * bf2f(wv8[4 + i]); }
            }
            a = wave_sum(a);
            if (ln == 0) ((float*)(ws + WS_B1))[it] = a;
        }
    }

    const float* xin = P.x;
    for (int l = 0; l < DEPTH; ++l) {
        const float* modl = MOD + (size_t)l * NB * NADA;
        for (int sub = 0; sub < 3; ++sub) {
            unsigned char* ws = launder_p(P.ws);
            const int bid = launder_i(vbid);
            const int lane = fresh_lane(), wave = wave0;
            norm_phase(xin, P.norm_g + ((size_t)l * 3 + sub) * DM, modl + (size_t)sub * 3 * DM, (bf16_t*)(ws + WS_H), lane, wave, G);
            GRID_BAR();
            if (sub != 1) {
                const int s = (sub == 0) ? 0 : 1;
                {
                    pg8::Gemm g{(const bf16_t*)(ws + WS_H), (const bf16_t*)(ws + WS_W13) + (size_t)(l * 2 + s) * 2 * FF * DM, NTOK, 2 * FF, DM, DM};
                    pg8::StaticOrder S; S.init(NTOK, 2 * FF, G, bid);
                    EpiSwiglu E{(bf16_t*)(ws + WS_BIG)};
#ifndef NO_G1
                    pg8::gemm_phase<EpiSwiglu, true>(lds3, g, S, E, wave0);
#endif
#ifdef PROBE_G1X2
                    pg8::gemm_phase<EpiSwiglu, true>(lds3, g, S, E, wave0);
#endif
                }
                GRID_BAR();
                {
                    pg8::Gemm g{(const bf16_t*)(ws + WS_BIG), (const bf16_t*)(ws + WS_W2) + (size_t)(l * 2 + s) * DM * FF, NTOK, DM, FF, FF};
                    pg8::StaticOrder S; S.init(NTOK, DM, G, bid);
                    EpiResid E{xin, P.out, modl + (size_t)(sub * 3 + 2) * DM, 0.5f};
#ifndef NO_G2
                    pg8::gemm_phase<EpiResid, true>(lds3, g, S, E, wave0);
#endif
                }
                xin = P.out;
                GRID_BAR();
            } else {
                {
                    pg8::Gemm g{(const bf16_t*)(ws + WS_H), (const bf16_t*)(ws + WS_WIN) + (size_t)l * NIN * DM, NTOK, NIN, DM, DM};
                    pg8::StaticOrder S; S.init(NTOK, NIN, G, bid);
                    EpiInProj E{ws, P.fox_fbias + l * 4};
#ifndef NO_INPROJ
                    pg8::gemm_phase<EpiInProj, true>(lds3, g, S, E, wave0);
#endif
                }
                GRID_BAR();
                if (bid < 32) {
                    const int mat = bid >> 4;
                    pg8::Gemm g{(const bf16_t*)(ws + (mat ? WS_VC : WS_KC)), (const bf16_t*)(ws + WS_CW1) + (size_t)(l * 2 + mat) * 256 * 2048, 4096, 256, 2048, 1024};
                    pg8::StaticOrder S; S.init(4096, 256, 16, bid & 15);
                    EpiGelu E{(bf16_t*)(ws + WS_CMPHID) + (size_t)mat * 4096 * 256, (const float*)(ws + WS_B1) + (l * 2 + mat) * 256};
#ifndef NO_CMP1
                    pg8::gemm_phase<EpiGelu, true>(lds3, g, S, E, wave0);
#endif
                } else {
                    const int nw = (G - 32) * NWAVES;
                    for (int it = (bid - 32) * NWAVES + wave; it < 64 + 512; it += nw) {
                        if (it < 64) {
                            const float* src = (const float*)(ws + WS_FLOG) + (size_t)it * SEQ + lane * 32;
                            float v[32];
#pragma unroll
                            for (int j = 0; j < 8; ++j) { const f32x4 q = *(const f32x4*)(src + 4 * j); v[4 * j] = q.x; v[4 * j + 1] = q.y; v[4 * j + 2] = q.z; v[4 * j + 3] = q.w; }
#pragma unroll
                            for (int j = 1; j < 32; ++j) v[j] += v[j - 1];
                            float tot = v[31], inc = tot;
#pragma unroll
                            for (int o = 1; o < 64; o <<= 1) { const float n = __shfl_up(inc, o); if (lane >= o) inc += n; }
                            const float excl = inc - tot;
                            float* dst = (float*)(ws + WS_FCUM) + (size_t)it * SEQ + lane * 32;
#pragma unroll
                            for (int j = 0; j < 8; ++j) { f32x4 q; q.x = (v[4 * j] + excl) * -8.0f; q.y = (v[4 * j + 1] + excl) * -8.0f; q.z = (v[4 * j + 2] + excl) * -8.0f; q.w = (v[4 * j + 3] + excl) * -8.0f; *(f32x4*)(dst + 4 * j) = q; }
                        } else {
                            const int id = it - 64;
                            const bf16_t* kp = (const bf16_t*)(ws + WS_MOBAK) + (size_t)id * 256 * 64 + (((lane >> 4) * 64 + ((lane >> 3) & 1) * 32) * 8 + (lane & 7));
                            float a = 0.f;
#pragma unroll 8
                            for (int k = 0; k < 256; ++k) a += bf2f((short)kp[(size_t)(k >> 6) * 4096 + (((k >> 5) & 1) * 4 * 64 + (k & 31)) * 8]);
                            ((float*)(ws + WS_KMEAN))[(size_t)id * 64 + lane] = a * (1.0f / 256.0f);
                        }
                    }
                }
                GRID_BAR();
                for (int it = bid * NWAVES + wave; it < 256; it += G * NWAVES) {
                    const int mat = it >> 7, rt = it & 127, hi = lane >> 5, c = lane & 31;
                    const bf16_t* A = (const bf16_t*)(ws + WS_CMPHID) + ((size_t)mat * 4096 + rt * 32 + c) * 256 + 8 * hi;
                    const bf16_t* Bt = (const bf16_t*)(ws + WS_CW2T) + (size_t)(l * 2 + mat) * 64 * 256 + (size_t)c * 256 + 8 * hi;
                    f32x16 a0, a1;
#pragma unroll
                    for (int r = 0; r < 16; ++r) { a0[r] = 0.f; a1[r] = 0.f; }
#pragma unroll 4
                    for (int ks = 0; ks < 16; ++ks) {
                        const bf16x8 af = *(const bf16x8*)(A + 16 * ks);
                        const bf16x8 b0 = *(const bf16x8*)(Bt + 16 * ks), b1 = *(const bf16x8*)(Bt + 32 * 256 + 16 * ks);
                        a0 = MFMA32(af, b0, a0); a1 = MFMA32(af, b1, a1);
                    }
#pragma unroll
                    for (int r = 0; r < 16; ++r) {
                        const int row = rt * 32 + crow(r, hi), rl = row & 127, bg = row >> 7;
                        const float v0 = (rl == 127) ? 0.f : a0[r], v1 = (rl == 127) ? 0.f : a1[r];
                        const bf16_t h0 = (bf16_t)(cvtpk(v0, 0.f) & 0xffffu), h1 = (bf16_t)(cvtpk(v1, 0.f) & 0xffffu);
                        if (mat == 0) {
                            bf16_t* kc = (bf16_t*)(ws + WS_KCMP) + (size_t)bg * 8192 + (rl >> 6) * 4096 + ((((rl >> 5) & 1) * 4) * 64 + (rl & 31)) * 8;
                            const int o0 = ((c >> 4) * 64 + ((c >> 3) & 1) * 32) * 8 + (c & 7);
                            kc[o0] = h0; kc[o0 + 2 * 64 * 8] = h1;
                        } else {
                            const int tt = rl & 63;
                            bf16_t* vc = (bf16_t*)(ws + WS_VCMPT) + (size_t)bg * 8192 + (rl >> 6) * 4096
                                         + ((((tt >> 5) * 2 + ((tt >> 4) & 1)) * 2) * 64 + ((tt >> 2) & 1) * 32 + c) * 8 + ((tt >> 3) & 1) * 4 + (tt & 3);
                            vc[0] = h0; vc[64 * 8] = h1;
                        }
                    }
                }
                GRID_BAR();
                {
#ifdef PROBE_ATTN2
                  for (int rep = 0; rep < 2; ++rep)
#else
                  const int rep = 0;
#endif
                  {
                    float* wl = (float*)(lds + wave * 16384);
                    const int lane_ = lane;
                    const int myq = (int)(__builtin_amdgcn_s_getreg((3 << 11) | 20) & 7u);
                    for (int qi = 0; qi < 8; ++qi) {
                        const int q = (myq + qi) & 7;
                        unsigned* ctr = ctl + 64 * (1 + (l * 2 + rep) * 8 + q);
                        for (;;) {
                            unsigned u = 0;
                            if (lane_ == 0) u = atomicAdd(ctr, 1u);
                            u = (unsigned)__builtin_amdgcn_readfirstlane((int)u);
                            if (u >= 2048u) break;
                            const int lane = launder_v(lane_);
                            if (u < 1024u) {
                                const int pr = (int)(u >> 9), i = (int)(u & 511u), slot = 63 - (i >> 3), w = i & 7;
                                const int bg = 4 * q + 2 * pr + (w >> 2);
                                nsa_unit(ws, bg >> 1, bg & 1, slot * 4 + (w & 3), lane, wl);
                            } else if (u < 1536u) {
                                const int i = (int)(u - 1024u), hf = i >> 8, slot = 63 - ((i & 255) >> 2);
                                fox_unit(ws, 8 * q + 4 * hf + (i & 3), slot, lane);
                            } else {
                                const int i = (int)(u - 1536u), hf = i >> 8, slot = 63 - ((i & 255) >> 2);
                                moba_unit(ws, 8 * q + 4 * hf + (i & 3), slot, lane);
                            }
                        }
                    }
                  }
                }
                GRID_BAR();
                {
                    pg8::Gemm g{(const bf16_t*)(ws + WS_H), (const bf16_t*)(ws + WS_WOUT) + (size_t)l * DM * DM, NTOK, DM, DM, DM};
                    pg8::StaticOrder S; S.init(NTOK, DM, G, bid);
                    EpiResid E{xin, P.out, modl + (size_t)(1 * 3 + 2) * DM, 1.0f};
#ifndef NO_OUTPROJ
                    pg8::gemm_phase<EpiResid, true>(lds3, g, S, E, wave0);
#endif
                }
                GRID_BAR();
            }
        }
    }
    final_norm(P.out, P.final_g, fresh_lane(), wave0, G);
}

extern "C" void kernel_launch(void* const* d_in, const int* in_sizes, int n_in, void* d_out, int out_size, void* d_ws, size_t ws_size, hipStream_t stream) {
    static int grid_blocks = 0;
    if (grid_blocks == 0) {
        if (n_in != 15 || ws_size < WS_END) { fprintf(stderr, "kernel_launch: unexpected inputs (n_in %d, ws %zu)\n", n_in, ws_size); grid_blocks = -1; return; }
        int dev = 0, cus = 0, per_cu = 0;
        hipGetDevice(&dev);
        hipDeviceGetAttribute(&cus, hipDeviceAttributeMultiprocessorCount, dev);
        if (hipFuncSetAttribute((const void*)fwd_megakernel, hipFuncAttributeMaxDynamicSharedMemorySize, LDS_BYTES) != hipSuccess) fprintf(stderr, "kernel_launch: hipFuncSetAttribute failed\n");
        if (hipOccupancyMaxActiveBlocksPerMultiprocessor(&per_cu, (const void*)fwd_megakernel, 512, LDS_BYTES) != hipSuccess || per_cu < 1) { fprintf(stderr, "kernel_launch: occupancy query gave %d\n", per_cu); per_cu = 1; }
        (void)hipGetLastError();
        grid_blocks = cus * per_cu;
        if (grid_blocks > 256) grid_blocks = 256;
    }
    if (grid_blocks < 0) return;
    hipMemsetAsync((char*)d_ws + WS_CTL, 0, 1 * MiB, stream);
    Params p{};
    p.x = (const float*)d_in[0]; p.c = (const float*)d_in[1]; p.positions = (const int*)d_in[2]; p.norm_g = (const float*)d_in[3];
    p.w_ada = (const float*)d_in[4]; p.b_ada = (const float*)d_in[5]; p.w_in = (const float*)d_in[6]; p.fox_fbias = (const float*)d_in[7];
    p.cmp_pos = (const float*)d_in[8]; p.cmp_w1 = (const float*)d_in[9]; p.cmp_w2 = (const float*)d_in[10]; p.w_out = (const float*)d_in[11];
    p.ffn_w13 = (const float*)d_in[12]; p.ffn_w2 = (const float*)d_in[13]; p.final_g = (const float*)d_in[14];
    p.out = (float*)d_out; p.ws = (unsigned char*)d_ws;
    void* args[] = {&p};
    hipError_t e = hipLaunchCooperativeKernel((const void*)fwd_megakernel, dim3(grid_blocks), dim3(512), args, LDS_BYTES, stream);
    if (e != hipSuccess) fprintf(stderr, "kernel_launch: cooperative launch failed: %s (grid %d)\n", hipGetErrorString(e), grid_blocks);
}
```

```cpp
#include <hip/hip_runtime.h>
#include <hip/hip_cooperative_groups.h>
#include <cstdio>
#include <cstdint>
namespace cg = cooperative_groups;

#define LAS __attribute__((address_space(3)))
typedef unsigned short bf16_t;
typedef short bf16x8 __attribute__((ext_vector_type(8)));
typedef short s16x4 __attribute__((ext_vector_type(4)));
typedef float f32x4 __attribute__((ext_vector_type(4)));
typedef float f32x2 __attribute__((ext_vector_type(2)));
typedef float f32x16 __attribute__((ext_vector_type(16)));
typedef unsigned u32x4 __attribute__((ext_vector_type(4)));
typedef unsigned u32x2 __attribute__((ext_vector_type(2)));
typedef __bf16 bf16x2_t __attribute__((ext_vector_type(2)));

constexpr int NB = 16, SEQ = 2048, DM = 1024, NTOK = NB * SEQ, DEPTH = 4, FF = 2816, NIN = 3072, NADA = 9216;
constexpr float LOG2E = 1.4426950408889634f;
constexpr float QK_C2 = 0.125f * LOG2E;
constexpr float NEG_INF = -__builtin_inff();

constexpr size_t MiB = 1u << 20;
constexpr size_t WS_CTL = 0;
constexpr size_t WS_B1 = 4 * MiB;
constexpr size_t WS_MOD = 1 * MiB;
constexpr size_t WS_COS = 5 * MiB, WS_SIN = 6 * MiB;
constexpr size_t WS_CW2T = 7 * MiB;
constexpr size_t WS_WIN = 8 * MiB;
constexpr size_t WS_WOUT = 32 * MiB;
constexpr size_t WS_CW1 = 40 * MiB;
constexpr size_t WS_W13 = 48 * MiB;
constexpr size_t WS_W2 = 136 * MiB;
constexpr size_t WS_H = 180 * MiB;
constexpr size_t WS_BIG = 244 * MiB;
constexpr size_t WS_QNSA = 244 * MiB;
constexpr size_t WS_KC = 276 * MiB;
constexpr size_t WS_VC = 285 * MiB;
constexpr size_t WS_KS = 294 * MiB, WS_KW = 302 * MiB;
constexpr size_t WS_FOXQ = 310 * MiB;
constexpr size_t WS_FOXK = 326 * MiB;
constexpr size_t WS_MOBAQ = 342 * MiB, WS_MOBAK = 358 * MiB;
constexpr size_t WS_VST = 374 * MiB, WS_VWT = 382 * MiB;
constexpr size_t WS_FOXVT = 390 * MiB, WS_MOBAVT = 406 * MiB;
constexpr size_t WS_GATES = 422 * MiB;
constexpr size_t WS_FLOG = 425 * MiB;
constexpr size_t WS_FCUM = 426 * MiB;
constexpr size_t WS_KMEAN = 427 * MiB;
constexpr size_t WS_CMPHID = 428 * MiB;
constexpr size_t WS_KCMP = 432 * MiB;
constexpr size_t WS_VCMPT = 433 * MiB;
constexpr size_t WS_END = 436 * MiB;

constexpr int RING_BYTES = 131072;
constexpr int LDS_BYTES = 147456;
constexpr int NWAVES = 8;

__device__ __forceinline__ unsigned cvtpk(float lo, float hi) { f32x2 v = {lo, hi}; bf16x2_t b = __builtin_convertvector(v, bf16x2_t); return __builtin_bit_cast(unsigned, b); }
__device__ __forceinline__ float bf2f(short s) { return __uint_as_float(((unsigned)(unsigned short)s) << 16); }
__device__ __forceinline__ float fast_exp2(float x) { return __builtin_amdgcn_exp2f(x); }
__device__ __forceinline__ float fast_rcp(float x) { return __builtin_amdgcn_rcpf(x); }
__device__ __forceinline__ float silu_f(float a) { return a * fast_rcp(1.0f + fast_exp2(-a * LOG2E)); }
__device__ __forceinline__ float sigmoid_f(float a) { return 1.0f / (1.0f + __expf(-a)); }
__device__ __forceinline__ float gelu_tanh(float x) {
    const float u = 0.7978845608028654f * (x + 0.044715f * x * x * x);
    const float e = fast_exp2(2.0f * LOG2E * u);
    const float th = 1.0f - 2.0f * fast_rcp(e + 1.0f);
    return 0.5f * x * (1.0f + th);
}
__device__ __forceinline__ float wave_sum(float v) {
#pragma unroll
    for (int o = 1; o < 64; o <<= 1) v += __shfl_xor(v, o);
    return v;
}
__device__ __forceinline__ unsigned char* launder_p(unsigned char* p) { size_t z = 0; asm volatile("" : "+s"(z)); return p + z; }
__device__ __forceinline__ int launder_i(int v) { asm volatile("" : "+s"(v)); return v; }
__device__ __forceinline__ int launder_v(int v) { asm volatile("" : "+v"(v)); return v; }
__device__ __forceinline__ int fresh_lane() { unsigned m = ~0u; asm volatile("" : "+s"(m)); return (int)__builtin_amdgcn_mbcnt_hi(m, __builtin_amdgcn_mbcnt_lo(m, 0u)); }
__device__ __forceinline__ int crow(int r, int hi) { return (r & 3) + 8 * (r >> 2) + 4 * hi; }

namespace pg8 {
constexpr int BM = 256, BK = 64, HALF = 128, HTB = HALF * BK * 2, STAGE_BYTES = 8 * HTB, NXCD = 8, WGM = 8;
__host__ __device__ __forceinline__ int lds_byte(int r, int c) { const int st = (r >> 4) * 2 + (c >> 5), rr = r & 15, cc = c & 31, ob = rr * 64 + cc * 2; return st * 1024 + (ob ^ (((ob >> 9) & 1) << 5)); }
__host__ __device__ __forceinline__ void stage_rc(int b, int& R, int& C) { const int st = b / 1024, sb = b % 1024, swz = sb ^ (((sb >> 9) & 1) << 5); R = (st >> 1) * 16 + swz / 64; C = (st & 1) * 32 + (swz % 64) / 2; }
__host__ __device__ __forceinline__ int perm32(int rho) { const int n = rho >> 4, i = rho & 15; return 8 * (i >> 2) + 4 * n + (i & 3); }

struct Unit { int pm, pn; };
struct Gemm { const bf16_t* A; const bf16_t* Bt; int M, N, K, lda; };

struct StaticOrder {
    int nM, nN, nwg, G, c;
    __device__ void init(int M, int N, int G_, int c_) { nM = M / BM; nN = N / BM; nwg = nM * nN; G = G_; c = c_; }
    __device__ bool next(int i, Unit& u) const {
        const long L = (long)i * G + c; if (L >= nwg) return false;
        int wgid = (int)L; { const int q = nwg / NXCD, r = nwg % NXCD, xcd = wgid % NXCD, off = wgid / NXCD; wgid = (xcd < r ? xcd * (q + 1) : r * (q + 1) + (xcd - r) * q) + off; }
        const int nig = WGM * nN, gid = wgid / nig, fm = gid * WGM, gsz = (nM - fm) < WGM ? (nM - fm) : WGM;
        u.pm = fm + ((wgid % nig) % gsz); u.pn = (wgid % nig) / gsz; return true;
    }
};

template <class Epi, bool ALIGN_EPI>
__device__ __forceinline__ void gemm_phase(LAS unsigned char* lds, const Gemm g, const StaticOrder& S, const Epi& E, int wave0) {
    const int wid = wave0, lane = fresh_lane(), tid = wid * 64 + lane, wr = wid >> 2, wc = wid & 3, fr = lane & 15, fq = lane >> 4;
    const int K = g.K, nt = K / BK, lda = g.lda;
    unsigned voffA[2], voffB[2];
#pragma unroll
    for (int i = 0; i < 2; ++i) { int R, C; stage_rc(tid * 16 + i * 8192, R, C); const int Rb = Epi::PERM ? ((R & ~31) + perm32(R & 31)) : R;
        voffA[i] = (unsigned)(R * lda + C) * 2u; voffB[i] = (unsigned)(Rb * K + C) * 2u; }
    const size_t kstep = (size_t)(BK * 2);
    const size_t hstepA = (size_t)HALF * lda * 2, hstepB = (size_t)HALF * K * 2;
    const size_t tstepA = 2 * hstepA, tstepB = 2 * hstepB;
    const unsigned ldsw = (unsigned)wid * 1024u;
    const int aoff = lds_byte(wr * 64 + fr, fq * 8), boff = lds_byte(wc * 32 + fr, fq * 8);
#define PG8_SA(b, h) (((b) * 2 + (h)) * HTB)
#define PG8_SB(b, h) ((4 + (b) * 2 + (h)) * HTB)
#define PG8_STAGE(bufoff, gbase, voff) do { _Pragma("unroll") for (int _i = 0; _i < 2; ++_i) \
        __builtin_amdgcn_global_load_lds((const unsigned*)((const char*)(gbase) + (voff)[_i]), (LAS unsigned*)(lds + (bufoff) + ldsw + _i * 8192), 16, 0, 0); } while (0)
#define PG8_LDA(dst, b, h) do { _Pragma("unroll") for (int m = 0; m < 4; ++m) _Pragma("unroll") for (int k = 0; k < 2; ++k) dst[m][k] = *(const LAS bf16x8*)(lds + PG8_SA(b, h) + aoff + m * 2048 + k * 1024); } while (0)
#define PG8_LDB(dst, b, h) do { _Pragma("unroll") for (int n = 0; n < 2; ++n) _Pragma("unroll") for (int k = 0; k < 2; ++k) dst[n][k] = *(const LAS bf16x8*)(lds + PG8_SB(b, h) + boff + n * 2048 + k * 1024); } while (0)
#define PG8_MMA(ai, bj, At, Bt) do { __builtin_amdgcn_s_setprio(1); _Pragma("unroll") for (int m = 0; m < 4; ++m) _Pragma("unroll") for (int n = 0; n < 2; ++n) _Pragma("unroll") for (int k = 0; k < 2; ++k) \
        acc[ai][bj][m][n] = __builtin_amdgcn_mfma_f32_16x16x32_bf16(Bt[n][k], At[m][k], acc[ai][bj][m][n], 0, 0, 0); __builtin_amdgcn_s_setprio(0); } while (0)
#define PG8_WAIT_V(n) asm volatile("s_waitcnt vmcnt(" #n ")" ::: "memory")
#define PG8_WAIT_L(n) asm volatile("s_waitcnt lgkmcnt(" #n ")" ::: "memory")
#define PG8_BAR __builtin_amdgcn_s_barrier()
#define PG8_SCHED __builtin_amdgcn_sched_barrier(0)
    Unit cur, nxt; int ui = 0;
    if (!S.next(0, cur)) return;
    f32x4 acc[2][2][4][2];
#pragma unroll
    for (int a = 0; a < 2; ++a)
#pragma unroll
        for (int b = 0; b < 2; ++b)
#pragma unroll
            for (int m = 0; m < 4; ++m)
#pragma unroll
                for (int n = 0; n < 2; ++n) acc[a][b][m][n] = (f32x4){0.f, 0.f, 0.f, 0.f};
    bf16x8 At[4][2], B0[2][2], B1[2][2];
    const char* cA = (const char*)g.A + (size_t)cur.pm * tstepA; const char* cB = (const char*)g.Bt + (size_t)cur.pn * tstepB;
    PG8_STAGE(PG8_SB(0, 0), cB, voffB); PG8_STAGE(PG8_SB(0, 1), cB + hstepB, voffB); PG8_STAGE(PG8_SA(0, 0), cA, voffA); PG8_STAGE(PG8_SA(0, 1), cA + hstepA, voffA);
    if (wr == 1) PG8_BAR;
    PG8_WAIT_V(2); PG8_BAR;
    PG8_STAGE(PG8_SB(1, 0), cB + kstep, voffB); PG8_STAGE(PG8_SA(1, 0), cA + kstep, voffA); PG8_STAGE(PG8_SB(1, 1), cB + hstepB + kstep, voffB);
    PG8_WAIT_V(6); PG8_BAR;
    for (;;) {
        const bool has_next = S.next(ui + 1, nxt);
        const char* nA = has_next ? (const char*)g.A + (size_t)nxt.pm * tstepA : cA; const char* nB = has_next ? (const char*)g.Bt + (size_t)nxt.pn * tstepB : cB;
        for (int t = 0; t < nt; t += 2) {
            const bool last = (t == nt - 2);
            const char* a1 = cA + (size_t)(t + 1) * kstep;
            const char* a2 = last ? nA : cA + (size_t)(t + 2) * kstep; const char* b2 = last ? nB : cB + (size_t)(t + 2) * kstep;
            const char* a3 = a2 + kstep; const char* b3 = b2 + kstep;
            PG8_LDB(B0, 0, 0); PG8_LDB(B1, 0, 1); PG8_SCHED; PG8_LDA(At, 0, 0); PG8_STAGE(PG8_SA(1, 1), a1 + hstepA, voffA);
            PG8_WAIT_V(8); PG8_WAIT_L(0); PG8_BAR; PG8_MMA(0, 0, At, B0); PG8_MMA(0, 1, At, B1); PG8_BAR; PG8_SCHED;
            PG8_LDA(At, 0, 1); PG8_STAGE(PG8_SB(0, 0), b2, voffB); PG8_STAGE(PG8_SB(0, 1), b2 + hstepB, voffB); PG8_STAGE(PG8_SA(0, 0), a2, voffA);
            PG8_WAIT_V(8); PG8_WAIT_L(0); PG8_BAR; PG8_MMA(1, 0, At, B0); PG8_MMA(1, 1, At, B1); PG8_BAR; PG8_SCHED;
            PG8_LDB(B0, 1, 0); PG8_LDB(B1, 1, 1); PG8_SCHED; PG8_LDA(At, 1, 0); PG8_STAGE(PG8_SA(0, 1), a2 + hstepA, voffA);
            PG8_WAIT_V(8); PG8_WAIT_L(0); PG8_BAR; PG8_MMA(0, 0, At, B0); PG8_MMA(0, 1, At, B1); PG8_BAR; PG8_SCHED;
            PG8_LDA(At, 1, 1); PG8_STAGE(PG8_SB(1, 0), b3, voffB); PG8_STAGE(PG8_SB(1, 1), b3 + hstepB, voffB); PG8_STAGE(PG8_SA(1, 0), a3, voffA);
            PG8_WAIT_V(8); PG8_WAIT_L(0); PG8_BAR; PG8_MMA(1, 0, At, B0); PG8_MMA(1, 1, At, B1); PG8_BAR; PG8_SCHED;
        }
        if constexpr (ALIGN_EPI) { if (wr == 0) PG8_BAR; }
        { int efr = fr, efq = fq, ewr = wr, ewc = wc; asm volatile("" : "+v"(efr), "+v"(efq), "+s"(ewr), "+s"(ewc)); E(acc, cur, ewr, ewc, efr, efq); }
        if (!has_next) break;
#pragma unroll
        for (int a = 0; a < 2; ++a)
#pragma unroll
            for (int b = 0; b < 2; ++b)
#pragma unroll
                for (int m = 0; m < 4; ++m)
#pragma unroll
                    for (int n = 0; n < 2; ++n) acc[a][b][m][n] = (f32x4){0.f, 0.f, 0.f, 0.f};
        cur = nxt; cA = nA; cB = nB; ++ui;
        if constexpr (ALIGN_EPI) { if (wr == 1) PG8_BAR; }
    }
    PG8_WAIT_V(0);
    if constexpr (!ALIGN_EPI) { if (wr == 0) PG8_BAR; }
    PG8_BAR;
#undef PG8_SA
#undef PG8_SB
#undef PG8_STAGE
#undef PG8_LDA
#undef PG8_LDB
#undef PG8_MMA
#undef PG8_WAIT_V
#undef PG8_WAIT_L
#undef PG8_BAR
#undef PG8_SCHED
}
}

struct EpiSwiglu {
    static constexpr bool PERM = true;
    bf16_t* O;
    __device__ __forceinline__ void operator()(const f32x4 (&acc)[2][2][4][2], const pg8::Unit& u, int wr, int wc, int fr, int fq) const {
        const int row0 = u.pm * 256 + wr * 64 + fr, col0 = u.pn * 128 + wc * 32 + 8 * fq;
#pragma unroll
        for (int ai = 0; ai < 2; ++ai)
#pragma unroll
            for (int m = 0; m < 4; ++m) {
                bf16_t* rowp = O + (size_t)(row0 + ai * 128 + m * 16) * FF + col0;
                const f32x4 a0 = acc[ai][0][m][0], a1 = acc[ai][0][m][1], b0 = acc[ai][1][m][0], b1 = acc[ai][1][m][1];
                u32x4 w;
                w.x = cvtpk(silu_f(a0[0]) * b0[0], silu_f(a0[1]) * b0[1]); w.y = cvtpk(silu_f(a0[2]) * b0[2], silu_f(a0[3]) * b0[3]);
                w.z = cvtpk(silu_f(a1[0]) * b1[0], silu_f(a1[1]) * b1[1]); w.w = cvtpk(silu_f(a1[2]) * b1[2], silu_f(a1[3]) * b1[3]);
                *(u32x4*)rowp = w;
            }
    }
};
struct EpiResid {
    static constexpr bool PERM = false;
    const float* xin; float* xout; const float* gate; float coef;
    __device__ __forceinline__ void operator()(const f32x4 (&acc)[2][2][4][2], const pg8::Unit& u, int wr, int wc, int fr, int fq) const {
        const int b = (u.pm * 256) >> 11;
        const int row0 = u.pm * 256 + wr * 64 + fr;
#pragma unroll
        for (int bj = 0; bj < 2; ++bj)
#pragma unroll
            for (int n = 0; n < 2; ++n) {
                const int col = u.pn * 256 + bj * 128 + wc * 32 + n * 16 + 4 * fq;
                const f32x4 gv = *(const f32x4*)(gate + (size_t)b * NADA + col) * coef;
                f32x4 xv[2][4];
#pragma unroll
                for (int ai = 0; ai < 2; ++ai)
#pragma unroll
                    for (int m = 0; m < 4; ++m) xv[ai][m] = *(const f32x4*)(xin + (size_t)(row0 + ai * 128 + m * 16) * DM + col);
#pragma unroll
                for (int ai = 0; ai < 2; ++ai)
#pragma unroll
                    for (int m = 0; m < 4; ++m) {
                        const size_t off = (size_t)(row0 + ai * 128 + m * 16) * DM + col;
                        *(f32x4*)(xout + off) = xv[ai][m] + gv * acc[ai][bj][m][n];
                    }
            }
    }
};
struct EpiGelu {
    static constexpr bool PERM = true;
    bf16_t* O; const float* bias;
    __device__ __forceinline__ void operator()(const f32x4 (&acc)[2][2][4][2], const pg8::Unit& u, int wr, int wc, int fr, int fq) const {
        const int row0 = u.pm * 256 + wr * 64 + fr;
#pragma unroll
        for (int bj = 0; bj < 2; ++bj) {
            const int col0 = u.pn * 256 + bj * 128 + wc * 32 + 8 * fq;
            const f32x4 bv0 = *(const f32x4*)(bias + col0), bv1 = *(const f32x4*)(bias + col0 + 4);
#pragma unroll
            for (int ai = 0; ai < 2; ++ai)
#pragma unroll
                for (int m = 0; m < 4; ++m) {
                    const f32x4 v0 = acc[ai][bj][m][0] + bv0, v1 = acc[ai][bj][m][1] + bv1;
                    u32x4 w;
                    w.x = cvtpk(gelu_tanh(v0[0]), gelu_tanh(v0[1])); w.y = cvtpk(gelu_tanh(v0[2]), gelu_tanh(v0[3]));
                    w.z = cvtpk(gelu_tanh(v1[0]), gelu_tanh(v1[1])); w.w = cvtpk(gelu_tanh(v1[2]), gelu_tanh(v1[3]));
                    *(u32x4*)(O + (size_t)(row0 + ai * 128 + m * 16) * 256 + col0) = w;
                }
        }
    }
};
struct EpiInProj {
    static constexpr bool PERM = true;
    unsigned char* ws; const float* fbias;
    __device__ __forceinline__ void operator()(const f32x4 (&acc)[2][2][4][2], const pg8::Unit& u, int wr, int wc, int fr, int fq) const {
        part<0>(acc, u, wr, wc, fr, fq); part<1>(acc, u, wr, wc, fr, fq);
    }
    template <int bj>
    __device__ __forceinline__ void part(const f32x4 (&acc)[2][2][4][2], const pg8::Unit& u, int wr, int wc, int fr, int fq) const {
        const float* cosT = (const float*)(ws + WS_COS); const float* sinT = (const float*)(ws + WS_SIN);
        {
            const int cb = u.pn * 256 + bj * 128 + wc * 32;
            const int hg = cb >> 6, half = (cb >> 5) & 1;
            if (hg > 44) return;
            int mode, NH = 1, hd = 0, pitch = 0; bool rope = false; bf16_t* base = nullptr;
            if (hg < 8)       { mode = 0; base = (bf16_t*)(ws + WS_QNSA); pitch = 512; hd = hg; rope = true; }
            else if (hg < 10) { mode = 1; base = (bf16_t*)(ws + WS_KC); NH = 2; hd = hg - 8; rope = true; }
            else if (hg < 12) { mode = 4; base = (bf16_t*)(ws + WS_KS); NH = 2; hd = hg - 10; rope = true; }
            else if (hg < 14) { mode = 4; base = (bf16_t*)(ws + WS_KW); NH = 2; hd = hg - 12; rope = true; }
            else if (hg < 18) { mode = 0; base = (bf16_t*)(ws + WS_FOXQ); pitch = 256; hd = hg - 14; }
            else if (hg < 22) { mode = 4; base = (bf16_t*)(ws + WS_FOXK); NH = 4; hd = hg - 18; }
            else if (hg < 26) { mode = 0; base = (bf16_t*)(ws + WS_MOBAQ); pitch = 256; hd = hg - 22; rope = true; }
            else if (hg < 30) { mode = 4; base = (bf16_t*)(ws + WS_MOBAK); NH = 4; hd = hg - 26; rope = true; }
            else if (hg < 32) { mode = 1; base = (bf16_t*)(ws + WS_VC); NH = 2; hd = hg - 30; }
            else if (hg < 34) { mode = 2; base = (bf16_t*)(ws + WS_VST); NH = 2; hd = hg - 32; }
            else if (hg < 36) { mode = 2; base = (bf16_t*)(ws + WS_VWT); NH = 2; hd = hg - 34; }
            else if (hg < 40) { mode = 2; base = (bf16_t*)(ws + WS_FOXVT); NH = 4; hd = hg - 36; }
            else if (hg < 44) { mode = 2; base = (bf16_t*)(ws + WS_MOBAVT); NH = 4; hd = hg - 40; }
            else { mode = 3; if (half) return; }
            const bool do_rope = rope && (half == 0);
#pragma unroll
            for (int ai = 0; ai < 2; ++ai)
#pragma unroll
                for (int m = 0; m < 4; ++m) {
                    const int row = u.pm * 256 + ai * 128 + wr * 64 + m * 16 + fr;
                    const int b = row >> 11, t = row & 2047;
                    float v[8];
#pragma unroll
                    for (int i = 0; i < 4; ++i) { v[i] = acc[ai][bj][m][0][i]; v[4 + i] = acc[ai][bj][m][1][i]; }
                    if (do_rope) {
                        float pr[8];
#pragma unroll
                        for (int i = 0; i < 8; ++i) pr[i] = __shfl_xor(v[i], 16);
                        if (fq < 2) {
                            const f32x4 c0 = *(const f32x4*)(cosT + (size_t)row * 8), c1 = *(const f32x4*)(cosT + (size_t)row * 8 + 4);
                            const f32x4 s0 = *(const f32x4*)(sinT + (size_t)row * 8), s1 = *(const f32x4*)(sinT + (size_t)row * 8 + 4);
                            const float sg = (fq == 0) ? -1.0f : 1.0f;
#pragma unroll
                            for (int i = 0; i < 4; ++i) { v[i] = v[i] * c0[i] + sg * pr[i] * s0[i]; v[4 + i] = v[4 + i] * c1[i] + sg * pr[4 + i] * s1[i]; }
                        }
                    }
                    if (mode == 3) {
                        float* gates = (float*)(ws + WS_GATES); float* flog = (float*)(ws + WS_FLOG);
                        if (fq < 3) {
                            f32x4 g0, g1;
#pragma unroll
                            for (int i = 0; i < 4; ++i) { g0[i] = sigmoid_f(v[i]); g1[i] = sigmoid_f(v[4 + i]); }
                            *(f32x4*)(gates + (size_t)row * 24 + 8 * fq) = g0; *(f32x4*)(gates + (size_t)row * 24 + 8 * fq + 4) = g1;
                        } else {
#pragma unroll
                            for (int i = 0; i < 4; ++i) {
                                const float z = v[i] + fbias[i];
                                const float ls = (z > 0.f) ? -log1pf(__expf(-z)) : (z - log1pf(__expf(z)));
                                flog[(size_t)(b * 4 + i) * SEQ + t] = ls;
                            }
                        }
                    } else {
                        u32x4 w; w.x = cvtpk(v[0], v[1]); w.y = cvtpk(v[2], v[3]); w.z = cvtpk(v[4], v[5]); w.w = cvtpk(v[6], v[7]);
                        const int dcol = half * 32 + 8 * fq;
                        if (mode == 0) *(u32x4*)(base + (size_t)row * pitch + hd * 64 + dcol) = w;
                        else if (mode == 1) *(u32x4*)(base + ((size_t)(b * NH + hd) * SEQ + t) * 64 + dcol) = w;
                        else if (mode == 4) {
                            const int d0 = half * 2 + (fq >> 1), khi = fq & 1;
                            *(u32x4*)(base + (size_t)(b * NH + hd) * SEQ * 64 + (size_t)(t >> 6) * 4096 + ((((t >> 5) & 1) * 4 + d0) * 64 + khi * 32 + (t & 31)) * 8) = w;
                        } else {
                            const int tt = t & 63, hf = tt >> 5, jj = (tt >> 4) & 1, piece = (tt >> 3) & 1, vhi = (tt >> 2) & 1, e = tt & 3;
                            bf16_t* p = base + (size_t)(b * NH + hd) * SEQ * 64 + (size_t)(t >> 6) * 4096 + (((hf * 2 + jj) * 2 + half) * 64 + vhi * 32 + 8 * fq) * 8 + piece * 4 + e;
                            p[0 * 8] = (bf16_t)(w.x & 0xffffu); p[1 * 8] = (bf16_t)(w.x >> 16);
                            p[2 * 8] = (bf16_t)(w.y & 0xffffu); p[3 * 8] = (bf16_t)(w.y >> 16);
                            p[4 * 8] = (bf16_t)(w.z & 0xffffu); p[5 * 8] = (bf16_t)(w.z >> 16);
                            p[6 * 8] = (bf16_t)(w.w & 0xffffu); p[7 * 8] = (bf16_t)(w.w >> 16);
                        }
                    }
                }
        }
    }
};

#define MFMA32(a, b, c) __builtin_amdgcn_mfma_f32_32x32x16_bf16((a), (b), (c), 0, 0, 0)
__device__ __forceinline__ f32x16 qk32(const bf16_t* kp, const bf16x8 (&qf)[4]) {
    f32x16 p;
#pragma unroll
    for (int r = 0; r < 16; ++r) p[r] = 0.f;
#pragma unroll
    for (int d0 = 0; d0 < 4; ++d0) { const bf16x8 kf = *(const bf16x8*)(kp + 16 * d0); p = MFMA32(kf, qf[d0], p); }
    return p;
}
__device__ __forceinline__ void pv32(f32x16 (&o)[2], const bf16_t* vp, int vpitch, const f32x16& p) {
#pragma unroll
    for (int j = 0; j < 2; ++j) {
        u32x4 pw; pw.x = cvtpk(p[8 * j + 0], p[8 * j + 1]); pw.y = cvtpk(p[8 * j + 2], p[8 * j + 3]); pw.z = cvtpk(p[8 * j + 4], p[8 * j + 5]); pw.w = cvtpk(p[8 * j + 6], p[8 * j + 7]);
        const bf16x8 pb = __builtin_bit_cast(bf16x8, pw);
#pragma unroll
        for (int dh = 0; dh < 2; ++dh) {
            const bf16_t* q = vp + (size_t)dh * 32 * vpitch + 16 * j;
            const s16x4 lo = *(const s16x4*)q, hi4 = *(const s16x4*)(q + 8);
            const bf16x8 va = (bf16x8){lo[0], lo[1], lo[2], lo[3], hi4[0], hi4[1], hi4[2], hi4[3]};
            o[dh] = MFMA32(va, pb, o[dh]);
        }
    }
}
__device__ __forceinline__ void load_k64(bf16x8 (&kf)[8], const bf16_t* ktile, int lane) {
    const bf16_t* p = ktile + lane * 8;
#pragma unroll
    for (int i = 0; i < 8; ++i) kf[i] = *(const bf16x8*)(p + i * 512);
}
__device__ __forceinline__ void load_v64(bf16x8 (&vf)[8], const bf16_t* vtile, int lane) {
    const bf16_t* p = vtile + lane * 8;
#pragma unroll
    for (int i = 0; i < 8; ++i) vf[i] = *(const bf16x8*)(p + i * 512);
}
template <int MODE, int MK>
__device__ __forceinline__ void softmax_pv(f32x16 (&o)[2], float& m, float& l, f32x16& p0, f32x16& p1, const bf16x8 (&vf)[8],
                                           int kb, int t, bool tsel, const float* F8, float Fq8, int hi) {
    if (MK == 2) {
#pragma unroll
        for (int r = 0; r < 16; ++r) {
            const int k0 = kb + crow(r, hi), k1 = k0 + 32;
            bool v0, v1;
            if (MODE == 0) { v0 = tsel && (k0 <= t); v1 = tsel && (k1 <= t); }
            else if (MODE == 1) { v0 = (k0 <= t) && (k0 > t - 512); v1 = (k1 <= t) && (k1 > t - 512); }
            else { v0 = (k0 <= t); v1 = (k1 <= t); }
            p0[r] = v0 ? p0[r] : NEG_INF; p1[r] = v1 ? p1[r] : NEG_INF;
        }
    }
    int ia = max(__float_as_int(p0[0]), __float_as_int(p1[0])), ib = max(__float_as_int(p0[1]), __float_as_int(p1[1]));
#pragma unroll
    for (int r = 2; r < 16; r += 2) { ia = max(ia, max(__float_as_int(p0[r]), __float_as_int(p1[r]))); ib = max(ib, max(__float_as_int(p0[r + 1]), __float_as_int(p1[r + 1]))); }
    float mx = __int_as_float(max(max(ia, ib), 0));
    if (MK == 1) mx = tsel ? mx : NEG_INF;
    mx = fmaxf(mx, __shfl_xor(mx, 32));
    const float mnew = fmaxf(m, mx);
    const float msafe = (mnew == NEG_INF) ? 0.f : mnew;
    const float alpha = fast_exp2((m - msafe) * QK_C2);
    float nm = -msafe * QK_C2;
    if (MK == 1) nm = tsel ? nm : NEG_INF;
    float ps = 0.f;
#pragma unroll
    for (int r = 0; r < 16; ++r) { p0[r] = fast_exp2(__builtin_fmaf(p0[r], QK_C2, nm)); p1[r] = fast_exp2(__builtin_fmaf(p1[r], QK_C2, nm)); ps += p0[r] + p1[r]; }
    l = l * alpha + ps; m = mnew;
#pragma unroll
    for (int r = 0; r < 16; ++r) { o[0][r] *= alpha; o[1][r] *= alpha; }
#pragma unroll
    for (int hf = 0; hf < 2; ++hf)
#pragma unroll
        for (int j = 0; j < 2; ++j) {
            const f32x16& p = hf ? p1 : p0;
            u32x4 pw; pw.x = cvtpk(p[8 * j + 0], p[8 * j + 1]); pw.y = cvtpk(p[8 * j + 2], p[8 * j + 3]); pw.z = cvtpk(p[8 * j + 4], p[8 * j + 5]); pw.w = cvtpk(p[8 * j + 6], p[8 * j + 7]);
            const bf16x8 pb = __builtin_bit_cast(bf16x8, pw);
#pragma unroll
            for (int dh = 0; dh < 2; ++dh) o[dh] = MFMA32(vf[(hf * 2 + j) * 2 + dh], pb, o[dh]);
        }
}
template <int MODE, class Sel>
__device__ __forceinline__ void flash_loop(f32x16 (&o)[2], float& m, float& l, const bf16x8 (&qf)[4], const bf16_t* K, const bf16_t* Vt,
                                           int jlo, int jhi, int t, int tmin, int tmax, Sel sel, const float* F8, float Fq8, int lane) {
    const int hi = lane >> 5;
    int j = jlo;
    for (; j <= jhi; ++j) { if (__any(sel(j))) break; }
    bf16x8 kf[8], vf[8];
    if (j <= jhi) load_k64(kf, K + (size_t)j * 4096, lane);
    while (j <= jhi) {
        int jn = j + 1;
        for (; jn <= jhi; ++jn) { if (__any(sel(jn))) break; }
        load_v64(vf, Vt + (size_t)j * 4096, lane);
        f32x16 p0, p1;
        const int kb = j * 64;
        if (MODE == 2) {
#pragma unroll
            for (int g = 0; g < 4; ++g) {
                const f32x4 fa = *(const f32x4*)(F8 + kb + 8 * g + 4 * hi), fbv = *(const f32x4*)(F8 + kb + 32 + 8 * g + 4 * hi);
#pragma unroll
                for (int i = 0; i < 4; ++i) { p0[4 * g + i] = fa[i]; p1[4 * g + i] = fbv[i]; }
            }
        } else {
#pragma unroll
            for (int r = 0; r < 16; ++r) { p0[r] = 0.f; p1[r] = 0.f; }
        }
#pragma unroll
        for (int d0 = 0; d0 < 4; ++d0) { p0 = MFMA32(kf[d0], qf[d0], p0); p1 = MFMA32(kf[4 + d0], qf[d0], p1); }
        if (jn <= jhi) load_k64(kf, K + (size_t)jn * 4096, lane);
        bool full = (kb + 63 <= tmin);
        if (MODE == 1) full = full && (kb > tmax - 512);
        if (full) {
            if (MODE == 0 && !__all(sel(j))) softmax_pv<MODE, 1>(o, m, l, p0, p1, vf, kb, t, sel(j), F8, Fq8, hi);
            else softmax_pv<MODE, 0>(o, m, l, p0, p1, vf, kb, t, true, F8, Fq8, hi);
        } else softmax_pv<MODE, 2>(o, m, l, p0, p1, vf, kb, t, sel(j), F8, Fq8, hi);
        j = jn;
    }
}
__device__ __forceinline__ void load_q(bf16x8 (&qf)[4], const bf16_t* qrow, int hi) {
#pragma unroll
    for (int d0 = 0; d0 < 4; ++d0) qf[d0] = *(const bf16x8*)(qrow + 16 * d0 + 8 * hi);
}
__device__ __forceinline__ void store_o(bf16_t* dst, const f32x16 (&o)[2], int hi) {
#pragma unroll
    for (int dh = 0; dh < 2; ++dh)
#pragma unroll
        for (int g = 0; g < 4; ++g) {
            u32x2 w; w.x = cvtpk(o[dh][4 * g + 0], o[dh][4 * g + 1]); w.y = cvtpk(o[dh][4 * g + 2], o[dh][4 * g + 3]);
            *(u32x2*)(dst + 32 * dh + 8 * g + 4 * hi) = w;
        }
}
__device__ __forceinline__ unsigned nsa_select(const float (&imp)[32], int t) {
    const int tb = t >> 6;
    unsigned sel = 1u | (1u << tb) | (1u << (tb > 0 ? tb - 1 : 0));
#pragma unroll
    for (int it = 0; it < 5; ++it) {
        float bv = NEG_INF; int bj = -1;
#pragma unroll
        for (int j = 1; j < 32; ++j) { const bool cand = (j <= tb - 2) && !((sel >> j) & 1u) && (imp[j] > bv); if (cand) { bv = imp[j]; bj = j; } }
        if (bj >= 0) sel |= 1u << bj;
    }
    if (tb <= 7) sel = (2u << tb) - 1u;
    return sel;
}

__device__ __forceinline__ void nsa_unit(unsigned char* ws, int b, int g, int qg, int lane, float* wl) {
    const int hi = lane >> 5, c = lane & 31;
    const int t = qg * 8 + (c >> 2), head = g * 4 + (c & 3), row = b * SEQ + t, bg = b * 2 + g;
    bf16x8 qf[4];
    load_q(qf, (const bf16_t*)(ws + WS_QNSA) + (size_t)row * 512 + head * 64, hi);
    const float* gp = (const float*)(ws + WS_GATES) + (size_t)row * 24 + head * 3;
    const float g0 = gp[0];
    f32x16 o[2];
    float* oa = wl + 256 + lane;
    {
        const bf16_t* Kc = (const bf16_t*)(ws + WS_KCMP) + (size_t)bg * 8192;
        const bf16_t* Vct = (const bf16_t*)(ws + WS_VCMPT) + (size_t)bg * 8192;
        f32x16 s[4];
        float mx = NEG_INF;
#pragma unroll
        for (int tile = 0; tile < 2; ++tile) {
            bf16x8 kf[8];
            load_k64(kf, Kc + tile * 4096, lane);
#pragma unroll
            for (int hf = 0; hf < 2; ++hf) {
                const int grp = tile * 2 + hf;
#pragma unroll
                for (int r = 0; r < 16; ++r) s[grp][r] = 0.f;
#pragma unroll
                for (int d0 = 0; d0 < 4; ++d0) s[grp] = MFMA32(kf[hf * 4 + d0], qf[d0], s[grp]);
#pragma unroll
                for (int r = 0; r < 16; ++r) {
                    const int key = 32 * grp + crow(r, hi);
                    const float v = (16 * key + 31 <= t) ? s[grp][r] * QK_C2 : NEG_INF;
                    s[grp][r] = v; mx = fmaxf(mx, v);
                }
            }
        }
        mx = fmaxf(mx, __shfl_xor(mx, 32));
        const float msafe = (mx == NEG_INF) ? 0.f : mx;
        float ps = 0.f;
#pragma unroll
        for (int grp = 0; grp < 4; ++grp)
#pragma unroll
            for (int r = 0; r < 16; ++r) { s[grp][r] = fast_exp2(s[grp][r] - msafe); ps += s[grp][r]; }
        ps += __shfl_xor(ps, 32);
        const float inv = 1.0f / fmaxf(ps, 1e-30f);
#pragma unroll
        for (int grp = 0; grp < 4; ++grp)
#pragma unroll
            for (int r = 0; r < 16; ++r) s[grp][r] *= inv;
#pragma unroll
        for (int r = 0; r < 16; ++r) { o[0][r] = 0.f; o[1][r] = 0.f; }
#pragma unroll
        for (int tile = 0; tile < 2; ++tile) {
            bf16x8 vf[8];
            load_v64(vf, Vct + tile * 4096, lane);
#pragma unroll
            for (int hf = 0; hf < 2; ++hf)
#pragma unroll
                for (int j = 0; j < 2; ++j) {
                    const f32x16& p = s[tile * 2 + hf];
                    u32x4 pw; pw.x = cvtpk(p[8 * j + 0], p[8 * j + 1]); pw.y = cvtpk(p[8 * j + 2], p[8 * j + 3]); pw.z = cvtpk(p[8 * j + 4], p[8 * j + 5]); pw.w = cvtpk(p[8 * j + 6], p[8 * j + 7]);
                    const bf16x8 pb = __builtin_bit_cast(bf16x8, pw);
#pragma unroll
                    for (int dh = 0; dh < 2; ++dh) o[dh] = MFMA32(vf[(hf * 2 + j) * 2 + dh], pb, o[dh]);
                }
        }
#pragma unroll
        for (int r = 0; r < 16; ++r) { oa[r * 64] = g0 * o[0][r]; oa[(16 + r) * 64] = g0 * o[1][r]; }
        float recv[4][4];
#pragma unroll
        for (int grp = 0; grp < 4; ++grp)
#pragma unroll
            for (int gq = 0; gq < 4; ++gq) recv[grp][gq] = __shfl_xor(s[grp][4 * gq + 3], 32);
#pragma unroll
        for (int grp = 0; grp < 4; ++grp)
#pragma unroll
            for (int gq = 0; gq < 4; ++gq) {
                const float own = (s[grp][4 * gq] + s[grp][4 * gq + 1]) + (s[grp][4 * gq + 2] + s[grp][4 * gq + 3]);
                const float plo = (gq > 0) ? recv[grp][gq > 0 ? gq - 1 : 0] : ((grp > 0) ? recv[grp > 0 ? grp - 1 : 0][3] : 0.f);
                const float prev = hi ? recv[grp][gq] : plo;
                float v = own + prev;
                v += __shfl_xor(v, 1); v += __shfl_xor(v, 2);
                if ((c & 3) == 0) wl[(c >> 2) * 32 + 8 * grp + 2 * gq + hi] = v;
            }
    }
    asm volatile("s_waitcnt lgkmcnt(0)" ::: "memory");
    float imp[32];
#pragma unroll
    for (int j4 = 0; j4 < 8; ++j4) { const f32x4 v = *(const f32x4*)(wl + (c >> 2) * 32 + 4 * j4); imp[4 * j4] = v[0]; imp[4 * j4 + 1] = v[1]; imp[4 * j4 + 2] = v[2]; imp[4 * j4 + 3] = v[3]; }
    asm volatile("s_waitcnt lgkmcnt(0)" ::: "memory");
    const unsigned sel = nsa_select(imp, t);
    const int jmax = (qg * 8 + 7) >> 6;
    {
        const bf16_t* Ks = (const bf16_t*)(ws + WS_KS) + (size_t)bg * SEQ * 64;
        const bf16_t* Vst = (const bf16_t*)(ws + WS_VST) + (size_t)bg * 64 * SEQ;
        float m = NEG_INF, l = 0.f;
#pragma unroll
        for (int r = 0; r < 16; ++r) { o[0][r] = 0.f; o[1][r] = 0.f; }
        flash_loop<0>(o, m, l, qf, Ks, Vst, 0, jmax, t, qg * 8, qg * 8 + 7, [&](int j) { return (bool)((sel >> j) & 1u); }, nullptr, 0.f, lane);
        l += __shfl_xor(l, 32);
        const float sc = gp[1] / fmaxf(l, 1e-30f);
#pragma unroll
        for (int r = 0; r < 16; ++r) { oa[r * 64] += sc * o[0][r]; oa[(16 + r) * 64] += sc * o[1][r]; }
        asm volatile("s_waitcnt lgkmcnt(0)" ::: "memory");
    }
    {
        const bf16_t* Kw = (const bf16_t*)(ws + WS_KW) + (size_t)bg * SEQ * 64;
        const bf16_t* Vwt = (const bf16_t*)(ws + WS_VWT) + (size_t)bg * 64 * SEQ;
        float m = NEG_INF, l = 0.f;
#pragma unroll
        for (int r = 0; r < 16; ++r) { o[0][r] = 0.f; o[1][r] = 0.f; }
        const int tl = qg * 8 - 511;
        const int jlo = (tl > 0 ? tl : 0) >> 6;
        flash_loop<1>(o, m, l, qf, Kw, Vwt, jlo, jmax, t, qg * 8, qg * 8 + 7, [&](int) { return true; }, nullptr, 0.f, lane);
        l += __shfl_xor(l, 32);
        const float sc = gp[2] / fmaxf(l, 1e-30f);
#pragma unroll
        for (int r = 0; r < 16; ++r) { o[0][r] = oa[r * 64] + sc * o[0][r]; o[1][r] = oa[(16 + r) * 64] + sc * o[1][r]; }
        asm volatile("s_waitcnt lgkmcnt(0)" ::: "memory");
    }
    store_o((bf16_t*)(ws + WS_H) + (size_t)row * DM + head * 64, o, hi);
}

__device__ __forceinline__ void fox_unit(unsigned char* ws, int bh, int qt, int lane) {
    const int hi = lane >> 5, c = lane & 31, b = bh >> 2, h = bh & 3;
    const int t = qt * 32 + c, row = b * SEQ + t;
    bf16x8 qf[4];
    load_q(qf, (const bf16_t*)(ws + WS_FOXQ) + (size_t)row * 256 + h * 64, hi);
    const bf16_t* K = (const bf16_t*)(ws + WS_FOXK) + (size_t)bh * SEQ * 64;
    const bf16_t* Vt = (const bf16_t*)(ws + WS_FOXVT) + (size_t)bh * 64 * SEQ;
    const float* F2 = (const float*)(ws + WS_FCUM) + (size_t)bh * SEQ;
    const float Fq2 = F2[t];
    f32x16 o[2]; float m = NEG_INF, l = 0.f;
#pragma unroll
    for (int r = 0; r < 16; ++r) { o[0][r] = 0.f; o[1][r] = 0.f; }
    const int jmax = (qt * 32 + 31) >> 6;
    flash_loop<2>(o, m, l, qf, K, Vt, 0, jmax, t, qt * 32, qt * 32 + 31, [&](int) { return true; }, F2, Fq2, lane);
    l += __shfl_xor(l, 32);
    const float sc = 1.0f / fmaxf(l, 1e-30f);
#pragma unroll
    for (int r = 0; r < 16; ++r) { o[0][r] *= sc; o[1][r] *= sc; }
    store_o((bf16_t*)(ws + WS_H) + (size_t)row * DM + 512 + h * 64, o, hi);
}

__device__ __forceinline__ void moba_unit(unsigned char* ws, int bh, int qt, int lane) {
    const int hi = lane >> 5, c = lane & 31, b = bh >> 2, h = bh & 3;
    const int t = qt * 32 + c, row = b * SEQ + t;
    bf16x8 qf[4];
    load_q(qf, (const bf16_t*)(ws + WS_MOBAQ) + (size_t)row * 256 + h * 64, hi);
    const bf16_t* K = (const bf16_t*)(ws + WS_MOBAK) + (size_t)bh * SEQ * 64;
    const bf16_t* Vt = (const bf16_t*)(ws + WS_MOBAVT) + (size_t)bh * 64 * SEQ;
    const int own = (qt * 32) >> 8;
    unsigned sel = 0u;
    {
        float gt[7];
        const float* km = (const float*)(ws + WS_KMEAN) + (size_t)bh * 8 * 64;
#pragma unroll
        for (int blk = 0; blk < 7; ++blk) {
            float a = 0.f;
            if (blk < own) {
#pragma unroll
                for (int d0 = 0; d0 < 4; ++d0) {
                    const f32x4 k0 = *(const f32x4*)(km + blk * 64 + 16 * d0 + 8 * hi), k1 = *(const f32x4*)(km + blk * 64 + 16 * d0 + 8 * hi + 4);
#pragma unroll
                    for (int i = 0; i < 4; ++i) { a += bf2f(qf[d0][i]) * k0[i]; a += bf2f(qf[d0][4 + i]) * k1[i]; }
                }
                a += __shfl_xor(a, 32);
            }
            gt[blk] = a;
        }
#pragma unroll
        for (int it = 0; it < 3; ++it) {
            float bv = NEG_INF; int bj = -1;
#pragma unroll
            for (int blk = 0; blk < 7; ++blk) { const bool cand = (blk < own) && !((sel >> blk) & 1u) && (gt[blk] > bv); if (cand) { bv = gt[blk]; bj = blk; } }
            if (bj >= 0) sel |= 1u << bj;
        }
    }
    f32x16 o[2]; float m = NEG_INF, l = 0.f;
#pragma unroll
    for (int r = 0; r < 16; ++r) { o[0][r] = 0.f; o[1][r] = 0.f; }
    const int jmax = (qt * 32 + 31) >> 6;
    flash_loop<0>(o, m, l, qf, K, Vt, 0, jmax, t, qt * 32, qt * 32 + 31, [&](int j) { const int blk = j >> 2; return (blk == own) || (bool)((sel >> blk) & 1u); }, nullptr, 0.f, lane);
    l += __shfl_xor(l, 32);
    const float sc = 1.0f / fmaxf(l, 1e-30f);
#pragma unroll
    for (int r = 0; r < 16; ++r) { o[0][r] *= sc; o[1][r] *= sc; }
    store_o((bf16_t*)(ws + WS_H) + (size_t)row * DM + 768 + h * 64, o, hi);
}


#define XB_TMO      128
#define XB_XCNT(j)  (256  + 64 * (j))
#define XB_XSUB(j)  (1280 + 64 * (j))
#define XB_XGEN(j)  (2304 + 64 * (j))
#define XB_TOP      3328
#define XB_TOPGEN   3392
#define XCD_BAR_WORDS 3456
#define XB_SPIN_CAP (1u << 22)
__device__ __forceinline__ unsigned xb_ld(unsigned* p)              { return __hip_atomic_load(p, __ATOMIC_RELAXED, __HIP_MEMORY_SCOPE_AGENT); }
__device__ __forceinline__ unsigned xb_add(unsigned* p, unsigned v) { return __hip_atomic_fetch_add(p, v, __ATOMIC_RELAXED, __HIP_MEMORY_SCOPE_AGENT); }
__device__ __forceinline__ unsigned xb_xcc_id() { return (unsigned)__builtin_amdgcn_s_getreg((3 << 11) | 20) & 0xFu; }
#define XB_SPIN(cond, bar) do { unsigned _sp = 0; while (cond) { __builtin_amdgcn_s_sleep(1); \
    if ((++_sp & 255u) == 0u) { if (xb_ld(&(bar)[XB_TMO])) break; if (_sp > XB_SPIN_CAP) { atomicAdd(&(bar)[XB_TMO], 1u); break; } } } } while (0)
__device__ __forceinline__ void xcd_barrier_post(unsigned* bar, unsigned x, volatile LAS unsigned* st) {
    if (threadIdx.x == 0) st[2] = xb_add(&bar[XB_XCNT(x)], 1u);
}
__device__ __forceinline__ void xcd_barrier_complete(unsigned* bar, unsigned x, unsigned& nloc, unsigned& nx) {
    const unsigned G = gridDim.x * gridDim.y * gridDim.z;
    unsigned sum, cnt, mine, sp = 0u;
    for (;;) {
        sum = 0u; cnt = 0u; mine = 0u;
#pragma unroll
        for (unsigned j = 0; j < 16; ++j) { const unsigned c = xb_ld(&bar[XB_XCNT(j)]); sum += c; cnt += (c > 0u) ? 1u : 0u; mine = (j == x) ? c : mine; }
        if (sum == G) break;
        __builtin_amdgcn_s_sleep(1);
        if ((++sp & 255u) == 0u) { if (xb_ld(&bar[XB_TMO])) break; if (sp > XB_SPIN_CAP) { atomicAdd(&bar[XB_TMO], 1u); break; } }
    }
    nloc = mine > 0u ? mine : 1u; nx = cnt > 0u ? cnt : 1u;
}
__device__ __forceinline__ void xcd_barrier(unsigned* bar_, unsigned x_, volatile LAS unsigned* st, bool leader) {
    asm volatile("s_waitcnt vmcnt(0)" ::: "memory");
    __syncthreads();
    if (leader) {
        size_t zo = 0; unsigned x = x_;
        asm volatile("" : "+s"(zo), "+s"(x));
        unsigned* bar = bar_ + zo;
        __builtin_amdgcn_s_waitcnt(0);
        unsigned nloc = st[0], nx = st[1];
        if (nloc == 0u) { xcd_barrier_complete(bar, x, nloc, nx); st[0] = nloc; st[1] = nx; }
        const unsigned old = xb_add(&bar[XB_XSUB(x)], 1u);
        const unsigned gen = old / nloc;
        if (old + 1u == (gen + 1u) * nloc) {
            __builtin_amdgcn_fence(__ATOMIC_RELEASE, "agent");
            asm volatile("s_waitcnt vmcnt(0)" ::: "memory");
            const unsigned og = xb_add(&bar[XB_TOP], 1u);
            const unsigned tg = og / nx;
            if (og + 1u == (tg + 1u) * nx) xb_add(&bar[XB_TOPGEN], 1u);
            else XB_SPIN(xb_ld(&bar[XB_TOPGEN]) == tg, bar);
            __builtin_amdgcn_fence(__ATOMIC_ACQUIRE, "agent");
            xb_add(&bar[XB_XGEN(x)], 1u);
            asm volatile("s_waitcnt vmcnt(0)" ::: "memory");
        } else {
            XB_SPIN(xb_ld(&bar[XB_XGEN(x)]) == gen, bar);
            __builtin_amdgcn_fence(__ATOMIC_ACQUIRE, "agent");
            asm volatile("s_waitcnt vmcnt(0)" ::: "memory");
        }
    }
    __syncthreads();
}

__device__ __forceinline__ int map_identity(int n) { return n; }
__device__ __forceinline__ int map_w13(int n) { const int tile = n >> 8, w = n & 255; return (w < 128) ? tile * 128 + w : FF + tile * 128 + (w - 128); }
__device__ __forceinline__ int map_win(int n) {
    if (n < 640) return n;
    if (n < 768) return n - 640 + 768;
    if (n < 896) return n - 768 + 1024;
    if (n < 1152) return n - 896 + 1304;
    if (n < 1408) return n - 1152 + 1560;
    if (n < 1664) return n - 1408 + 2076;
    if (n < 1920) return n - 1664 + 2332;
    if (n < 2048) return n - 1920 + 640;
    if (n < 2176) return n - 2048 + 896;
    if (n < 2304) return n - 2176 + 1152;
    if (n < 2560) return n - 2304 + 1816;
    if (n < 2816) return n - 2560 + 2588;
    if (n < 2840) return n - 2816 + 1280;
    if (n < 2844) return n - 2840 + 2072;
    return -1;
}
template <int MAP>
__device__ __forceinline__ void transpose_item(const float* W, int K, int Nsrc, int Ndst, bf16_t* WT, float* scr, int item, int lane) {
    const int nblk = Ndst / 64, kb = item / nblk, nb = item % nblk, k0 = 64 * kb, n0 = 64 * nb;
    const int nq = (lane & 15) * 4, nd = n0 + nq;
    const int src = (MAP == 0) ? map_identity(nd) : (MAP == 1) ? map_w13(nd) : map_win(nd);
    f32x4 v[16];
#pragma unroll
    for (int i = 0; i < 16; ++i) { const int kk = 4 * i + (lane >> 4); v[i] = (src >= 0) ? *(const f32x4*)(W + (size_t)(k0 + kk) * Nsrc + src) : (f32x4){0.f, 0.f, 0.f, 0.f}; }
#pragma unroll
    for (int i = 0; i < 16; ++i) { const int kk = 4 * i + (lane >> 4); float* d = scr + kk * 65 + nq; d[0] = v[i][0]; d[1] = v[i][1]; d[2] = v[i][2]; d[3] = v[i][3]; }
    asm volatile("s_waitcnt lgkmcnt(0)" ::: "memory");
    const int cc = lane & 7;
#pragma unroll
    for (int j = 0; j < 8; ++j) { const int n = (lane >> 3) + 8 * j; const float* sp = scr + (8 * cc) * 65 + n;
        u32x4 ov; ov.x = cvtpk(sp[0 * 65], sp[1 * 65]); ov.y = cvtpk(sp[2 * 65], sp[3 * 65]); ov.z = cvtpk(sp[4 * 65], sp[5 * 65]); ov.w = cvtpk(sp[6 * 65], sp[7 * 65]);
        *(u32x4*)(WT + (size_t)(n0 + n) * K + k0 + 8 * cc) = ov; }
    asm volatile("s_waitcnt lgkmcnt(0)" ::: "memory");
}
__device__ __forceinline__ void sincos_acc(float ang, float& sn, float& cs) {
    const double a = (double)ang;
    const double k = __builtin_rint(a * 0.15915494309189535);
    const double r = (a - k * 6.283185307179586) * 0.25;
    const double r2 = r * r;
    double s = r * (1.0 + r2 * (-1.0 / 6 + r2 * (1.0 / 120 + r2 * (-1.0 / 5040 + r2 * (1.0 / 362880 + r2 * (-1.0 / 39916800 + r2 * (1.0 / 6227020800.0)))))));
    double c = 1.0 + r2 * (-0.5 + r2 * (1.0 / 24 + r2 * (-1.0 / 720 + r2 * (1.0 / 40320 + r2 * (-1.0 / 3628800 + r2 * (1.0 / 479001600.0))))));
    double s2 = 2.0 * s * c, c2 = c * c - s * s;
    double s4 = 2.0 * s2 * c2, c4 = c2 * c2 - s2 * s2;
    sn = (float)s4; cs = (float)c4;
}

struct Params {
    const float* x; const float* c; const int* positions; const float* norm_g; const float* w_ada; const float* b_ada; const float* w_in; const float* fox_fbias;
    const float* cmp_pos; const float* cmp_w1; const float* cmp_w2; const float* w_out; const float* ffn_w13; const float* ffn_w2; const float* final_g;
    float* out; unsigned char* ws;
};

__device__ __forceinline__ void prologue(const Params& P, unsigned char* lds, int tid, int lane, int wave, int G) {
    unsigned char* ws = P.ws;
    float* cact = (float*)lds;
    float* part = (float*)(lds + 65536);
    for (int i = tid; i < NB * DM; i += 512) { const float v = P.c[i]; cact[i] = v / (1.0f + __expf(-v)); }
    __syncthreads();
    float* MOD = (float*)(ws + WS_MOD);
    for (int item = blockIdx.x; item < DEPTH * 64; item += G) {
        const int l = item >> 6, jb = (item & 63) * 144, j0 = jb + 4 * lane;
        const bool act = lane < 36;
        const float* wp = P.w_ada + (size_t)l * DM * NADA + (act ? j0 : jb);
        f32x4 acc4[16];
#pragma unroll
        for (int b = 0; b < 16; ++b) acc4[b] = (f32x4){0.f, 0.f, 0.f, 0.f};
        const int kbeg = wave * 128;
#pragma unroll 4
        for (int k = kbeg; k < kbeg + 128; ++k) {
            const f32x4 w = *(const f32x4*)(wp + (size_t)k * NADA);
#pragma unroll
            for (int b = 0; b < 16; ++b) acc4[b] += w * cact[b * DM + k];
        }
        if (act) {
#pragma unroll
            for (int b = 0; b < 16; ++b) *(f32x4*)(part + (wave * 16 + b) * 144 + 4 * lane) = acc4[b];
        }
        __syncthreads();
        for (int o = tid; o < 16 * 144; o += 512) {
            const int b = o / 144, col = o % 144;
            float sm = 0.f;
#pragma unroll
            for (int w = 0; w < 8; ++w) sm += part[(w * 16 + b) * 144 + col];
            const int j = jb + col;
            MOD[((size_t)l * NB + b) * NADA + j] = sm + P.b_ada[(size_t)l * NADA + j];
        }
        __syncthreads();
    }
    float* scr = (float*)(lds + wave * 16640);
    const int gw = blockIdx.x * NWAVES + wave, NGW = G * NWAVES;
    constexpr int I_WIN = 16 * 48, I_WOUT = 16 * 16, I_CW1 = 32 * 4, I_W13 = 16 * 88, I_W2 = 44 * 16, I_CW2 = 4 * 1;
    constexpr int T_WIN = 4 * I_WIN, T_WOUT = 4 * I_WOUT, T_CW1 = 8 * I_CW1, T_W13 = 8 * I_W13, T_W2 = 8 * I_W2, T_CW2 = 8 * I_CW2;
    constexpr int NITEMS = T_WIN + T_WOUT + T_CW1 + T_W13 + T_W2 + T_CW2;
    for (int it = gw; it < NITEMS; it += NGW) {
        int r = it;
        if (r < T_W13) { const int q = r / I_W13; transpose_item<1>(P.ffn_w13 + (size_t)q * DM * 2 * FF, DM, 2 * FF, 2 * FF, (bf16_t*)(ws + WS_W13) + (size_t)q * 2 * FF * DM, scr, r % I_W13, lane); continue; } r -= T_W13;
        if (r < T_W2) { const int q = r / I_W2; transpose_item<0>(P.ffn_w2 + (size_t)q * FF * DM, FF, DM, DM, (bf16_t*)(ws + WS_W2) + (size_t)q * DM * FF, scr, r % I_W2, lane); continue; } r -= T_W2;
        if (r < T_WIN) { const int q = r / I_WIN; transpose_item<2>(P.w_in + (size_t)q * DM * 2844, DM, 2844, NIN, (bf16_t*)(ws + WS_WIN) + (size_t)q * NIN * DM, scr, r % I_WIN, lane); continue; } r -= T_WIN;
        if (r < T_WOUT) { const int q = r / I_WOUT; transpose_item<0>(P.w_out + (size_t)q * DM * DM, DM, DM, DM, (bf16_t*)(ws + WS_WOUT) + (size_t)q * DM * DM, scr, r % I_WOUT, lane); continue; } r -= T_WOUT;
        if (r < T_CW1) { const int q = r / I_CW1; transpose_item<0>(P.cmp_w1 + (size_t)q * 2048 * 256, 2048, 256, 256, (bf16_t*)(ws + WS_CW1) + (size_t)q * 256 * 2048, scr, r % I_CW1, lane); continue; } r -= T_CW1;
        { const int q = r / I_CW2; transpose_item<0>(P.cmp_w2 + (size_t)q * 256 * 64, 256, 64, 64, (bf16_t*)(ws + WS_CW2T) + (size_t)q * 64 * 256, scr, r % I_CW2, lane); }
    }
    {
        float* cosT = (float*)(ws + WS_COS); float* sinT = (float*)(ws + WS_SIN);
        for (int e = blockIdx.x * 512 + tid; e < NTOK * 8; e += G * 512) {
            const int i = e & 7;
            const float inv = (i == 0) ? 1.0f : (i == 1) ? 0.1939227432012558f : (i == 2) ? 0.03760603070259094f : (i == 3) ? 0.007292664609849453f :
                              (i == 4) ? 0.0014142135623842478f : (i == 5) ? 0.00027424818836152554f : (i == 6) ? 5.318296098266728e-05f : 1.0313386155758053e-05f;
            const float ang = (float)P.positions[e >> 3] * inv;
            float sn, cs; sincos_acc(ang, sn, cs);
            cosT[e] = cs; sinT[e] = sn;
        }
    }
}

__device__ __forceinline__ void norm_phase(const float* xin, const float* g, const float* mod  , bf16_t* H, int lane, int wave, int G) {
    const int gw = blockIdx.x * NWAVES + wave, NGW = G * NWAVES;
    for (int row = gw; row < NTOK; row += NGW) {
        const int b = row >> 11;
        const f32x4* xr = (const f32x4*)(xin + (size_t)row * DM) + lane;
        f32x4 v[4]; float s = 0.f;
#pragma unroll
        for (int j = 0; j < 4; ++j) { v[j] = xr[64 * j]; s += (v[j].x * v[j].x + v[j].y * v[j].y) + (v[j].z * v[j].z + v[j].w * v[j].w); }
        const float rstd = 1.0f / sqrtf(wave_sum(s) * (1.0f / DM) + 1e-6f);
        const f32x4* gr = (const f32x4*)g + lane;
        const f32x4* sh = (const f32x4*)(mod + (size_t)b * NADA) + lane;
        const f32x4* sc = (const f32x4*)(mod + (size_t)b * NADA + DM) + lane;
        u32x2* o8 = (u32x2*)(H + (size_t)row * DM) + lane;
#pragma unroll
        for (int j = 0; j < 4; ++j) {
            const f32x4 gg = gr[64 * j], s1 = sc[64 * j] + 1.0f, s0 = sh[64 * j];
            const f32x4 y = v[j] * rstd * gg * s1 + s0;
            u32x2 w; w.x = cvtpk(y.x, y.y); w.y = cvtpk(y.z, y.w);
            o8[64 * j] = w;
        }
    }
}
__device__ __forceinline__ void final_norm(float* x, const float* g, int lane, int wave, int G) {
    const int gw = blockIdx.x * NWAVES + wave, NGW = G * NWAVES;
    for (int row = gw; row < NTOK; row += NGW) {
        f32x4* xr = (f32x4*)(x + (size_t)row * DM) + lane;
        f32x4 v[4]; float s = 0.f;
#pragma unroll
        for (int j = 0; j < 4; ++j) { v[j] = xr[64 * j]; s += (v[j].x * v[j].x + v[j].y * v[j].y) + (v[j].z * v[j].z + v[j].w * v[j].w); }
        const float rstd = 1.0f / sqrtf(wave_sum(s) * (1.0f / DM) + 1e-6f);
        const f32x4* gr = (const f32x4*)g + lane;
#pragma unroll
        for (int j = 0; j < 4; ++j) xr[64 * j] = v[j] * rstd * gr[64 * j];
    }
}

__global__ void __launch_bounds__(512, 2) fwd_megakernel(Params P) {
    extern __shared__ __attribute__((aligned(16))) unsigned char lds[];
    cg::grid_group grid = cg::this_grid();
    const int tid = threadIdx.x, lane = tid & 63, wave = __builtin_amdgcn_readfirstlane(tid >> 6), wave0 = wave;
    const int G = gridDim.x;
    unsigned char* ws = P.ws;
    LAS unsigned char* lds3 = (LAS unsigned char*)lds;
    const float* MOD = (const float*)(ws + WS_MOD);
    unsigned* ctl = (unsigned*)(ws + WS_CTL);

    volatile LAS unsigned* bst = (volatile LAS unsigned*)(lds3 + LDS_BYTES - 64);
    if (tid == 0) { bst[0] = 0u; bst[1] = 0u; }
    __syncthreads();
    const unsigned xcc = (unsigned)__builtin_amdgcn_readfirstlane((int)xb_xcc_id());
    xcd_barrier_post(ctl + 65536, xcc, bst);
    const bool leader = (tid == 0);
#define GRID_BAR() xcd_barrier((unsigned*)(P.ws + WS_CTL) + 65536, xcc, bst, leader)
    prologue(P, lds, tid, lane, wave, G);
    if (P.ws == nullptr) grid.sync();
    GRID_BAR();
    if (tid == 0) {
        bool ok = ((G & 7) == 0);
        for (unsigned j = 0; j < 16; ++j) { const unsigned cnt = xb_ld(ctl + 65536 + XB_XCNT(j)); ok = ok && (cnt == ((j < 8u) ? (unsigned)(G >> 3) : 0u)); }
        bst[3] = ok ? (bst[2] * 8u + xcc) : (unsigned)blockIdx.x;
    }
    __syncthreads();
    const int vbid = __builtin_amdgcn_readfirstlane((int)bst[3]);
#ifdef PROBE_SYNC20
    for (int i = 0; i < 20; ++i) GRID_BAR();
#endif
    {
        const int ln = fresh_lane(), wv = wave0;
        for (int it = blockIdx.x * NWAVES + wv; it < 8 * 256; it += G * NWAVES) {
            const int lm = it >> 8;
            const bf16_t* wr_ = (const bf16_t*)(ws + WS_CW1) + (size_t)it * 2048 + ln * 32;
            const float* pp = P.cmp_pos + (size_t)lm * 2048 + ln * 32;
            float a = 0.f;
#pragma unroll
            for (int j = 0; j < 4; ++j) {
                const bf16x8 wv8 = *(const bf16x8*)(wr_ + 8 * j);
                const f32x4 p0 = *(const f32x4*)(pp + 8 * j), p1 = *(const f32x4*)(pp + 8 * j + 4);
#pragma unroll
                for (int i = 0; i < 4; ++i) { a += p0[i] * bf2f(wv8[i]); a += p1[i] * bf2f(wv8[4 + i]); }
            }
            a = wave_sum(a);
            if (ln == 0) ((float*)(ws + WS_B1))[it] = a;
        }
    }

    const float* xin = P.x;
    for (int l = 0; l < DEPTH; ++l) {
        const float* modl = MOD + (size_t)l * NB * NADA;
        for (int sub = 0; sub < 3; ++sub) {
            unsigned char* ws = launder_p(P.ws);
            const int bid = launder_i(vbid);
            const int lane = fresh_lane(), wave = wave0;
            norm_phase(xin, P.norm_g + ((size_t)l * 3 + sub) * DM, modl + (size_t)sub * 3 * DM, (bf16_t*)(ws + WS_H), lane, wave, G);
            GRID_BAR();
            if (sub != 1) {
                const int s = (sub == 0) ? 0 : 1;
                {
                    pg8::Gemm g{(const bf16_t*)(ws + WS_H), (const bf16_t*)(ws + WS_W13) + (size_t)(l * 2 + s) * 2 * FF * DM, NTOK, 2 * FF, DM, DM};
                    pg8::StaticOrder S; S.init(NTOK, 2 * FF, G, bid);
                    EpiSwiglu E{(bf16_t*)(ws + WS_BIG)};
#ifndef NO_G1
                    pg8::gemm_phase<EpiSwiglu, true>(lds3, g, S, E, wave0);
#endif
#ifdef PROBE_G1X2
                    pg8::gemm_phase<EpiSwiglu, true>(lds3, g, S, E, wave0);
#endif
                }
                GRID_BAR();
                {
                    pg8::Gemm g{(const bf16_t*)(ws + WS_BIG), (const bf16_t*)(ws + WS_W2) + (size_t)(l * 2 + s) * DM * FF, NTOK, DM, FF, FF};
                    pg8::StaticOrder S; S.init(NTOK, DM, G, bid);
                    EpiResid E{xin, P.out, modl + (size_t)(sub * 3 + 2) * DM, 0.5f};
#ifndef NO_G2
                    pg8::gemm_phase<EpiResid, true>(lds3, g, S, E, wave0);
#endif
                }
                xin = P.out;
                GRID_BAR();
            } else {
                {
                    pg8::Gemm g{(const bf16_t*)(ws + WS_H), (const bf16_t*)(ws + WS_WIN) + (size_t)l * NIN * DM, NTOK, NIN, DM, DM};
                    pg8::StaticOrder S; S.init(NTOK, NIN, G, bid);
                    EpiInProj E{ws, P.fox_fbias + l * 4};
#ifndef NO_INPROJ
                    pg8::gemm_phase<EpiInProj, true>(lds3, g, S, E, wave0);
#endif
                }
                GRID_BAR();
                if (bid < 32) {
                    const int mat = bid >> 4;
                    pg8::Gemm g{(const bf16_t*)(ws + (mat ? WS_VC : WS_KC)), (const bf16_t*)(ws + WS_CW1) + (size_t)(l * 2 + mat) * 256 * 2048, 4096, 256, 2048, 1024};
                    pg8::StaticOrder S; S.init(4096, 256, 16, bid & 15);
                    EpiGelu E{(bf16_t*)(ws + WS_CMPHID) + (size_t)mat * 4096 * 256, (const float*)(ws + WS_B1) + (l * 2 + mat) * 256};
#ifndef NO_CMP1
                    pg8::gemm_phase<EpiGelu, true>(lds3, g, S, E, wave0);
#endif
                } else {
                    const int nw = (G - 32) * NWAVES;
                    for (int it = (bid - 32) * NWAVES + wave; it < 64 + 512; it += nw) {
                        if (it < 64) {
                            const float* src = (const float*)(ws + WS_FLOG) + (size_t)it * SEQ + lane * 32;
                            float v[32];
#pragma unroll
                            for (int j = 0; j < 8; ++j) { const f32x4 q = *(const f32x4*)(src + 4 * j); v[4 * j] = q.x; v[4 * j + 1] = q.y; v[4 * j + 2] = q.z; v[4 * j + 3] = q.w; }
#pragma unroll
                            for (int j = 1; j < 32; ++j) v[j] += v[j - 1];
                            float tot = v[31], inc = tot;
#pragma unroll
                            for (int o = 1; o < 64; o <<= 1) { const float n = __shfl_up(inc, o); if (lane >= o) inc += n; }
                            const float excl = inc - tot;
                            float* dst = (float*)(ws + WS_FCUM) + (size_t)it * SEQ + lane * 32;
#pragma unroll
                            for (int j = 0; j < 8; ++j) { f32x4 q; q.x = (v[4 * j] + excl) * -8.0f; q.y = (v[4 * j + 1] + excl) * -8.0f; q.z = (v[4 * j + 2] + excl) * -8.0f; q.w = (v[4 * j + 3] + excl) * -8.0f; *(f32x4*)(dst + 4 * j) = q; }
                        } else {
                            const int id = it - 64;
                            const bf16_t* kp = (const bf16_t*)(ws + WS_MOBAK) + (size_t)id * 256 * 64 + (((lane >> 4) * 64 + ((lane >> 3) & 1) * 32) * 8 + (lane & 7));
                            float a = 0.f;
#pragma unroll 8
                            for (int k = 0; k < 256; ++k) a += bf2f((short)kp[(size_t)(k >> 6) * 4096 + (((k >> 5) & 1) * 4 * 64 + (k & 31)) * 8]);
                            ((float*)(ws + WS_KMEAN))[(size_t)id * 64 + lane] = a * (1.0f / 256.0f);
                        }
                    }
                }
                GRID_BAR();
                for (int it = bid * NWAVES + wave; it < 256; it += G * NWAVES) {
                    const int mat = it >> 7, rt = it & 127, hi = lane >> 5, c = lane & 31;
                    const bf16_t* A = (const bf16_t*)(ws + WS_CMPHID) + ((size_t)mat * 4096 + rt * 32 + c) * 256 + 8 * hi;
                    const bf16_t* Bt = (const bf16_t*)(ws + WS_CW2T) + (size_t)(l * 2 + mat) * 64 * 256 + (size_t)c * 256 + 8 * hi;
                    f32x16 a0, a1;
#pragma unroll
                    for (int r = 0; r < 16; ++r) { a0[r] = 0.f; a1[r] = 0.f; }
#pragma unroll 4
                    for (int ks = 0; ks < 16; ++ks) {
                        const bf16x8 af = *(const bf16x8*)(A + 16 * ks);
                        const bf16x8 b0 = *(const bf16x8*)(Bt + 16 * ks), b1 = *(const bf16x8*)(Bt + 32 * 256 + 16 * ks);
                        a0 = MFMA32(af, b0, a0); a1 = MFMA32(af, b1, a1);
                    }
#pragma unroll
                    for (int r = 0; r < 16; ++r) {
                        const int row = rt * 32 + crow(r, hi), rl = row & 127, bg = row >> 7;
                        const float v0 = (rl == 127) ? 0.f : a0[r], v1 = (rl == 127) ? 0.f : a1[r];
                        const bf16_t h0 = (bf16_t)(cvtpk(v0, 0.f) & 0xffffu), h1 = (bf16_t)(cvtpk(v1, 0.f) & 0xffffu);
                        if (mat == 0) {
                            bf16_t* kc = (bf16_t*)(ws + WS_KCMP) + (size_t)bg * 8192 + (rl >> 6) * 4096 + ((((rl >> 5) & 1) * 4) * 64 + (rl & 31)) * 8;
                            const int o0 = ((c >> 4) * 64 + ((c >> 3) & 1) * 32) * 8 + (c & 7);
                            kc[o0] = h0; kc[o0 + 2 * 64 * 8] = h1;
                        } else {
                            const int tt = rl & 63;
                            bf16_t* vc = (bf16_t*)(ws + WS_VCMPT) + (size_t)bg * 8192 + (rl >> 6) * 4096
                                         + ((((tt >> 5) * 2 + ((tt >> 4) & 1)) * 2) * 64 + ((tt >> 2) & 1) * 32 + c) * 8 + ((tt >> 3) & 1) * 4 + (tt & 3);
                            vc[0] = h0; vc[64 * 8] = h1;
                        }
                    }
                }
                GRID_BAR();
                {
#ifdef PROBE_ATTN2
                  for (int rep = 0; rep < 2; ++rep)
#else
                  const int rep = 0;
#endif
                  {
                    float* wl = (float*)(lds + wave * 16384);
                    const int lane_ = lane;
                    const int myq = (int)(__builtin_amdgcn_s_getreg((3 << 11) | 20) & 7u);
                    for (int qi = 0; qi < 8; ++qi) {
                        const int q = (myq + qi) & 7;
                        unsigned* ctr = ctl + 64 * (1 + (l * 2 + rep) * 8 + q);
                        for (;;) {
                            unsigned u = 0;
                            if (lane_ == 0) u = atomicAdd(ctr, 1u);
                            u = (unsigned)__builtin_amdgcn_readfirstlane((int)u);
                            if (u >= 2048u) break;
                            const int lane = launder_v(lane_);
                            if (u < 1024u) {
                                const int pr = (int)(u >> 9), i = (int)(u & 511u), slot = 63 - (i >> 3), w = i & 7;
                                const int bg = 4 * q + 2 * pr + (w >> 2);
                                nsa_unit(ws, bg >> 1, bg & 1, slot * 4 + (w & 3), lane, wl);
                            } else if (u < 1536u) {
                                const int i = (int)(u - 1024u), hf = i >> 8, slot = 63 - ((i & 255) >> 2);
                                fox_unit(ws, 8 * q + 4 * hf + (i & 3), slot, lane);
                            } else {
                                const int i = (int)(u - 1536u), hf = i >> 8, slot = 63 - ((i & 255) >> 2);
                                moba_unit(ws, 8 * q + 4 * hf + (i & 3), slot, lane);
                            }
                        }
                    }
                  }
                }
                GRID_BAR();
                {
                    pg8::Gemm g{(const bf16_t*)(ws + WS_H), (const bf16_t*)(ws + WS_WOUT) + (size_t)l * DM * DM, NTOK, DM, DM, DM};
                    pg8::StaticOrder S; S.init(NTOK, DM, G, bid);
                    EpiResid E{xin, P.out, modl + (size_t)(1 * 3 + 2) * DM, 1.0f};
#ifndef NO_OUTPROJ
                    pg8::gemm_phase<EpiResid, true>(lds3, g, S, E, wave0);
#endif
                }
                GRID_BAR();
            }
        }
    }
    final_norm(P.out, P.final_g, fresh_lane(), wave0, G);
}

extern "C" void kernel_launch(void* const* d_in, const int* in_sizes, int n_in, void* d_out, int out_size, void* d_ws, size_t ws_size, hipStream_t stream) {
    static int grid_blocks = 0;
    if (grid_blocks == 0) {
        if (n_in != 15 || ws_size < WS_END) { fprintf(stderr, "kernel_launch: unexpected inputs (n_in %d, ws %zu)\n", n_in, ws_size); grid_blocks = -1; return; }
        int dev = 0, cus = 0, per_cu = 0;
        hipGetDevice(&dev);
        hipDeviceGetAttribute(&cus, hipDeviceAttributeMultiprocessorCount, dev);
        if (hipFuncSetAttribute((const void*)fwd_megakernel, hipFuncAttributeMaxDynamicSharedMemorySize, LDS_BYTES) != hipSuccess) fprintf(stderr, "kernel_launch: hipFuncSetAttribute failed\n");
        if (hipOccupancyMaxActiveBlocksPerMultiprocessor(&per_cu, (const void*)fwd_megakernel, 512, LDS_BYTES) != hipSuccess || per_cu < 1) { fprintf(stderr, "kernel_launch: occupancy query gave %d\n", per_cu); per_cu = 1; }
        (void)hipGetLastError();
        grid_blocks = cus * per_cu;
        if (grid_blocks > 256) grid_blocks = 256;
    }
    if (grid_blocks < 0) return;
    hipMemsetAsync((char*)d_ws + WS_CTL, 0, 1 * MiB, stream);
    Params p{};
    p.x = (const float*)d_in[0]; p.c = (const float*)d_in[1]; p.positions = (const int*)d_in[2]; p.norm_g = (const float*)d_in[3];
    p.w_ada = (const float*)d_in[4]; p.b_ada = (const float*)d_in[5]; p.w_in = (const float*)d_in[6]; p.fox_fbias = (const float*)d_in[7];
    p.cmp_pos = (const float*)d_in[8]; p.cmp_w1 = (const float*)d_in[9]; p.cmp_w2 = (const float*)d_in[10]; p.w_out = (const float*)d_in[11];
    p.ffn_w13 = (const float*)d_in[12]; p.ffn_w2 = (const float*)d_in[13]; p.final_g = (const float*)d_in[14];
    p.out = (float*)d_out; p.ws = (unsigned char*)d_ws;
    void* args[] = {&p};
    hipError_t e = hipLaunchCooperativeKernel((const void*)fwd_megakernel, dim3(grid_blocks), dim3(512), args, LDS_BYTES, stream);
    if (e != hipSuccess) fprintf(stderr, "kernel_launch: cooperative launch failed: %s (grid %d)\n", hipGetErrorString(e), grid_blocks);
}
```

```cpp
#include <hip/hip_runtime.h>
#include <hip/hip_cooperative_groups.h>
#include <cstdio>
#include <cstdint>
namespace cg = cooperative_groups;

#define LAS __attribute__((address_space(3)))
typedef unsigned short bf16_t;
typedef short bf16x8 __attribute__((ext_vector_type(8)));
typedef short s16x4 __attribute__((ext_vector_type(4)));
typedef float f32x4 __attribute__((ext_vector_type(4)));
typedef float f32x2 __attribute__((ext_vector_type(2)));
typedef float f32x16 __attribute__((ext_vector_type(16)));
typedef unsigned u32x4 __attribute__((ext_vector_type(4)));
typedef unsigned u32x2 __attribute__((ext_vector_type(2)));
typedef __bf16 bf16x2_t __attribute__((ext_vector_type(2)));

constexpr int NB = 16, SEQ = 2048, DM = 1024, NTOK = NB * SEQ, DEPTH = 4, FF = 2816, NIN = 3072, NADA = 9216;
constexpr float LOG2E = 1.4426950408889634f;
constexpr float QK_C2 = 0.125f * LOG2E;
constexpr float NEG_INF = -__builtin_inff();

constexpr size_t MiB = 1u << 20;
constexpr size_t WS_CTL = 0;
constexpr size_t WS_B1 = 4 * MiB;
constexpr size_t WS_MOD = 1 * MiB;
constexpr size_t WS_COS = 5 * MiB, WS_SIN = 6 * MiB;
constexpr size_t WS_CW2T = 7 * MiB;
constexpr size_t WS_WIN = 8 * MiB;
constexpr size_t WS_WOUT = 32 * MiB;
constexpr size_t WS_CW1 = 40 * MiB;
constexpr size_t WS_W13 = 48 * MiB;
constexpr size_t WS_W2 = 136 * MiB;
constexpr size_t WS_H = 180 * MiB;
constexpr size_t WS_BIG = 244 * MiB;
constexpr size_t WS_QNSA = 244 * MiB;
constexpr size_t WS_KC = 276 * MiB;
constexpr size_t WS_VC = 285 * MiB;
constexpr size_t WS_KS = 294 * MiB, WS_KW = 302 * MiB;
constexpr size_t WS_FOXQ = 310 * MiB;
constexpr size_t WS_FOXK = 326 * MiB;
constexpr size_t WS_MOBAQ = 342 * MiB, WS_MOBAK = 358 * MiB;
constexpr size_t WS_VST = 374 * MiB, WS_VWT = 382 * MiB;
constexpr size_t WS_FOXVT = 390 * MiB, WS_MOBAVT = 406 * MiB;
constexpr size_t WS_GATES = 422 * MiB;
constexpr size_t WS_FLOG = 425 * MiB;
constexpr size_t WS_FCUM = 426 * MiB;
constexpr size_t WS_KMEAN = 427 * MiB;
constexpr size_t WS_CMPHID = 428 * MiB;
constexpr size_t WS_KCMP = 432 * MiB;
constexpr size_t WS_VCMPT = 433 * MiB;
constexpr size_t WS_END = 436 * MiB;

constexpr int RING_BYTES = 131072;
constexpr int LDS_BYTES = 147456;
constexpr int NWAVES = 8;

__device__ __forceinline__ unsigned cvtpk(float lo, float hi) { f32x2 v = {lo, hi}; bf16x2_t b = __builtin_convertvector(v, bf16x2_t); return __builtin_bit_cast(unsigned, b); }
__device__ __forceinline__ float bf2f(short s) { return __uint_as_float(((unsigned)(unsigned short)s) << 16); }
__device__ __forceinline__ float fast_exp2(float x) { return __builtin_amdgcn_exp2f(x); }
__device__ __forceinline__ float fast_rcp(float x) { return __builtin_amdgcn_rcpf(x); }
__device__ __forceinline__ float silu_f(float a) { return a * fast_rcp(1.0f + fast_exp2(-a * LOG2E)); }
__device__ __forceinline__ float sigmoid_f(float a) { return 1.0f / (1.0f + __expf(-a)); }
__device__ __forceinline__ float gelu_tanh(float x) {
    const float u = 0.7978845608028654f * (x + 0.044715f * x * x * x);
    const float e = fast_exp2(2.0f * LOG2E * u);
    const float th = 1.0f - 2.0f * fast_rcp(e + 1.0f);
    return 0.5f * x * (1.0f + th);
}
__device__ __forceinline__ float wave_sum(float v) {
#pragma unroll
    for (int o = 1; o < 64; o <<= 1) v += __shfl_xor(v, o);
    return v;
}
__device__ __forceinline__ unsigned char* launder_p(unsigned char* p) { size_t z = 0; asm volatile("" : "+s"(z)); return p + z; }
__device__ __forceinline__ int launder_i(int v) { asm volatile("" : "+s"(v)); return v; }
__device__ __forceinline__ int launder_v(int v) { asm volatile("" : "+v"(v)); return v; }
__device__ __forceinline__ int fresh_lane() { unsigned m = ~0u; asm volatile("" : "+s"(m)); return (int)__builtin_amdgcn_mbcnt_hi(m, __builtin_amdgcn_mbcnt_lo(m, 0u)); }
__device__ __forceinline__ int crow(int r, int hi) { return (r & 3) + 8 * (r >> 2) + 4 * hi; }

namespace pg8 {
constexpr int BM = 256, BK = 64, HALF = 128, HTB = HALF * BK * 2, STAGE_BYTES = 8 * HTB, NXCD = 8, WGM = 8;
__host__ __device__ __forceinline__ int lds_byte(int r, int c) { const int st = (r >> 4) * 2 + (c >> 5), rr = r & 15, cc = c & 31, ob = rr * 64 + cc * 2; return st * 1024 + (ob ^ (((ob >> 9) & 1) << 5)); }
__host__ __device__ __forceinline__ void stage_rc(int b, int& R, int& C) { const int st = b / 1024, sb = b % 1024, swz = sb ^ (((sb >> 9) & 1) << 5); R = (st >> 1) * 16 + swz / 64; C = (st & 1) * 32 + (swz % 64) / 2; }
__host__ __device__ __forceinline__ int perm32(int rho) { const int n = rho >> 4, i = rho & 15; return 8 * (i >> 2) + 4 * n + (i & 3); }

struct Unit { int pm, pn; };
struct Gemm { const bf16_t* A; const bf16_t* Bt; int M, N, K, lda; };

struct StaticOrder {
    int nM, nN, nwg, G, c;
    __device__ void init(int M, int N, int G_, int c_) { nM = M / BM; nN = N / BM; nwg = nM * nN; G = G_; c = c_; }
    __device__ bool next(int i, Unit& u) const {
        const long L = (long)i * G + c; if (L >= nwg) return false;
        int wgid = (int)L; { const int q = nwg / NXCD, r = nwg % NXCD, xcd = wgid % NXCD, off = wgid / NXCD; wgid = (xcd < r ? xcd * (q + 1) : r * (q + 1) + (xcd - r) * q) + off; }
        const int nig = WGM * nN, gid = wgid / nig, fm = gid * WGM, gsz = (nM - fm) < WGM ? (nM - fm) : WGM;
        u.pm = fm + ((wgid % nig) % gsz); u.pn = (wgid % nig) / gsz; return true;
    }
};

template <class Epi, bool ALIGN_EPI>
__device__ __forceinline__ void gemm_phase(LAS unsigned char* lds, const Gemm g, const StaticOrder& S, const Epi& E, int wave0) {
    const int wid = wave0, lane = fresh_lane(), tid = wid * 64 + lane, wr = wid >> 2, wc = wid & 3, fr = lane & 15, fq = lane >> 4;
    const int K = g.K, nt = K / BK, lda = g.lda;
    unsigned voffA[2], voffB[2];
#pragma unroll
    for (int i = 0; i < 2; ++i) { int R, C; stage_rc(tid * 16 + i * 8192, R, C); const int Rb = Epi::PERM ? ((R & ~31) + perm32(R & 31)) : R;
        voffA[i] = (unsigned)(R * lda + C) * 2u; voffB[i] = (unsigned)(Rb * K + C) * 2u; }
    const size_t kstep = (size_t)(BK * 2);
    const size_t hstepA = (size_t)HALF * lda * 2, hstepB = (size_t)HALF * K * 2;
    const size_t tstepA = 2 * hstepA, tstepB = 2 * hstepB;
    const unsigned ldsw = (unsigned)wid * 1024u;
    const int aoff = lds_byte(wr * 64 + fr, fq * 8), boff = lds_byte(wc * 32 + fr, fq * 8);
#define PG8_SA(b, h) (((b) * 2 + (h)) * HTB)
#define PG8_SB(b, h) ((4 + (b) * 2 + (h)) * HTB)
#define PG8_STAGE(bufoff, gbase, voff) do { _Pragma("unroll") for (int _i = 0; _i < 2; ++_i) \
        __builtin_amdgcn_global_load_lds((const unsigned*)((const char*)(gbase) + (voff)[_i]), (LAS unsigned*)(lds + (bufoff) + ldsw + _i * 8192), 16, 0, 0); } while (0)
#define PG8_LDA(dst, b, h) do { _Pragma("unroll") for (int m = 0; m < 4; ++m) _Pragma("unroll") for (int k = 0; k < 2; ++k) dst[m][k] = *(const LAS bf16x8*)(lds + PG8_SA(b, h) + aoff + m * 2048 + k * 1024); } while (0)
#define PG8_LDB(dst, b, h) do { _Pragma("unroll") for (int n = 0; n < 2; ++n) _Pragma("unroll") for (int k = 0; k < 2; ++k) dst[n][k] = *(const LAS bf16x8*)(lds + PG8_SB(b, h) + boff + n * 2048 + k * 1024); } while (0)
#define PG8_MMA(ai, bj, At, Bt) do { __builtin_amdgcn_s_setprio(1); _Pragma("unroll") for (int m = 0; m < 4; ++m) _Pragma("unroll") for (int n = 0; n < 2; ++n) _Pragma("unroll") for (int k = 0; k < 2; ++k) \
        acc[ai][bj][m][n] = __builtin_amdgcn_mfma_f32_16x16x32_bf16(Bt[n][k], At[m][k], acc[ai][bj][m][n], 0, 0, 0); __builtin_amdgcn_s_setprio(0); } while (0)
#define PG8_WAIT_V(n) asm volatile("s_waitcnt vmcnt(" #n ")" ::: "memory")
#define PG8_WAIT_L(n) asm volatile("s_waitcnt lgkmcnt(" #n ")" ::: "memory")
#define PG8_BAR __builtin_amdgcn_s_barrier()
#define PG8_SCHED __builtin_amdgcn_sched_barrier(0)
    Unit cur, nxt; int ui = 0;
    if (!S.next(0, cur)) return;
    f32x4 acc[2][2][4][2];
#pragma unroll
    for (int a = 0; a < 2; ++a)
#pragma unroll
        for (int b = 0; b < 2; ++b)
#pragma unroll
            for (int m = 0; m < 4; ++m)
#pragma unroll
                for (int n = 0; n < 2; ++n) acc[a][b][m][n] = (f32x4){0.f, 0.f, 0.f, 0.f};
    bf16x8 At[4][2], B0[2][2], B1[2][2];
    const char* cA = (const char*)g.A + (size_t)cur.pm * tstepA; const char* cB = (const char*)g.Bt + (size_t)cur.pn * tstepB;
    PG8_STAGE(PG8_SB(0, 0), cB, voffB); PG8_STAGE(PG8_SB(0, 1), cB + hstepB, voffB); PG8_STAGE(PG8_SA(0, 0), cA, voffA); PG8_STAGE(PG8_SA(0, 1), cA + hstepA, voffA);
    if (wr == 1) PG8_BAR;
    PG8_WAIT_V(2); PG8_BAR;
    PG8_STAGE(PG8_SB(1, 0), cB + kstep, voffB); PG8_STAGE(PG8_SA(1, 0), cA + kstep, voffA); PG8_STAGE(PG8_SB(1, 1), cB + hstepB + kstep, voffB);
    PG8_WAIT_V(6); PG8_BAR;
    for (;;) {
        const bool has_next = S.next(ui + 1, nxt);
        const char* nA = has_next ? (const char*)g.A + (size_t)nxt.pm * tstepA : cA; const char* nB = has_next ? (const char*)g.Bt + (size_t)nxt.pn * tstepB : cB;
        for (int t = 0; t < nt; t += 2) {
            const bool last = (t == nt - 2);
            const char* a1 = cA + (size_t)(t + 1) * kstep;
            const char* a2 = last ? nA : cA + (size_t)(t + 2) * kstep; const char* b2 = last ? nB : cB + (size_t)(t + 2) * kstep;
            const char* a3 = a2 + kstep; const char* b3 = b2 + kstep;
            PG8_LDB(B0, 0, 0); PG8_LDB(B1, 0, 1); PG8_SCHED; PG8_LDA(At, 0, 0); PG8_STAGE(PG8_SA(1, 1), a1 + hstepA, voffA);
            PG8_WAIT_V(8); PG8_WAIT_L(0); PG8_BAR; PG8_MMA(0, 0, At, B0); PG8_MMA(0, 1, At, B1); PG8_BAR; PG8_SCHED;
            PG8_LDA(At, 0, 1); PG8_STAGE(PG8_SB(0, 0), b2, voffB); PG8_STAGE(PG8_SB(0, 1), b2 + hstepB, voffB); PG8_STAGE(PG8_SA(0, 0), a2, voffA);
            PG8_WAIT_V(8); PG8_WAIT_L(0); PG8_BAR; PG8_MMA(1, 0, At, B0); PG8_MMA(1, 1, At, B1); PG8_BAR; PG8_SCHED;
            PG8_LDB(B0, 1, 0); PG8_LDB(B1, 1, 1); PG8_SCHED; PG8_LDA(At, 1, 0); PG8_STAGE(PG8_SA(0, 1), a2 + hstepA, voffA);
            PG8_WAIT_V(8); PG8_WAIT_L(0); PG8_BAR; PG8_MMA(0, 0, At, B0); PG8_MMA(0, 1, At, B1); PG8_BAR; PG8_SCHED;
            PG8_LDA(At, 1, 1); PG8_STAGE(PG8_SB(1, 0), b3, voffB); PG8_STAGE(PG8_SB(1, 1), b3 + hstepB, voffB); PG8_STAGE(PG8_SA(1, 0), a3, voffA);
            PG8_WAIT_V(8); PG8_WAIT_L(0); PG8_BAR; PG8_MMA(1, 0, At, B0); PG8_MMA(1, 1, At, B1); PG8_BAR; PG8_SCHED;
        }
        if constexpr (ALIGN_EPI) { if (wr == 0) PG8_BAR; }
        { int efr = fr, efq = fq, ewr = wr, ewc = wc; asm volatile("" : "+v"(efr), "+v"(efq), "+s"(ewr), "+s"(ewc)); E(acc, cur, ewr, ewc, efr, efq); }
        if (!has_next) break;
#pragma unroll
        for (int a = 0; a < 2; ++a)
#pragma unroll
            for (int b = 0; b < 2; ++b)
#pragma unroll
                for (int m = 0; m < 4; ++m)
#pragma unroll
                    for (int n = 0; n < 2; ++n) acc[a][b][m][n] = (f32x4){0.f, 0.f, 0.f, 0.f};
        cur = nxt; cA = nA; cB = nB; ++ui;
        if constexpr (ALIGN_EPI) { if (wr == 1) PG8_BAR; }
    }
    PG8_WAIT_V(0);
    if constexpr (!ALIGN_EPI) { if (wr == 0) PG8_BAR; }
    PG8_BAR;
#undef PG8_SA
#undef PG8_SB
#undef PG8_STAGE
#undef PG8_LDA
#undef PG8_LDB
#undef PG8_MMA
#undef PG8_WAIT_V
#undef PG8_WAIT_L
#undef PG8_BAR
#undef PG8_SCHED
}
}

struct EpiSwiglu {
    static constexpr bool PERM = true;
    bf16_t* O;
    __device__ __forceinline__ void operator()(const f32x4 (&acc)[2][2][4][2], const pg8::Unit& u, int wr, int wc, int fr, int fq) const {
        const int row0 = u.pm * 256 + wr * 64 + fr, col0 = u.pn * 128 + wc * 32 + 8 * fq;
#pragma unroll
        for (int ai = 0; ai < 2; ++ai)
#pragma unroll
            for (int m = 0; m < 4; ++m) {
                bf16_t* rowp = O + (size_t)(row0 + ai * 128 + m * 16) * FF + col0;
                const f32x4 a0 = acc[ai][0][m][0], a1 = acc[ai][0][m][1], b0 = acc[ai][1][m][0], b1 = acc[ai][1][m][1];
                u32x4 w;
                w.x = cvtpk(silu_f(a0[0]) * b0[0], silu_f(a0[1]) * b0[1]); w.y = cvtpk(silu_f(a0[2]) * b0[2], silu_f(a0[3]) * b0[3]);
                w.z = cvtpk(silu_f(a1[0]) * b1[0], silu_f(a1[1]) * b1[1]); w.w = cvtpk(silu_f(a1[2]) * b1[2], silu_f(a1[3]) * b1[3]);
                *(u32x4*)rowp = w;
            }
    }
};
struct EpiResid {
    static constexpr bool PERM = false;
    const float* xin; float* xout; const float* gate; float coef;
    __device__ __forceinline__ void operator()(const f32x4 (&acc)[2][2][4][2], const pg8::Unit& u, int wr, int wc, int fr, int fq) const {
        const int b = (u.pm * 256) >> 11;
        const int row0 = u.pm * 256 + wr * 64 + fr;
#pragma unroll
        for (int bj = 0; bj < 2; ++bj)
#pragma unroll
            for (int n = 0; n < 2; ++n) {
                const int col = u.pn * 256 + bj * 128 + wc * 32 + n * 16 + 4 * fq;
                const f32x4 gv = *(const f32x4*)(gate + (size_t)b * NADA + col) * coef;
                f32x4 xv[2][4];
#pragma unroll
                for (int ai = 0; ai < 2; ++ai)
#pragma unroll
                    for (int m = 0; m < 4; ++m) xv[ai][m] = *(const f32x4*)(xin + (size_t)(row0 + ai * 128 + m * 16) * DM + col);
#pragma unroll
                for (int ai = 0; ai < 2; ++ai)
#pragma unroll
                    for (int m = 0; m < 4; ++m) {
                        const size_t off = (size_t)(row0 + ai * 128 + m * 16) * DM + col;
                        *(f32x4*)(xout + off) = xv[ai][m] + gv * acc[ai][bj][m][n];
                    }
            }
    }
};
struct EpiGelu {
    static constexpr bool PERM = true;
    bf16_t* O; const float* bias;
    __device__ __forceinline__ void operator()(const f32x4 (&acc)[2][2][4][2], const pg8::Unit& u, int wr, int wc, int fr, int fq) const {
        const int row0 = u.pm * 256 + wr * 64 + fr;
#pragma unroll
        for (int bj = 0; bj < 2; ++bj) {
            const int col0 = u.pn * 256 + bj * 128 + wc * 32 + 8 * fq;
            const f32x4 bv0 = *(const f32x4*)(bias + col0), bv1 = *(const f32x4*)(bias + col0 + 4);
#pragma unroll
            for (int ai = 0; ai < 2; ++ai)
#pragma unroll
                for (int m = 0; m < 4; ++m) {
                    const f32x4 v0 = acc[ai][bj][m][0] + bv0, v1 = acc[ai][bj][m][1] + bv1;
                    u32x4 w;
                    w.x = cvtpk(gelu_tanh(v0[0]), gelu_tanh(v0[1])); w.y = cvtpk(gelu_tanh(v0[2]), gelu_tanh(v0[3]));
                    w.z = cvtpk(gelu_tanh(v1[0]), gelu_tanh(v1[1])); w.w = cvtpk(gelu_tanh(v1[2]), gelu_tanh(v1[3]));
                    *(u32x4*)(O + (size_t)(row0 + ai * 128 + m * 16) * 256 + col0) = w;
                }
        }
    }
};
struct EpiInProj {
    static constexpr bool PERM = true;
    unsigned char* ws; const float* fbias;
    __device__ __forceinline__ void operator()(const f32x4 (&acc)[2][2][4][2], const pg8::Unit& u, int wr, int wc, int fr, int fq) const {
        part<0>(acc, u, wr, wc, fr, fq); part<1>(acc, u, wr, wc, fr, fq);
    }
    template <int bj>
    __device__ __forceinline__ void part(const f32x4 (&acc)[2][2][4][2], const pg8::Unit& u, int wr, int wc, int fr, int fq) const {
        const float* cosT = (const float*)(ws + WS_COS); const float* sinT = (const float*)(ws + WS_SIN);
        {
            const int cb = u.pn * 256 + bj * 128 + wc * 32;
            const int hg = cb >> 6, half = (cb >> 5) & 1;
            if (hg > 44) return;
            int mode, NH = 1, hd = 0, pitch = 0; bool rope = false; bf16_t* base = nullptr;
            if (hg < 8)       { mode = 0; base = (bf16_t*)(ws + WS_QNSA); pitch = 512; hd = hg; rope = true; }
            else if (hg < 10) { mode = 1; base = (bf16_t*)(ws + WS_KC); NH = 2; hd = hg - 8; rope = true; }
            else if (hg < 12) { mode = 4; base = (bf16_t*)(ws + WS_KS); NH = 2; hd = hg - 10; rope = true; }
            else if (hg < 14) { mode = 4; base = (bf16_t*)(ws + WS_KW); NH = 2; hd = hg - 12; rope = true; }
            else if (hg < 18) { mode = 0; base = (bf16_t*)(ws + WS_FOXQ); pitch = 256; hd = hg - 14; }
            else if (hg < 22) { mode = 4; base = (bf16_t*)(ws + WS_FOXK); NH = 4; hd = hg - 18; }
            else if (hg < 26) { mode = 0; base = (bf16_t*)(ws + WS_MOBAQ); pitch = 256; hd = hg - 22; rope = true; }
            else if (hg < 30) { mode = 4; base = (bf16_t*)(ws + WS_MOBAK); NH = 4; hd = hg - 26; rope = true; }
            else if (hg < 32) { mode = 1; base = (bf16_t*)(ws + WS_VC); NH = 2; hd = hg - 30; }
            else if (hg < 34) { mode = 2; base = (bf16_t*)(ws + WS_VST); NH = 2; hd = hg - 32; }
            else if (hg < 36) { mode = 2; base = (bf16_t*)(ws + WS_VWT); NH = 2; hd = hg - 34; }
            else if (hg < 40) { mode = 2; base = (bf16_t*)(ws + WS_FOXVT); NH = 4; hd = hg - 36; }
            else if (hg < 44) { mode = 2; base = (bf16_t*)(ws + WS_MOBAVT); NH = 4; hd = hg - 40; }
            else { mode = 3; if (half) return; }
            const bool do_rope = rope && (half == 0);
#pragma unroll
            for (int ai = 0; ai < 2; ++ai) {
                f32x4 rc[4][4];
                if (do_rope && fq < 2) {
#pragma unroll
                    for (int m = 0; m < 4; ++m) {
                        const size_t ro = (size_t)(u.pm * 256 + ai * 128 + wr * 64 + m * 16 + fr) * 8;
                        rc[m][0] = *(const f32x4*)(cosT + ro); rc[m][1] = *(const f32x4*)(cosT + ro + 4);
                        rc[m][2] = *(const f32x4*)(sinT + ro); rc[m][3] = *(const f32x4*)(sinT + ro + 4);
                    }
                }
#pragma unroll
                for (int m = 0; m < 4; ++m) {
                    const int row = u.pm * 256 + ai * 128 + wr * 64 + m * 16 + fr;
                    const int b = row >> 11, t = row & 2047;
                    float v[8];
#pragma unroll
                    for (int i = 0; i < 4; ++i) { v[i] = acc[ai][bj][m][0][i]; v[4 + i] = acc[ai][bj][m][1][i]; }
                    if (do_rope) {
                        float pr[8];
#pragma unroll
                        for (int i = 0; i < 8; ++i) pr[i] = __shfl_xor(v[i], 16);
                        if (fq < 2) {
                            const f32x4 c0 = rc[m][0], c1 = rc[m][1], s0 = rc[m][2], s1 = rc[m][3];
                            const float sg = (fq == 0) ? -1.0f : 1.0f;
#pragma unroll
                            for (int i = 0; i < 4; ++i) { v[i] = v[i] * c0[i] + sg * pr[i] * s0[i]; v[4 + i] = v[4 + i] * c1[i] + sg * pr[4 + i] * s1[i]; }
                        }
                    }
                    if (mode == 3) {
                        float* gates = (float*)(ws + WS_GATES); float* flog = (float*)(ws + WS_FLOG);
                        if (fq < 3) {
                            f32x4 g0, g1;
#pragma unroll
                            for (int i = 0; i < 4; ++i) { g0[i] = sigmoid_f(v[i]); g1[i] = sigmoid_f(v[4 + i]); }
                            *(f32x4*)(gates + (size_t)row * 24 + 8 * fq) = g0; *(f32x4*)(gates + (size_t)row * 24 + 8 * fq + 4) = g1;
                        } else {
#pragma unroll
                            for (int i = 0; i < 4; ++i) {
                                const float z = v[i] + fbias[i];
                                const float ls = (z > 0.f) ? -log1pf(__expf(-z)) : (z - log1pf(__expf(z)));
                                flog[(size_t)(b * 4 + i) * SEQ + t] = ls;
                            }
                        }
                    } else {
                        u32x4 w; w.x = cvtpk(v[0], v[1]); w.y = cvtpk(v[2], v[3]); w.z = cvtpk(v[4], v[5]); w.w = cvtpk(v[6], v[7]);
                        const int dcol = half * 32 + 8 * fq;
                        if (mode == 0) *(u32x4*)(base + (size_t)row * pitch + hd * 64 + dcol) = w;
                        else if (mode == 1) *(u32x4*)(base + ((size_t)(b * NH + hd) * SEQ + t) * 64 + dcol) = w;
                        else if (mode == 4) {
                            const int d0 = half * 2 + (fq >> 1), khi = fq & 1;
                            *(u32x4*)(base + (size_t)(b * NH + hd) * SEQ * 64 + (size_t)(t >> 6) * 4096 + ((((t >> 5) & 1) * 4 + d0) * 64 + khi * 32 + (t & 31)) * 8) = w;
                        } else {
                            const int tt = t & 63, hf = tt >> 5, jj = (tt >> 4) & 1, piece = (tt >> 3) & 1, vhi = (tt >> 2) & 1, e = tt & 3;
                            bf16_t* p = base + (size_t)(b * NH + hd) * SEQ * 64 + (size_t)(t >> 6) * 4096 + (((hf * 2 + jj) * 2 + half) * 64 + vhi * 32 + 8 * fq) * 8 + piece * 4 + e;
                            p[0 * 8] = (bf16_t)(w.x & 0xffffu); p[1 * 8] = (bf16_t)(w.x >> 16);
                            p[2 * 8] = (bf16_t)(w.y & 0xffffu); p[3 * 8] = (bf16_t)(w.y >> 16);
                            p[4 * 8] = (bf16_t)(w.z & 0xffffu); p[5 * 8] = (bf16_t)(w.z >> 16);
                            p[6 * 8] = (bf16_t)(w.w & 0xffffu); p[7 * 8] = (bf16_t)(w.w >> 16);
                        }
                    }
                }
            }
        }
    }
};

#define MFMA32(a, b, c) __builtin_amdgcn_mfma_f32_32x32x16_bf16((a), (b), (c), 0, 0, 0)
__device__ __forceinline__ f32x16 qk32(const bf16_t* kp, const bf16x8 (&qf)[4]) {
    f32x16 p;
#pragma unroll
    for (int r = 0; r < 16; ++r) p[r] = 0.f;
#pragma unroll
    for (int d0 = 0; d0 < 4; ++d0) { const bf16x8 kf = *(const bf16x8*)(kp + 16 * d0); p = MFMA32(kf, qf[d0], p); }
    return p;
}
__device__ __forceinline__ void pv32(f32x16 (&o)[2], const bf16_t* vp, int vpitch, const f32x16& p) {
#pragma unroll
    for (int j = 0; j < 2; ++j) {
        u32x4 pw; pw.x = cvtpk(p[8 * j + 0], p[8 * j + 1]); pw.y = cvtpk(p[8 * j + 2], p[8 * j + 3]); pw.z = cvtpk(p[8 * j + 4], p[8 * j + 5]); pw.w = cvtpk(p[8 * j + 6], p[8 * j + 7]);
        const bf16x8 pb = __builtin_bit_cast(bf16x8, pw);
#pragma unroll
        for (int dh = 0; dh < 2; ++dh) {
            const bf16_t* q = vp + (size_t)dh * 32 * vpitch + 16 * j;
            const s16x4 lo = *(const s16x4*)q, hi4 = *(const s16x4*)(q + 8);
            const bf16x8 va = (bf16x8){lo[0], lo[1], lo[2], lo[3], hi4[0], hi4[1], hi4[2], hi4[3]};
            o[dh] = MFMA32(va, pb, o[dh]);
        }
    }
}
__device__ __forceinline__ void load_k64(bf16x8 (&kf)[8], const bf16_t* ktile, int lane) {
    const bf16_t* p = ktile + lane * 8;
#pragma unroll
    for (int i = 0; i < 8; ++i) kf[i] = *(const bf16x8*)(p + i * 512);
}
__device__ __forceinline__ void load_v64(bf16x8 (&vf)[8], const bf16_t* vtile, int lane) {
    const bf16_t* p = vtile + lane * 8;
#pragma unroll
    for (int i = 0; i < 8; ++i) vf[i] = *(const bf16x8*)(p + i * 512);
}
template <int MODE, int MK>
__device__ __forceinline__ void softmax_pv(f32x16 (&o)[2], float& m, float& l, f32x16& p0, f32x16& p1, const bf16x8 (&vf)[8],
                                           int kb, int t, bool tsel, const float* F8, float Fq8, int hi) {
    if (MK == 2) {
#pragma unroll
        for (int r = 0; r < 16; ++r) {
            const int k0 = kb + crow(r, hi), k1 = k0 + 32;
            bool v0, v1;
            if (MODE == 0) { v0 = tsel && (k0 <= t); v1 = tsel && (k1 <= t); }
            else if (MODE == 1) { v0 = (k0 <= t) && (k0 > t - 512); v1 = (k1 <= t) && (k1 > t - 512); }
            else { v0 = (k0 <= t); v1 = (k1 <= t); }
            p0[r] = v0 ? p0[r] : NEG_INF; p1[r] = v1 ? p1[r] : NEG_INF;
        }
    }
    int ia = max(__float_as_int(p0[0]), __float_as_int(p1[0])), ib = max(__float_as_int(p0[1]), __float_as_int(p1[1]));
#pragma unroll
    for (int r = 2; r < 16; r += 2) { ia = max(ia, max(__float_as_int(p0[r]), __float_as_int(p1[r]))); ib = max(ib, max(__float_as_int(p0[r + 1]), __float_as_int(p1[r + 1]))); }
    float mx = __int_as_float(max(max(ia, ib), 0));
    if (MK == 1) mx = tsel ? mx : NEG_INF;
    mx = fmaxf(mx, __shfl_xor(mx, 32));
    const float mnew = fmaxf(m, mx);
    const float msafe = (mnew == NEG_INF) ? 0.f : mnew;
    const float alpha = fast_exp2((m - msafe) * QK_C2);
    float nm = -msafe * QK_C2;
    if (MK == 1) nm = tsel ? nm : NEG_INF;
    float ps = 0.f;
#pragma unroll
    for (int r = 0; r < 16; ++r) { p0[r] = fast_exp2(__builtin_fmaf(p0[r], QK_C2, nm)); p1[r] = fast_exp2(__builtin_fmaf(p1[r], QK_C2, nm)); ps += p0[r] + p1[r]; }
    l = l * alpha + ps; m = mnew;
#pragma unroll
    for (int r = 0; r < 16; ++r) { o[0][r] *= alpha; o[1][r] *= alpha; }
#pragma unroll
    for (int hf = 0; hf < 2; ++hf)
#pragma unroll
        for (int j = 0; j < 2; ++j) {
            const f32x16& p = hf ? p1 : p0;
            u32x4 pw; pw.x = cvtpk(p[8 * j + 0], p[8 * j + 1]); pw.y = cvtpk(p[8 * j + 2], p[8 * j + 3]); pw.z = cvtpk(p[8 * j + 4], p[8 * j + 5]); pw.w = cvtpk(p[8 * j + 6], p[8 * j + 7]);
            const bf16x8 pb = __builtin_bit_cast(bf16x8, pw);
#pragma unroll
            for (int dh = 0; dh < 2; ++dh) o[dh] = MFMA32(vf[(hf * 2 + j) * 2 + dh], pb, o[dh]);
        }
}
template <int MODE, class Sel>
__device__ __forceinline__ void flash_loop(f32x16 (&o)[2], float& m, float& l, const bf16x8 (&qf)[4], const bf16_t* K, const bf16_t* Vt,
                                           int jlo, int jhi, int t, int tmin, int tmax, Sel sel, const float* F8, float Fq8, int lane) {
    const int hi = lane >> 5;
    int j = jlo;
    for (; j <= jhi; ++j) { if (__any(sel(j))) break; }
    bf16x8 kf[8], vf[8];
    if (j <= jhi) load_k64(kf, K + (size_t)j * 4096, lane);
    while (j <= jhi) {
        int jn = j + 1;
        for (; jn <= jhi; ++jn) { if (__any(sel(jn))) break; }
        load_v64(vf, Vt + (size_t)j * 4096, lane);
        f32x16 p0, p1;
        const int kb = j * 64;
        if (MODE == 2) {
#pragma unroll
            for (int g = 0; g < 4; ++g) {
                const f32x4 fa = *(const f32x4*)(F8 + kb + 8 * g + 4 * hi), fbv = *(const f32x4*)(F8 + kb + 32 + 8 * g + 4 * hi);
#pragma unroll
                for (int i = 0; i < 4; ++i) { p0[4 * g + i] = fa[i]; p1[4 * g + i] = fbv[i]; }
            }
        } else {
#pragma unroll
            for (int r = 0; r < 16; ++r) { p0[r] = 0.f; p1[r] = 0.f; }
        }
#pragma unroll
        for (int d0 = 0; d0 < 4; ++d0) { p0 = MFMA32(kf[d0], qf[d0], p0); p1 = MFMA32(kf[4 + d0], qf[d0], p1); }
        if (jn <= jhi) load_k64(kf, K + (size_t)jn * 4096, lane);
        bool full = (kb + 63 <= tmin);
        if (MODE == 1) full = full && (kb > tmax - 512);
        if (full) {
            if (MODE == 0 && !__all(sel(j))) softmax_pv<MODE, 1>(o, m, l, p0, p1, vf, kb, t, sel(j), F8, Fq8, hi);
            else softmax_pv<MODE, 0>(o, m, l, p0, p1, vf, kb, t, true, F8, Fq8, hi);
        } else softmax_pv<MODE, 2>(o, m, l, p0, p1, vf, kb, t, sel(j), F8, Fq8, hi);
        j = jn;
    }
}
__device__ __forceinline__ void load_q(bf16x8 (&qf)[4], const bf16_t* qrow, int hi) {
#pragma unroll
    for (int d0 = 0; d0 < 4; ++d0) qf[d0] = *(const bf16x8*)(qrow + 16 * d0 + 8 * hi);
}
__device__ __forceinline__ void store_o(bf16_t* dst, const f32x16 (&o)[2], int hi) {
#pragma unroll
    for (int dh = 0; dh < 2; ++dh)
#pragma unroll
        for (int g = 0; g < 4; ++g) {
            u32x2 w; w.x = cvtpk(o[dh][4 * g + 0], o[dh][4 * g + 1]); w.y = cvtpk(o[dh][4 * g + 2], o[dh][4 * g + 3]);
            *(u32x2*)(dst + 32 * dh + 8 * g + 4 * hi) = w;
        }
}
__device__ __forceinline__ unsigned nsa_select(const float (&imp)[32], int t) {
    const int tb = t >> 6;
    unsigned sel = 1u | (1u << tb) | (1u << (tb > 0 ? tb - 1 : 0));
#pragma unroll
    for (int it = 0; it < 5; ++it) {
        float bv = NEG_INF; int bj = -1;
#pragma unroll
        for (int j = 1; j < 32; ++j) { const bool cand = (j <= tb - 2) && !((sel >> j) & 1u) && (imp[j] > bv); if (cand) { bv = imp[j]; bj = j; } }
        if (bj >= 0) sel |= 1u << bj;
    }
    if (tb <= 7) sel = (2u << tb) - 1u;
    return sel;
}

__device__ __forceinline__ void nsa_unit(unsigned char* ws, int b, int g, int qg, int lane, float* wl) {
    const int hi = lane >> 5, c = lane & 31;
    const int t = qg * 8 + (c >> 2), head = g * 4 + (c & 3), row = b * SEQ + t, bg = b * 2 + g;
    bf16x8 qf[4];
    load_q(qf, (const bf16_t*)(ws + WS_QNSA) + (size_t)row * 512 + head * 64, hi);
    const float* gp = (const float*)(ws + WS_GATES) + (size_t)row * 24 + head * 3;
    const float g0 = gp[0];
    f32x16 o[2];
    float* oa = wl + 256 + lane;
    {
        const bf16_t* Kc = (const bf16_t*)(ws + WS_KCMP) + (size_t)bg * 8192;
        const bf16_t* Vct = (const bf16_t*)(ws + WS_VCMPT) + (size_t)bg * 8192;
        f32x16 s[4];
        float mx = NEG_INF;
#pragma unroll
        for (int tile = 0; tile < 2; ++tile) {
            bf16x8 kf[8];
            load_k64(kf, Kc + tile * 4096, lane);
#pragma unroll
            for (int hf = 0; hf < 2; ++hf) {
                const int grp = tile * 2 + hf;
#pragma unroll
                for (int r = 0; r < 16; ++r) s[grp][r] = 0.f;
#pragma unroll
                for (int d0 = 0; d0 < 4; ++d0) s[grp] = MFMA32(kf[hf * 4 + d0], qf[d0], s[grp]);
#pragma unroll
                for (int r = 0; r < 16; ++r) {
                    const int key = 32 * grp + crow(r, hi);
                    const float v = (16 * key + 31 <= t) ? s[grp][r] * QK_C2 : NEG_INF;
                    s[grp][r] = v; mx = fmaxf(mx, v);
                }
            }
        }
        mx = fmaxf(mx, __shfl_xor(mx, 32));
        const float msafe = (mx == NEG_INF) ? 0.f : mx;
        float ps = 0.f;
#pragma unroll
        for (int grp = 0; grp < 4; ++grp)
#pragma unroll
            for (int r = 0; r < 16; ++r) { s[grp][r] = fast_exp2(s[grp][r] - msafe); ps += s[grp][r]; }
        ps += __shfl_xor(ps, 32);
        const float inv = 1.0f / fmaxf(ps, 1e-30f);
#pragma unroll
        for (int grp = 0; grp < 4; ++grp)
#pragma unroll
            for (int r = 0; r < 16; ++r) s[grp][r] *= inv;
#pragma unroll
        for (int r = 0; r < 16; ++r) { o[0][r] = 0.f; o[1][r] = 0.f; }
#pragma unroll
        for (int tile = 0; tile < 2; ++tile) {
            bf16x8 vf[8];
            load_v64(vf, Vct + tile * 4096, lane);
#pragma unroll
            for (int hf = 0; hf < 2; ++hf)
#pragma unroll
                for (int j = 0; j < 2; ++j) {
                    const f32x16& p = s[tile * 2 + hf];
                    u32x4 pw; pw.x = cvtpk(p[8 * j + 0], p[8 * j + 1]); pw.y = cvtpk(p[8 * j + 2], p[8 * j + 3]); pw.z = cvtpk(p[8 * j + 4], p[8 * j + 5]); pw.w = cvtpk(p[8 * j + 6], p[8 * j + 7]);
                    const bf16x8 pb = __builtin_bit_cast(bf16x8, pw);
#pragma unroll
                    for (int dh = 0; dh < 2; ++dh) o[dh] = MFMA32(vf[(hf * 2 + j) * 2 + dh], pb, o[dh]);
                }
        }
#pragma unroll
        for (int r = 0; r < 16; ++r) { oa[r * 64] = g0 * o[0][r]; oa[(16 + r) * 64] = g0 * o[1][r]; }
        float recv[4][4];
#pragma unroll
        for (int grp = 0; grp < 4; ++grp)
#pragma unroll
            for (int gq = 0; gq < 4; ++gq) recv[grp][gq] = __shfl_xor(s[grp][4 * gq + 3], 32);
#pragma unroll
        for (int grp = 0; grp < 4; ++grp)
#pragma unroll
            for (int gq = 0; gq < 4; ++gq) {
                const float own = (s[grp][4 * gq] + s[grp][4 * gq + 1]) + (s[grp][4 * gq + 2] + s[grp][4 * gq + 3]);
                const float plo = (gq > 0) ? recv[grp][gq > 0 ? gq - 1 : 0] : ((grp > 0) ? recv[grp > 0 ? grp - 1 : 0][3] : 0.f);
                const float prev = hi ? recv[grp][gq] : plo;
                float v = own + prev;
                v += __shfl_xor(v, 1); v += __shfl_xor(v, 2);
                if ((c & 3) == 0) wl[(c >> 2) * 32 + 8 * grp + 2 * gq + hi] = v;
            }
    }
    asm volatile("s_waitcnt lgkmcnt(0)" ::: "memory");
    float imp[32];
#pragma unroll
    for (int j4 = 0; j4 < 8; ++j4) { const f32x4 v = *(const f32x4*)(wl + (c >> 2) * 32 + 4 * j4); imp[4 * j4] = v[0]; imp[4 * j4 + 1] = v[1]; imp[4 * j4 + 2] = v[2]; imp[4 * j4 + 3] = v[3]; }
    asm volatile("s_waitcnt lgkmcnt(0)" ::: "memory");
    const unsigned sel = nsa_select(imp, t);
    const int jmax = (qg * 8 + 7) >> 6;
    {
        const bf16_t* Ks = (const bf16_t*)(ws + WS_KS) + (size_t)bg * SEQ * 64;
        const bf16_t* Vst = (const bf16_t*)(ws + WS_VST) + (size_t)bg * 64 * SEQ;
        float m = NEG_INF, l = 0.f;
#pragma unroll
        for (int r = 0; r < 16; ++r) { o[0][r] = 0.f; o[1][r] = 0.f; }
        flash_loop<0>(o, m, l, qf, Ks, Vst, 0, jmax, t, qg * 8, qg * 8 + 7, [&](int j) { return (bool)((sel >> j) & 1u); }, nullptr, 0.f, lane);
        l += __shfl_xor(l, 32);
        const float sc = gp[1] / fmaxf(l, 1e-30f);
#pragma unroll
        for (int r = 0; r < 16; ++r) { oa[r * 64] += sc * o[0][r]; oa[(16 + r) * 64] += sc * o[1][r]; }
        asm volatile("s_waitcnt lgkmcnt(0)" ::: "memory");
    }
    {
        const bf16_t* Kw = (const bf16_t*)(ws + WS_KW) + (size_t)bg * SEQ * 64;
        const bf16_t* Vwt = (const bf16_t*)(ws + WS_VWT) + (size_t)bg * 64 * SEQ;
        float m = NEG_INF, l = 0.f;
#pragma unroll
        for (int r = 0; r < 16; ++r) { o[0][r] = 0.f; o[1][r] = 0.f; }
        const int tl = qg * 8 - 511;
        const int jlo = (tl > 0 ? tl : 0) >> 6;
        flash_loop<1>(o, m, l, qf, Kw, Vwt, jlo, jmax, t, qg * 8, qg * 8 + 7, [&](int) { return true; }, nullptr, 0.f, lane);
        l += __shfl_xor(l, 32);
        const float sc = gp[2] / fmaxf(l, 1e-30f);
#pragma unroll
        for (int r = 0; r < 16; ++r) { o[0][r] = oa[r * 64] + sc * o[0][r]; o[1][r] = oa[(16 + r) * 64] + sc * o[1][r]; }
        asm volatile("s_waitcnt lgkmcnt(0)" ::: "memory");
    }
    store_o((bf16_t*)(ws + WS_H) + (size_t)row * DM + head * 64, o, hi);
}

__device__ __forceinline__ void fox_unit(unsigned char* ws, int bh, int qt, int lane) {
    const int hi = lane >> 5, c = lane & 31, b = bh >> 2, h = bh & 3;
    const int t = qt * 32 + c, row = b * SEQ + t;
    bf16x8 qf[4];
    load_q(qf, (const bf16_t*)(ws + WS_FOXQ) + (size_t)row * 256 + h * 64, hi);
    const bf16_t* K = (const bf16_t*)(ws + WS_FOXK) + (size_t)bh * SEQ * 64;
    const bf16_t* Vt = (const bf16_t*)(ws + WS_FOXVT) + (size_t)bh * 64 * SEQ;
    const float* F2 = (const float*)(ws + WS_FCUM) + (size_t)bh * SEQ;
    const float Fq2 = F2[t];
    f32x16 o[2]; float m = NEG_INF, l = 0.f;
#pragma unroll
    for (int r = 0; r < 16; ++r) { o[0][r] = 0.f; o[1][r] = 0.f; }
    const int jmax = (qt * 32 + 31) >> 6;
    flash_loop<2>(o, m, l, qf, K, Vt, 0, jmax, t, qt * 32, qt * 32 + 31, [&](int) { return true; }, F2, Fq2, lane);
    l += __shfl_xor(l, 32);
    const float sc = 1.0f / fmaxf(l, 1e-30f);
#pragma unroll
    for (int r = 0; r < 16; ++r) { o[0][r] *= sc; o[1][r] *= sc; }
    store_o((bf16_t*)(ws + WS_H) + (size_t)row * DM + 512 + h * 64, o, hi);
}

__device__ __forceinline__ void moba_unit(unsigned char* ws, int bh, int qt, int lane) {
    const int hi = lane >> 5, c = lane & 31, b = bh >> 2, h = bh & 3;
    const int t = qt * 32 + c, row = b * SEQ + t;
    bf16x8 qf[4];
    load_q(qf, (const bf16_t*)(ws + WS_MOBAQ) + (size_t)row * 256 + h * 64, hi);
    const bf16_t* K = (const bf16_t*)(ws + WS_MOBAK) + (size_t)bh * SEQ * 64;
    const bf16_t* Vt = (const bf16_t*)(ws + WS_MOBAVT) + (size_t)bh * 64 * SEQ;
    const int own = (qt * 32) >> 8;
    unsigned sel = 0u;
    {
        float gt[7];
        const float* km = (const float*)(ws + WS_KMEAN) + (size_t)bh * 8 * 64;
#pragma unroll
        for (int blk = 0; blk < 7; ++blk) {
            float a = 0.f;
            if (blk < own) {
#pragma unroll
                for (int d0 = 0; d0 < 4; ++d0) {
                    const f32x4 k0 = *(const f32x4*)(km + blk * 64 + 16 * d0 + 8 * hi), k1 = *(const f32x4*)(km + blk * 64 + 16 * d0 + 8 * hi + 4);
#pragma unroll
                    for (int i = 0; i < 4; ++i) { a += bf2f(qf[d0][i]) * k0[i]; a += bf2f(qf[d0][4 + i]) * k1[i]; }
                }
                a += __shfl_xor(a, 32);
            }
            gt[blk] = a;
        }
#pragma unroll
        for (int it = 0; it < 3; ++it) {
            float bv = NEG_INF; int bj = -1;
#pragma unroll
            for (int blk = 0; blk < 7; ++blk) { const bool cand = (blk < own) && !((sel >> blk) & 1u) && (gt[blk] > bv); if (cand) { bv = gt[blk]; bj = blk; } }
            if (bj >= 0) sel |= 1u << bj;
        }
    }
    f32x16 o[2]; float m = NEG_INF, l = 0.f;
#pragma unroll
    for (int r = 0; r < 16; ++r) { o[0][r] = 0.f; o[1][r] = 0.f; }
    const int jmax = (qt * 32 + 31) >> 6;
    flash_loop<0>(o, m, l, qf, K, Vt, 0, jmax, t, qt * 32, qt * 32 + 31, [&](int j) { const int blk = j >> 2; return (blk == own) || (bool)((sel >> blk) & 1u); }, nullptr, 0.f, lane);
    l += __shfl_xor(l, 32);
    const float sc = 1.0f / fmaxf(l, 1e-30f);
#pragma unroll
    for (int r = 0; r < 16; ++r) { o[0][r] *= sc; o[1][r] *= sc; }
    store_o((bf16_t*)(ws + WS_H) + (size_t)row * DM + 768 + h * 64, o, hi);
}


#define XB_TMO      128
#define XB_XCNT(j)  (256  + 64 * (j))
#define XB_XSUB(j)  (1280 + 64 * (j))
#define XB_XGEN(j)  (2304 + 64 * (j))
#define XB_TOP      3328
#define XB_TOPGEN   3392
#define XCD_BAR_WORDS 3456
#define XB_SPIN_CAP (1u << 22)
__device__ __forceinline__ unsigned xb_ld(unsigned* p)              { return __hip_atomic_load(p, __ATOMIC_RELAXED, __HIP_MEMORY_SCOPE_AGENT); }
__device__ __forceinline__ unsigned xb_add(unsigned* p, unsigned v) { return __hip_atomic_fetch_add(p, v, __ATOMIC_RELAXED, __HIP_MEMORY_SCOPE_AGENT); }
__device__ __forceinline__ unsigned xb_xcc_id() { return (unsigned)__builtin_amdgcn_s_getreg((3 << 11) | 20) & 0xFu; }
#define XB_SPIN(cond, bar) do { unsigned _sp = 0; while (cond) { __builtin_amdgcn_s_sleep(1); \
    if ((++_sp & 255u) == 0u) { if (xb_ld(&(bar)[XB_TMO])) break; if (_sp > XB_SPIN_CAP) { atomicAdd(&(bar)[XB_TMO], 1u); break; } } } } while (0)
__device__ __forceinline__ void xcd_barrier_post(unsigned* bar, unsigned x, volatile LAS unsigned* st) {
    if (threadIdx.x == 0) st[2] = xb_add(&bar[XB_XCNT(x)], 1u);
}
__device__ __forceinline__ void xcd_barrier_complete(unsigned* bar, unsigned x, unsigned& nloc, unsigned& nx) {
    const unsigned G = gridDim.x * gridDim.y * gridDim.z;
    unsigned sum, cnt, mine, sp = 0u;
    for (;;) {
        sum = 0u; cnt = 0u; mine = 0u;
#pragma unroll
        for (unsigned j = 0; j < 16; ++j) { const unsigned c = xb_ld(&bar[XB_XCNT(j)]); sum += c; cnt += (c > 0u) ? 1u : 0u; mine = (j == x) ? c : mine; }
        if (sum == G) break;
        __builtin_amdgcn_s_sleep(1);
        if ((++sp & 255u) == 0u) { if (xb_ld(&bar[XB_TMO])) break; if (sp > XB_SPIN_CAP) { atomicAdd(&bar[XB_TMO], 1u); break; } }
    }
    nloc = mine > 0u ? mine : 1u; nx = cnt > 0u ? cnt : 1u;
}
__device__ __forceinline__ void xcd_barrier(unsigned* bar_, unsigned x_, volatile LAS unsigned* st, bool leader) {
    asm volatile("s_waitcnt vmcnt(0)" ::: "memory");
    __syncthreads();
    if (leader) {
        size_t zo = 0; unsigned x = x_;
        asm volatile("" : "+s"(zo), "+s"(x));
        unsigned* bar = bar_ + zo;
        __builtin_amdgcn_s_waitcnt(0);
        unsigned nloc = st[0], nx = st[1];
        if (nloc == 0u) { xcd_barrier_complete(bar, x, nloc, nx); st[0] = nloc; st[1] = nx; }
        const unsigned old = xb_add(&bar[XB_XSUB(x)], 1u);
        const unsigned gen = old / nloc;
        if (old + 1u == (gen + 1u) * nloc) {
            __builtin_amdgcn_fence(__ATOMIC_RELEASE, "agent");
            asm volatile("s_waitcnt vmcnt(0)" ::: "memory");
            const unsigned og = xb_add(&bar[XB_TOP], 1u);
            const unsigned tg = og / nx;
            if (og + 1u == (tg + 1u) * nx) xb_add(&bar[XB_TOPGEN], 1u);
            else XB_SPIN(xb_ld(&bar[XB_TOPGEN]) == tg, bar);
            __builtin_amdgcn_fence(__ATOMIC_ACQUIRE, "agent");
            xb_add(&bar[XB_XGEN(x)], 1u);
            asm volatile("s_waitcnt vmcnt(0)" ::: "memory");
        } else {
            XB_SPIN(xb_ld(&bar[XB_XGEN(x)]) == gen, bar);
            __builtin_amdgcn_fence(__ATOMIC_ACQUIRE, "agent");
            asm volatile("s_waitcnt vmcnt(0)" ::: "memory");
        }
    }
    __syncthreads();
}

__device__ __forceinline__ int map_identity(int n) { return n; }
__device__ __forceinline__ int map_w13(int n) { const int tile = n >> 8, w = n & 255; return (w < 128) ? tile * 128 + w : FF + tile * 128 + (w - 128); }
__device__ __forceinline__ int map_win(int n) {
    if (n < 640) return n;
    if (n < 768) return n - 640 + 768;
    if (n < 896) return n - 768 + 1024;
    if (n < 1152) return n - 896 + 1304;
    if (n < 1408) return n - 1152 + 1560;
    if (n < 1664) return n - 1408 + 2076;
    if (n < 1920) return n - 1664 + 2332;
    if (n < 2048) return n - 1920 + 640;
    if (n < 2176) return n - 2048 + 896;
    if (n < 2304) return n - 2176 + 1152;
    if (n < 2560) return n - 2304 + 1816;
    if (n < 2816) return n - 2560 + 2588;
    if (n < 2840) return n - 2816 + 1280;
    if (n < 2844) return n - 2840 + 2072;
    return -1;
}
template <int MAP>
__device__ __forceinline__ void transpose_item(const float* W, int K, int Nsrc, int Ndst, bf16_t* WT, float* scr, int item, int lane) {
    const int nblk = Ndst / 64, kb = item / nblk, nb = item % nblk, k0 = 64 * kb, n0 = 64 * nb;
    const int nq = (lane & 15) * 4, nd = n0 + nq;
    const int src = (MAP == 0) ? map_identity(nd) : (MAP == 1) ? map_w13(nd) : map_win(nd);
    f32x4 v[16];
#pragma unroll
    for (int i = 0; i < 16; ++i) { const int kk = 4 * i + (lane >> 4); v[i] = (src >= 0) ? *(const f32x4*)(W + (size_t)(k0 + kk) * Nsrc + src) : (f32x4){0.f, 0.f, 0.f, 0.f}; }
#pragma unroll
    for (int i = 0; i < 16; ++i) { const int kk = 4 * i + (lane >> 4); float* d = scr + kk * 65 + nq; d[0] = v[i][0]; d[1] = v[i][1]; d[2] = v[i][2]; d[3] = v[i][3]; }
    asm volatile("s_waitcnt lgkmcnt(0)" ::: "memory");
    const int cc = lane & 7;
#pragma unroll
    for (int j = 0; j < 8; ++j) { const int n = (lane >> 3) + 8 * j; const float* sp = scr + (8 * cc) * 65 + n;
        u32x4 ov; ov.x = cvtpk(sp[0 * 65], sp[1 * 65]); ov.y = cvtpk(sp[2 * 65], sp[3 * 65]); ov.z = cvtpk(sp[4 * 65], sp[5 * 65]); ov.w = cvtpk(sp[6 * 65], sp[7 * 65]);
        *(u32x4*)(WT + (size_t)(n0 + n) * K + k0 + 8 * cc) = ov; }
    asm volatile("s_waitcnt lgkmcnt(0)" ::: "memory");
}
__device__ __forceinline__ void sincos_acc(float ang, float& sn, float& cs) {
    const double a = (double)ang;
    const double k = __builtin_rint(a * 0.15915494309189535);
    const double r = (a - k * 6.283185307179586) * 0.25;
    const double r2 = r * r;
    double s = r * (1.0 + r2 * (-1.0 / 6 + r2 * (1.0 / 120 + r2 * (-1.0 / 5040 + r2 * (1.0 / 362880 + r2 * (-1.0 / 39916800 + r2 * (1.0 / 6227020800.0)))))));
    double c = 1.0 + r2 * (-0.5 + r2 * (1.0 / 24 + r2 * (-1.0 / 720 + r2 * (1.0 / 40320 + r2 * (-1.0 / 3628800 + r2 * (1.0 / 479001600.0))))));
    double s2 = 2.0 * s * c, c2 = c * c - s * s;
    double s4 = 2.0 * s2 * c2, c4 = c2 * c2 - s2 * s2;
    sn = (float)s4; cs = (float)c4;
}

struct Params {
    const float* x; const float* c; const int* positions; const float* norm_g; const float* w_ada; const float* b_ada; const float* w_in; const float* fox_fbias;
    const float* cmp_pos; const float* cmp_w1; const float* cmp_w2; const float* w_out; const float* ffn_w13; const float* ffn_w2; const float* final_g;
    float* out; unsigned char* ws;
};

__device__ __forceinline__ void prologue(const Params& P, unsigned char* lds, int tid, int lane, int wave, int G) {
    unsigned char* ws = P.ws;
    float* cact = (float*)lds;
    float* part = (float*)(lds + 65536);
    for (int i = tid; i < NB * DM; i += 512) { const float v = P.c[i]; cact[i] = v / (1.0f + __expf(-v)); }
    __syncthreads();
    float* MOD = (float*)(ws + WS_MOD);
    for (int item = blockIdx.x; item < DEPTH * 64; item += G) {
        const int l = item >> 6, jb = (item & 63) * 144, j0 = jb + 4 * lane;
        const bool act = lane < 36;
        const float* wp = P.w_ada + (size_t)l * DM * NADA + (act ? j0 : jb);
        f32x4 acc4[16];
#pragma unroll
        for (int b = 0; b < 16; ++b) acc4[b] = (f32x4){0.f, 0.f, 0.f, 0.f};
        const int kbeg = wave * 128;
#pragma unroll 4
        for (int k = kbeg; k < kbeg + 128; ++k) {
            const f32x4 w = *(const f32x4*)(wp + (size_t)k * NADA);
#pragma unroll
            for (int b = 0; b < 16; ++b) acc4[b] += w * cact[b * DM + k];
        }
        if (act) {
#pragma unroll
            for (int b = 0; b < 16; ++b) *(f32x4*)(part + (wave * 16 + b) * 144 + 4 * lane) = acc4[b];
        }
        __syncthreads();
        for (int o = tid; o < 16 * 144; o += 512) {
            const int b = o / 144, col = o % 144;
            float sm = 0.f;
#pragma unroll
            for (int w = 0; w < 8; ++w) sm += part[(w * 16 + b) * 144 + col];
            const int j = jb + col;
            MOD[((size_t)l * NB + b) * NADA + j] = sm + P.b_ada[(size_t)l * NADA + j];
        }
        __syncthreads();
    }
    float* scr = (float*)(lds + wave * 16640);
    const int gw = blockIdx.x * NWAVES + wave, NGW = G * NWAVES;
    constexpr int I_WIN = 16 * 48, I_WOUT = 16 * 16, I_CW1 = 32 * 4, I_W13 = 16 * 88, I_W2 = 44 * 16, I_CW2 = 4 * 1;
    constexpr int T_WIN = 4 * I_WIN, T_WOUT = 4 * I_WOUT, T_CW1 = 8 * I_CW1, T_W13 = 8 * I_W13, T_W2 = 8 * I_W2, T_CW2 = 8 * I_CW2;
    constexpr int NITEMS = T_WIN + T_WOUT + T_CW1 + T_W13 + T_W2 + T_CW2;
    for (int it = gw; it < NITEMS; it += NGW) {
        int r = it;
        if (r < T_W13) { const int q = r / I_W13; transpose_item<1>(P.ffn_w13 + (size_t)q * DM * 2 * FF, DM, 2 * FF, 2 * FF, (bf16_t*)(ws + WS_W13) + (size_t)q * 2 * FF * DM, scr, r % I_W13, lane); continue; } r -= T_W13;
        if (r < T_W2) { const int q = r / I_W2; transpose_item<0>(P.ffn_w2 + (size_t)q * FF * DM, FF, DM, DM, (bf16_t*)(ws + WS_W2) + (size_t)q * DM * FF, scr, r % I_W2, lane); continue; } r -= T_W2;
        if (r < T_WIN) { const int q = r / I_WIN; transpose_item<2>(P.w_in + (size_t)q * DM * 2844, DM, 2844, NIN, (bf16_t*)(ws + WS_WIN) + (size_t)q * NIN * DM, scr, r % I_WIN, lane); continue; } r -= T_WIN;
        if (r < T_WOUT) { const int q = r / I_WOUT; transpose_item<0>(P.w_out + (size_t)q * DM * DM, DM, DM, DM, (bf16_t*)(ws + WS_WOUT) + (size_t)q * DM * DM, scr, r % I_WOUT, lane); continue; } r -= T_WOUT;
        if (r < T_CW1) { const int q = r / I_CW1; transpose_item<0>(P.cmp_w1 + (size_t)q * 2048 * 256, 2048, 256, 256, (bf16_t*)(ws + WS_CW1) + (size_t)q * 256 * 2048, scr, r % I_CW1, lane); continue; } r -= T_CW1;
        { const int q = r / I_CW2; transpose_item<0>(P.cmp_w2 + (size_t)q * 256 * 64, 256, 64, 64, (bf16_t*)(ws + WS_CW2T) + (size_t)q * 64 * 256, scr, r % I_CW2, lane); }
    }
    {
        float* cosT = (float*)(ws + WS_COS); float* sinT = (float*)(ws + WS_SIN);
        for (int e = blockIdx.x * 512 + tid; e < NTOK * 8; e += G * 512) {
            const int i = e & 7;
            const float inv = (i == 0) ? 1.0f : (i == 1) ? 0.1939227432012558f : (i == 2) ? 0.03760603070259094f : (i == 3) ? 0.007292664609849453f :
                              (i == 4) ? 0.0014142135623842478f : (i == 5) ? 0.00027424818836152554f : (i == 6) ? 5.318296098266728e-05f : 1.0313386155758053e-05f;
            const float ang = (float)P.positions[e >> 3] * inv;
            float sn, cs; sincos_acc(ang, sn, cs);
            cosT[e] = cs; sinT[e] = sn;
        }
    }
}

__device__ __forceinline__ void norm_phase(const float* xin, const float* g, const float* mod  , bf16_t* H, int lane, int wave, int G) {
    const int gw = blockIdx.x * NWAVES + wave, NGW = G * NWAVES;
    for (int row = gw; row < NTOK; row += NGW) {
        const int b = row >> 11;
        const f32x4* xr = (const f32x4*)(xin + (size_t)row * DM) + lane;
        f32x4 v[4]; float s = 0.f;
#pragma unroll
        for (int j = 0; j < 4; ++j) { v[j] = xr[64 * j]; s += (v[j].x * v[j].x + v[j].y * v[j].y) + (v[j].z * v[j].z + v[j].w * v[j].w); }
        const float rstd = 1.0f / sqrtf(wave_sum(s) * (1.0f / DM) + 1e-6f);
        const f32x4* gr = (const f32x4*)g + lane;
        const f32x4* sh = (const f32x4*)(mod + (size_t)b * NADA) + lane;
        const f32x4* sc = (const f32x4*)(mod + (size_t)b * NADA + DM) + lane;
        u32x2* o8 = (u32x2*)(H + (size_t)row * DM) + lane;
#pragma unroll
        for (int j = 0; j < 4; ++j) {
            const f32x4 gg = gr[64 * j], s1 = sc[64 * j] + 1.0f, s0 = sh[64 * j];
            const f32x4 y = v[j] * rstd * gg * s1 + s0;
            u32x2 w; w.x = cvtpk(y.x, y.y); w.y = cvtpk(y.z, y.w);
            o8[64 * j] = w;
        }
    }
}
__device__ __forceinline__ void final_norm(float* x, const float* g, int lane, int wave, int G) {
    const int gw = blockIdx.x * NWAVES + wave, NGW = G * NWAVES;
    for (int row = gw; row < NTOK; row += NGW) {
        f32x4* xr = (f32x4*)(x + (size_t)row * DM) + lane;
        f32x4 v[4]; float s = 0.f;
#pragma unroll
        for (int j = 0; j < 4; ++j) { v[j] = xr[64 * j]; s += (v[j].x * v[j].x + v[j].y * v[j].y) + (v[j].z * v[j].z + v[j].w * v[j].w); }
        const float rstd = 1.0f / sqrtf(wave_sum(s) * (1.0f / DM) + 1e-6f);
        const f32x4* gr = (const f32x4*)g + lane;
#pragma unroll
        for (int j = 0; j < 4; ++j) xr[64 * j] = v[j] * rstd * gr[64 * j];
    }
}

__global__ void __launch_bounds__(512, 2) fwd_megakernel(Params P) {
    extern __shared__ __attribute__((aligned(16))) unsigned char lds[];
    cg::grid_group grid = cg::this_grid();
    const int tid = threadIdx.x, lane = tid & 63, wave = __builtin_amdgcn_readfirstlane(tid >> 6), wave0 = wave;
    const int G = gridDim.x;
    unsigned char* ws = P.ws;
    LAS unsigned char* lds3 = (LAS unsigned char*)lds;
    const float* MOD = (const float*)(ws + WS_MOD);
    unsigned* ctl = (unsigned*)(ws + WS_CTL);

    volatile LAS unsigned* bst = (volatile LAS unsigned*)(lds3 + LDS_BYTES - 64);
    if (tid == 0) { bst[0] = 0u; bst[1] = 0u; }
    __syncthreads();
    const unsigned xcc = (unsigned)__builtin_amdgcn_readfirstlane((int)xb_xcc_id());
    xcd_barrier_post(ctl + 65536, xcc, bst);
    const bool leader = (tid == 0);
#define GRID_BAR() xcd_barrier((unsigned*)(P.ws + WS_CTL) + 65536, xcc, bst, leader)
    prologue(P, lds, tid, lane, wave, G);
    if (P.ws == nullptr) grid.sync();
    GRID_BAR();
    if (tid == 0) {
        bool ok = ((G & 7) == 0);
        for (unsigned j = 0; j < 16; ++j) { const unsigned cnt = xb_ld(ctl + 65536 + XB_XCNT(j)); ok = ok && (cnt == ((j < 8u) ? (unsigned)(G >> 3) : 0u)); }
        bst[3] = ok ? (bst[2] * 8u + xcc) : (unsigned)blockIdx.x;
    }
    __syncthreads();
    const int vbid = __builtin_amdgcn_readfirstlane((int)bst[3]);
#ifdef PROBE_SYNC20
    for (int i = 0; i < 20; ++i) GRID_BAR();
#endif
    {
        const int ln = fresh_lane(), wv = wave0;
        for (int it = blockIdx.x * NWAVES + wv; it < 8 * 256; it += G * NWAVES) {
            const int lm = it >> 8;
            const bf16_t* wr_ = (const bf16_t*)(ws + WS_CW1) + (size_t)it * 2048 + ln * 32;
            const float* pp = P.cmp_pos + (size_t)lm * 2048 + ln * 32;
            float a = 0.f;
#pragma unroll
            for (int j = 0; j < 4; ++j) {
                const bf16x8 wv8 = *(const bf16x8*)(wr_ + 8 * j);
                const f32x4 p0 = *(const f32x4*)(pp + 8 * j), p1 = *(const f32x4*)(pp + 8 * j + 4);
#pragma unroll
                for (int i = 0; i < 4; ++i) { a += p0[i] * bf2f(wv8[i]); a += p1[i] * bf2f(wv8[4 + i]); }
            }
            a = wave_sum(a);
            if (ln == 0) ((float*)(ws + WS_B1))[it] = a;
        }
    }

    const float* xin = P.x;
    for (int l = 0; l < DEPTH; ++l) {
        const float* modl = MOD + (size_t)l * NB * NADA;
        for (int sub = 0; sub < 3; ++sub) {
            unsigned char* ws = launder_p(P.ws);
            const int bid = launder_i(vbid);
            const int lane = fresh_lane(), wave = wave0;
            norm_phase(xin, P.norm_g + ((size_t)l * 3 + sub) * DM, modl + (size_t)sub * 3 * DM, (bf16_t*)(ws + WS_H), lane, wave, G);
            GRID_BAR();
            if (sub != 1) {
                const int s = (sub == 0) ? 0 : 1;
                {
                    pg8::Gemm g{(const bf16_t*)(ws + WS_H), (const bf16_t*)(ws + WS_W13) + (size_t)(l * 2 + s) * 2 * FF * DM, NTOK, 2 * FF, DM, DM};
                    pg8::StaticOrder S; S.init(NTOK, 2 * FF, G, bid);
                    EpiSwiglu E{(bf16_t*)(ws + WS_BIG)};
#ifndef NO_G1
                    pg8::gemm_phase<EpiSwiglu, true>(lds3, g, S, E, wave0);
#endif
#ifdef PROBE_G1X2
                    pg8::gemm_phase<EpiSwiglu, true>(lds3, g, S, E, wave0);
#endif
                }
                GRID_BAR();
                {
                    pg8::Gemm g{(const bf16_t*)(ws + WS_BIG), (const bf16_t*)(ws + WS_W2) + (size_t)(l * 2 + s) * DM * FF, NTOK, DM, FF, FF};
                    pg8::StaticOrder S; S.init(NTOK, DM, G, bid);
                    EpiResid E{xin, P.out, modl + (size_t)(sub * 3 + 2) * DM, 0.5f};
#ifndef NO_G2
                    pg8::gemm_phase<EpiResid, true>(lds3, g, S, E, wave0);
#endif
                }
                xin = P.out;
                GRID_BAR();
            } else {
                {
                    pg8::Gemm g{(const bf16_t*)(ws + WS_H), (const bf16_t*)(ws + WS_WIN) + (size_t)l * NIN * DM, NTOK, NIN, DM, DM};
                    pg8::StaticOrder S; S.init(NTOK, NIN, G, bid);
                    EpiInProj E{ws, P.fox_fbias + l * 4};
#ifndef NO_INPROJ
                    pg8::gemm_phase<EpiInProj, true>(lds3, g, S, E, wave0);
#endif
                }
                GRID_BAR();
                if (bid < 32) {
                    const int mat = bid >> 4;
                    pg8::Gemm g{(const bf16_t*)(ws + (mat ? WS_VC : WS_KC)), (const bf16_t*)(ws + WS_CW1) + (size_t)(l * 2 + mat) * 256 * 2048, 4096, 256, 2048, 1024};
                    pg8::StaticOrder S; S.init(4096, 256, 16, bid & 15);
                    EpiGelu E{(bf16_t*)(ws + WS_CMPHID) + (size_t)mat * 4096 * 256, (const float*)(ws + WS_B1) + (l * 2 + mat) * 256};
#ifndef NO_CMP1
                    pg8::gemm_phase<EpiGelu, true>(lds3, g, S, E, wave0);
#endif
                } else {
                    const int nw = (G - 32) * NWAVES;
                    for (int it = (bid - 32) * NWAVES + wave; it < 64 + 512; it += nw) {
                        if (it < 64) {
                            const float* src = (const float*)(ws + WS_FLOG) + (size_t)it * SEQ + lane * 32;
                            float v[32];
#pragma unroll
                            for (int j = 0; j < 8; ++j) { const f32x4 q = *(const f32x4*)(src + 4 * j); v[4 * j] = q.x; v[4 * j + 1] = q.y; v[4 * j + 2] = q.z; v[4 * j + 3] = q.w; }
#pragma unroll
                            for (int j = 1; j < 32; ++j) v[j] += v[j - 1];
                            float tot = v[31], inc = tot;
#pragma unroll
                            for (int o = 1; o < 64; o <<= 1) { const float n = __shfl_up(inc, o); if (lane >= o) inc += n; }
                            const float excl = inc - tot;
                            float* dst = (float*)(ws + WS_FCUM) + (size_t)it * SEQ + lane * 32;
#pragma unroll
                            for (int j = 0; j < 8; ++j) { f32x4 q; q.x = (v[4 * j] + excl) * -8.0f; q.y = (v[4 * j + 1] + excl) * -8.0f; q.z = (v[4 * j + 2] + excl) * -8.0f; q.w = (v[4 * j + 3] + excl) * -8.0f; *(f32x4*)(dst + 4 * j) = q; }
                        } else {
                            const int id = it - 64;
                            const bf16_t* kp = (const bf16_t*)(ws + WS_MOBAK) + (size_t)id * 256 * 64 + (((lane >> 4) * 64 + ((lane >> 3) & 1) * 32) * 8 + (lane & 7));
                            float a = 0.f;
#pragma unroll 8
                            for (int k = 0; k < 256; ++k) a += bf2f((short)kp[(size_t)(k >> 6) * 4096 + (((k >> 5) & 1) * 4 * 64 + (k & 31)) * 8]);
                            ((float*)(ws + WS_KMEAN))[(size_t)id * 64 + lane] = a * (1.0f / 256.0f);
                        }
                    }
                }
                GRID_BAR();
                for (int it = bid * NWAVES + wave; it < 256; it += G * NWAVES) {
                    const int mat = it >> 7, rt = it & 127, hi = lane >> 5, c = lane & 31;
                    const bf16_t* A = (const bf16_t*)(ws + WS_CMPHID) + ((size_t)mat * 4096 + rt * 32 + c) * 256 + 8 * hi;
                    const bf16_t* Bt = (const bf16_t*)(ws + WS_CW2T) + (size_t)(l * 2 + mat) * 64 * 256 + (size_t)c * 256 + 8 * hi;
                    f32x16 a0, a1;
#pragma unroll
                    for (int r = 0; r < 16; ++r) { a0[r] = 0.f; a1[r] = 0.f; }
#pragma unroll 4
                    for (int ks = 0; ks < 16; ++ks) {
                        const bf16x8 af = *(const bf16x8*)(A + 16 * ks);
                        const bf16x8 b0 = *(const bf16x8*)(Bt + 16 * ks), b1 = *(const bf16x8*)(Bt + 32 * 256 + 16 * ks);
                        a0 = MFMA32(af, b0, a0); a1 = MFMA32(af, b1, a1);
                    }
#pragma unroll
                    for (int r = 0; r < 16; ++r) {
                        const int row = rt * 32 + crow(r, hi), rl = row & 127, bg = row >> 7;
                        const float v0 = (rl == 127) ? 0.f : a0[r], v1 = (rl == 127) ? 0.f : a1[r];
                        const bf16_t h0 = (bf16_t)(cvtpk(v0, 0.f) & 0xffffu), h1 = (bf16_t)(cvtpk(v1, 0.f) & 0xffffu);
                        if (mat == 0) {
                            bf16_t* kc = (bf16_t*)(ws + WS_KCMP) + (size_t)bg * 8192 + (rl >> 6) * 4096 + ((((rl >> 5) & 1) * 4) * 64 + (rl & 31)) * 8;
                            const int o0 = ((c >> 4) * 64 + ((c >> 3) & 1) * 32) * 8 + (c & 7);
                            kc[o0] = h0; kc[o0 + 2 * 64 * 8] = h1;
                        } else {
                            const int tt = rl & 63;
                            bf16_t* vc = (bf16_t*)(ws + WS_VCMPT) + (size_t)bg * 8192 + (rl >> 6) * 4096
                                         + ((((tt >> 5) * 2 + ((tt >> 4) & 1)) * 2) * 64 + ((tt >> 2) & 1) * 32 + c) * 8 + ((tt >> 3) & 1) * 4 + (tt & 3);
                            vc[0] = h0; vc[64 * 8] = h1;
                        }
                    }
                }
                GRID_BAR();
                {
#ifdef PROBE_ATTN2
                  for (int rep = 0; rep < 2; ++rep)
#else
                  const int rep = 0;
#endif
                  {
                    float* wl = (float*)(lds + wave * 16384);
                    const int lane_ = lane;
                    const int myq = (int)(__builtin_amdgcn_s_getreg((3 << 11) | 20) & 7u);
                    for (int qi = 0; qi < 8; ++qi) {
                        const int q = (myq + qi) & 7;
                        unsigned* ctr = ctl + 64 * (1 + (l * 2 + rep) * 8 + q);
                        for (;;) {
                            unsigned u = 0;
                            if (lane_ == 0) u = atomicAdd(ctr, 1u);
                            u = (unsigned)__builtin_amdgcn_readfirstlane((int)u);
                            if (u >= 2048u) break;
                            const int lane = launder_v(lane_);
                            if (u < 1024u) {
                                const int pr = (int)(u >> 9), i = (int)(u & 511u), slot = 63 - (i >> 3), w = i & 7;
                                const int bg = 4 * q + 2 * pr + (w >> 2);
                                nsa_unit(ws, bg >> 1, bg & 1, slot * 4 + (w & 3), lane, wl);
                            } else if (u < 1536u) {
                                const int i = (int)(u - 1024u), hf = i >> 8, slot = 63 - ((i & 255) >> 2);
                                fox_unit(ws, 8 * q + 4 * hf + (i & 3), slot, lane);
                            } else {
                                const int i = (int)(u - 1536u), hf = i >> 8, slot = 63 - ((i & 255) >> 2);
                                moba_unit(ws, 8 * q + 4 * hf + (i & 3), slot, lane);
                            }
                        }
                    }
                  }
                }
                GRID_BAR();
                {
                    pg8::Gemm g{(const bf16_t*)(ws + WS_H), (const bf16_t*)(ws + WS_WOUT) + (size_t)l * DM * DM, NTOK, DM, DM, DM};
                    pg8::StaticOrder S; S.init(NTOK, DM, G, bid);
                    EpiResid E{xin, P.out, modl + (size_t)(1 * 3 + 2) * DM, 1.0f};
#ifndef NO_OUTPROJ
                    pg8::gemm_phase<EpiResid, true>(lds3, g, S, E, wave0);
#endif
                }
                GRID_BAR();
            }
        }
    }
    final_norm(P.out, P.final_g, fresh_lane(), wave0, G);
}

extern "C" void kernel_launch(void* const* d_in, const int* in_sizes, int n_in, void* d_out, int out_size, void* d_ws, size_t ws_size, hipStream_t stream) {
    static int grid_blocks = 0;
    if (grid_blocks == 0) {
        if (n_in != 15 || ws_size < WS_END) { fprintf(stderr, "kernel_launch: unexpected inputs (n_in %d, ws %zu)\n", n_in, ws_size); grid_blocks = -1; return; }
        int dev = 0, cus = 0, per_cu = 0;
        hipGetDevice(&dev);
        hipDeviceGetAttribute(&cus, hipDeviceAttributeMultiprocessorCount, dev);
        if (hipFuncSetAttribute((const void*)fwd_megakernel, hipFuncAttributeMaxDynamicSharedMemorySize, LDS_BYTES) != hipSuccess) fprintf(stderr, "kernel_launch: hipFuncSetAttribute failed\n");
        if (hipOccupancyMaxActiveBlocksPerMultiprocessor(&per_cu, (const void*)fwd_megakernel, 512, LDS_BYTES) != hipSuccess || per_cu < 1) { fprintf(stderr, "kernel_launch: occupancy query gave %d\n", per_cu); per_cu = 1; }
        (void)hipGetLastError();
        grid_blocks = cus * per_cu;
        if (grid_blocks > 256) grid_blocks = 256;
    }
    if (grid_blocks < 0) return;
    hipMemsetAsync((char*)d_ws + WS_CTL, 0, 1 * MiB, stream);
    Params p{};
    p.x = (const float*)d_in[0]; p.c = (const float*)d_in[1]; p.positions = (const int*)d_in[2]; p.norm_g = (const float*)d_in[3];
    p.w_ada = (const float*)d_in[4]; p.b_ada = (const float*)d_in[5]; p.w_in = (const float*)d_in[6]; p.fox_fbias = (const float*)d_in[7];
    p.cmp_pos = (const float*)d_in[8]; p.cmp_w1 = (const float*)d_in[9]; p.cmp_w2 = (const float*)d_in[10]; p.w_out = (const float*)d_in[11];
    p.ffn_w13 = (const float*)d_in[12]; p.ffn_w2 = (const float*)d_in[13]; p.final_g = (const float*)d_in[14];
    p.out = (float*)d_out; p.ws = (unsigned char*)d_ws;
    void* args[] = {&p};
    hipError_t e = hipLaunchCooperativeKernel((const void*)fwd_megakernel, dim3(grid_blocks), dim3(512), args, LDS_BYTES, stream);
    if (e != hipSuccess) fprintf(stderr, "kernel_launch: cooperative launch failed: %s (grid %d)\n", hipGetErrorString(e), grid_blocks);
}
```

```cpp
#include <hip/hip_runtime.h>
#include <hip/hip_cooperative_groups.h>
#include <cstdio>
#include <cstdint>
namespace cg = cooperative_groups;

#define LAS __attribute__((address_space(3)))
typedef unsigned short bf16_t;
typedef short bf16x8 __attribute__((ext_vector_type(8)));
typedef short s16x4 __attribute__((ext_vector_type(4)));
typedef float f32x4 __attribute__((ext_vector_type(4)));
typedef float f32x2 __attribute__((ext_vector_type(2)));
typedef float f32x16 __attribute__((ext_vector_type(16)));
typedef unsigned u32x4 __attribute__((ext_vector_type(4)));
typedef unsigned u32x2 __attribute__((ext_vector_type(2)));
typedef __bf16 bf16x2_t __attribute__((ext_vector_type(2)));

constexpr int NB = 16, SEQ = 2048, DM = 1024, NTOK = NB * SEQ, DEPTH = 4, FF = 2816, NIN = 3072, NADA = 9216;
constexpr float LOG2E = 1.4426950408889634f;
constexpr float QK_C2 = 0.125f * LOG2E;
constexpr float NEG_INF = -__builtin_inff();

constexpr size_t MiB = 1u << 20;
constexpr size_t WS_CTL = 0;
constexpr size_t WS_B1 = 4 * MiB;
constexpr size_t WS_MOD = 1 * MiB;
constexpr size_t WS_COS = 5 * MiB, WS_SIN = 6 * MiB;
constexpr size_t WS_CW2T = 7 * MiB;
constexpr size_t WS_WIN = 8 * MiB;
constexpr size_t WS_WOUT = 32 * MiB;
constexpr size_t WS_CW1 = 40 * MiB;
constexpr size_t WS_W13 = 48 * MiB;
constexpr size_t WS_W2 = 136 * MiB;
constexpr size_t WS_H = 180 * MiB;
constexpr size_t WS_BIG = 244 * MiB;
constexpr size_t WS_QNSA = 244 * MiB;
constexpr size_t WS_KC = 276 * MiB;
constexpr size_t WS_VC = 285 * MiB;
constexpr size_t WS_KS = 294 * MiB, WS_KW = 302 * MiB;
constexpr size_t WS_FOXQ = 310 * MiB;
constexpr size_t WS_FOXK = 326 * MiB;
constexpr size_t WS_MOBAQ = 342 * MiB, WS_MOBAK = 358 * MiB;
constexpr size_t WS_VST = 374 * MiB, WS_VWT = 382 * MiB;
constexpr size_t WS_FOXVT = 390 * MiB, WS_MOBAVT = 406 * MiB;
constexpr size_t WS_GATES = 422 * MiB;
constexpr size_t WS_FLOG = 425 * MiB;
constexpr size_t WS_FCUM = 426 * MiB;
constexpr size_t WS_KMEAN = 427 * MiB;
constexpr size_t WS_CMPHID = 428 * MiB;
constexpr size_t WS_KCMP = 432 * MiB;
constexpr size_t WS_VCMPT = 433 * MiB;
constexpr size_t WS_END = 436 * MiB;

constexpr int RING_BYTES = 131072;
constexpr int LDS_BYTES = 147456;
constexpr int NWAVES = 8;

__device__ __forceinline__ unsigned cvtpk(float lo, float hi) { f32x2 v = {lo, hi}; bf16x2_t b = __builtin_convertvector(v, bf16x2_t); return __builtin_bit_cast(unsigned, b); }
__device__ __forceinline__ float bf2f(short s) { return __uint_as_float(((unsigned)(unsigned short)s) << 16); }
__device__ __forceinline__ float fast_exp2(float x) { return __builtin_amdgcn_exp2f(x); }
__device__ __forceinline__ float fast_rcp(float x) { return __builtin_amdgcn_rcpf(x); }
__device__ __forceinline__ float silu_f(float a) { return a * fast_rcp(1.0f + fast_exp2(-a * LOG2E)); }
__device__ __forceinline__ float sigmoid_f(float a) { return 1.0f / (1.0f + __expf(-a)); }
__device__ __forceinline__ float gelu_tanh(float x) {
    const float u = 0.7978845608028654f * (x + 0.044715f * x * x * x);
    const float e = fast_exp2(2.0f * LOG2E * u);
    const float th = 1.0f - 2.0f * fast_rcp(e + 1.0f);
    return 0.5f * x * (1.0f + th);
}
__device__ __forceinline__ float wave_sum(float v) {
#pragma unroll
    for (int o = 1; o < 64; o <<= 1) v += __shfl_xor(v, o);
    return v;
}
__device__ __forceinline__ unsigned char* launder_p(unsigned char* p) { size_t z = 0; asm volatile("" : "+s"(z)); return p + z; }
__device__ __forceinline__ int launder_i(int v) { asm volatile("" : "+s"(v)); return v; }
__device__ __forceinline__ int launder_v(int v) { asm volatile("" : "+v"(v)); return v; }
__device__ __forceinline__ int fresh_lane() { unsigned m = ~0u; asm volatile("" : "+s"(m)); return (int)__builtin_amdgcn_mbcnt_hi(m, __builtin_amdgcn_mbcnt_lo(m, 0u)); }
__device__ __forceinline__ int crow(int r, int hi) { return (r & 3) + 8 * (r >> 2) + 4 * hi; }

namespace pg8 {
constexpr int BM = 256, BK = 64, HALF = 128, HTB = HALF * BK * 2, STAGE_BYTES = 8 * HTB, NXCD = 8, WGM = 8;
__host__ __device__ __forceinline__ int lds_byte(int r, int c) { const int st = (r >> 4) * 2 + (c >> 5), rr = r & 15, cc = c & 31, ob = rr * 64 + cc * 2; return st * 1024 + (ob ^ (((ob >> 9) & 1) << 5)); }
__host__ __device__ __forceinline__ void stage_rc(int b, int& R, int& C) { const int st = b / 1024, sb = b % 1024, swz = sb ^ (((sb >> 9) & 1) << 5); R = (st >> 1) * 16 + swz / 64; C = (st & 1) * 32 + (swz % 64) / 2; }
__host__ __device__ __forceinline__ int perm32(int rho) { const int n = rho >> 4, i = rho & 15; return 8 * (i >> 2) + 4 * n + (i & 3); }

struct Unit { int pm, pn; };
struct Gemm { const bf16_t* A; const bf16_t* Bt; int M, N, K, lda; };

struct StaticOrder {
    int nM, nN, nwg, G, c;
    __device__ void init(int M, int N, int G_, int c_) { nM = M / BM; nN = N / BM; nwg = nM * nN; G = G_; c = c_; }
    __device__ bool next(int i, Unit& u) const {
        const long L = (long)i * G + c; if (L >= nwg) return false;
        int wgid = (int)L; { const int q = nwg / NXCD, r = nwg % NXCD, xcd = wgid % NXCD, off = wgid / NXCD; wgid = (xcd < r ? xcd * (q + 1) : r * (q + 1) + (xcd - r) * q) + off; }
        const int nig = WGM * nN, gid = wgid / nig, fm = gid * WGM, gsz = (nM - fm) < WGM ? (nM - fm) : WGM;
        u.pm = fm + ((wgid % nig) % gsz); u.pn = (wgid % nig) / gsz; return true;
    }
};

template <class Epi, bool ALIGN_EPI>
__device__ __forceinline__ void gemm_phase(LAS unsigned char* lds, const Gemm g, const StaticOrder& S, const Epi& E, int wave0) {
    const int wid = wave0, lane = fresh_lane(), tid = wid * 64 + lane, wr = wid >> 2, wc = wid & 3, fr = lane & 15, fq = lane >> 4;
    const int K = g.K, nt = K / BK, lda = g.lda;
    unsigned voffA[2], voffB[2];
#pragma unroll
    for (int i = 0; i < 2; ++i) { int R, C; stage_rc(tid * 16 + i * 8192, R, C); const int Rb = Epi::PERM ? ((R & ~31) + perm32(R & 31)) : R;
        voffA[i] = (unsigned)(R * lda + C) * 2u; voffB[i] = (unsigned)(Rb * K + C) * 2u; }
    const size_t kstep = (size_t)(BK * 2);
    const size_t hstepA = (size_t)HALF * lda * 2, hstepB = (size_t)HALF * K * 2;
    const size_t tstepA = 2 * hstepA, tstepB = 2 * hstepB;
    const unsigned ldsw = (unsigned)wid * 1024u;
    const int aoff = lds_byte(wr * 64 + fr, fq * 8), boff = lds_byte(wc * 32 + fr, fq * 8);
#define PG8_SA(b, h) (((b) * 2 + (h)) * HTB)
#define PG8_SB(b, h) ((4 + (b) * 2 + (h)) * HTB)
#define PG8_STAGE(bufoff, gbase, voff) do { _Pragma("unroll") for (int _i = 0; _i < 2; ++_i) \
        __builtin_amdgcn_global_load_lds((const unsigned*)((const char*)(gbase) + (voff)[_i]), (LAS unsigned*)(lds + (bufoff) + ldsw + _i * 8192), 16, 0, 0); } while (0)
#define PG8_LDA(dst, b, h) do { _Pragma("unroll") for (int m = 0; m < 4; ++m) _Pragma("unroll") for (int k = 0; k < 2; ++k) dst[m][k] = *(const LAS bf16x8*)(lds + PG8_SA(b, h) + aoff + m * 2048 + k * 1024); } while (0)
#define PG8_LDB(dst, b, h) do { _Pragma("unroll") for (int n = 0; n < 2; ++n) _Pragma("unroll") for (int k = 0; k < 2; ++k) dst[n][k] = *(const LAS bf16x8*)(lds + PG8_SB(b, h) + boff + n * 2048 + k * 1024); } while (0)
#define PG8_MMA(ai, bj, At, Bt) do { __builtin_amdgcn_s_setprio(1); _Pragma("unroll") for (int m = 0; m < 4; ++m) _Pragma("unroll") for (int n = 0; n < 2; ++n) _Pragma("unroll") for (int k = 0; k < 2; ++k) \
        acc[ai][bj][m][n] = __builtin_amdgcn_mfma_f32_16x16x32_bf16(Bt[n][k], At[m][k], acc[ai][bj][m][n], 0, 0, 0); __builtin_amdgcn_s_setprio(0); } while (0)
#define PG8_WAIT_V(n) asm volatile("s_waitcnt vmcnt(" #n ")" ::: "memory")
#define PG8_WAIT_L(n) asm volatile("s_waitcnt lgkmcnt(" #n ")" ::: "memory")
#define PG8_BAR __builtin_amdgcn_s_barrier()
#define PG8_SCHED __builtin_amdgcn_sched_barrier(0)
    Unit cur, nxt; int ui = 0;
    if (!S.next(0, cur)) return;
    f32x4 acc[2][2][4][2];
#pragma unroll
    for (int a = 0; a < 2; ++a)
#pragma unroll
        for (int b = 0; b < 2; ++b)
#pragma unroll
            for (int m = 0; m < 4; ++m)
#pragma unroll
                for (int n = 0; n < 2; ++n) acc[a][b][m][n] = (f32x4){0.f, 0.f, 0.f, 0.f};
    bf16x8 At[4][2], B0[2][2], B1[2][2];
    const char* cA = (const char*)g.A + (size_t)cur.pm * tstepA; const char* cB = (const char*)g.Bt + (size_t)cur.pn * tstepB;
    PG8_STAGE(PG8_SB(0, 0), cB, voffB); PG8_STAGE(PG8_SB(0, 1), cB + hstepB, voffB); PG8_STAGE(PG8_SA(0, 0), cA, voffA); PG8_STAGE(PG8_SA(0, 1), cA + hstepA, voffA);
    if (wr == 1) PG8_BAR;
    PG8_WAIT_V(2); PG8_BAR;
    PG8_STAGE(PG8_SB(1, 0), cB + kstep, voffB); PG8_STAGE(PG8_SA(1, 0), cA + kstep, voffA); PG8_STAGE(PG8_SB(1, 1), cB + hstepB + kstep, voffB);
    PG8_WAIT_V(6); PG8_BAR;
    for (;;) {
        const bool has_next = S.next(ui + 1, nxt);
        const char* nA = has_next ? (const char*)g.A + (size_t)nxt.pm * tstepA : cA; const char* nB = has_next ? (const char*)g.Bt + (size_t)nxt.pn * tstepB : cB;
        for (int t = 0; t < nt; t += 2) {
            const bool last = (t == nt - 2);
            const char* a1 = cA + (size_t)(t + 1) * kstep;
            const char* a2 = last ? nA : cA + (size_t)(t + 2) * kstep; const char* b2 = last ? nB : cB + (size_t)(t + 2) * kstep;
            const char* a3 = a2 + kstep; const char* b3 = b2 + kstep;
            PG8_LDB(B0, 0, 0); PG8_LDB(B1, 0, 1); PG8_SCHED; PG8_LDA(At, 0, 0); PG8_STAGE(PG8_SA(1, 1), a1 + hstepA, voffA);
            PG8_WAIT_V(8); PG8_WAIT_L(0); PG8_BAR; PG8_MMA(0, 0, At, B0); PG8_MMA(0, 1, At, B1); PG8_BAR; PG8_SCHED;
            PG8_LDA(At, 0, 1); PG8_STAGE(PG8_SB(0, 0), b2, voffB); PG8_STAGE(PG8_SB(0, 1), b2 + hstepB, voffB); PG8_STAGE(PG8_SA(0, 0), a2, voffA);
            PG8_WAIT_V(8); PG8_WAIT_L(0); PG8_BAR; PG8_MMA(1, 0, At, B0); PG8_MMA(1, 1, At, B1); PG8_BAR; PG8_SCHED;
            PG8_LDB(B0, 1, 0); PG8_LDB(B1, 1, 1); PG8_SCHED; PG8_LDA(At, 1, 0); PG8_STAGE(PG8_SA(0, 1), a2 + hstepA, voffA);
            PG8_WAIT_V(8); PG8_WAIT_L(0); PG8_BAR; PG8_MMA(0, 0, At, B0); PG8_MMA(0, 1, At, B1); PG8_BAR; PG8_SCHED;
            PG8_LDA(At, 1, 1); PG8_STAGE(PG8_SB(1, 0), b3, voffB); PG8_STAGE(PG8_SB(1, 1), b3 + hstepB, voffB); PG8_STAGE(PG8_SA(1, 0), a3, voffA);
            PG8_WAIT_V(8); PG8_WAIT_L(0); PG8_BAR; PG8_MMA(1, 0, At, B0); PG8_MMA(1, 1, At, B1); PG8_BAR; PG8_SCHED;
        }
        if constexpr (ALIGN_EPI) { if (wr == 0) PG8_BAR; }
        { int efr = fr, efq = fq, ewr = wr, ewc = wc; asm volatile("" : "+v"(efr), "+v"(efq), "+s"(ewr), "+s"(ewc)); E(acc, cur, ewr, ewc, efr, efq); }
        if (!has_next) break;
#pragma unroll
        for (int a = 0; a < 2; ++a)
#pragma unroll
            for (int b = 0; b < 2; ++b)
#pragma unroll
                for (int m = 0; m < 4; ++m)
#pragma unroll
                    for (int n = 0; n < 2; ++n) acc[a][b][m][n] = (f32x4){0.f, 0.f, 0.f, 0.f};
        cur = nxt; cA = nA; cB = nB; ++ui;
        if constexpr (ALIGN_EPI) { if (wr == 1) PG8_BAR; }
    }
    PG8_WAIT_V(0);
    if constexpr (!ALIGN_EPI) { if (wr == 0) PG8_BAR; }
    PG8_BAR;
#undef PG8_SA
#undef PG8_SB
#undef PG8_STAGE
#undef PG8_LDA
#undef PG8_LDB
#undef PG8_MMA
#undef PG8_WAIT_V
#undef PG8_WAIT_L
#undef PG8_BAR
#undef PG8_SCHED
}
}

struct EpiSwiglu {
    static constexpr bool PERM = true;
    bf16_t* O;
    __device__ __forceinline__ void operator()(const f32x4 (&acc)[2][2][4][2], const pg8::Unit& u, int wr, int wc, int fr, int fq) const {
        const int row0 = u.pm * 256 + wr * 64 + fr, col0 = u.pn * 128 + wc * 32 + 8 * fq;
#pragma unroll
        for (int ai = 0; ai < 2; ++ai)
#pragma unroll
            for (int m = 0; m < 4; ++m) {
                bf16_t* rowp = O + (size_t)(row0 + ai * 128 + m * 16) * FF + col0;
                const f32x4 a0 = acc[ai][0][m][0], a1 = acc[ai][0][m][1], b0 = acc[ai][1][m][0], b1 = acc[ai][1][m][1];
                u32x4 w;
                w.x = cvtpk(silu_f(a0[0]) * b0[0], silu_f(a0[1]) * b0[1]); w.y = cvtpk(silu_f(a0[2]) * b0[2], silu_f(a0[3]) * b0[3]);
                w.z = cvtpk(silu_f(a1[0]) * b1[0], silu_f(a1[1]) * b1[1]); w.w = cvtpk(silu_f(a1[2]) * b1[2], silu_f(a1[3]) * b1[3]);
                *(u32x4*)rowp = w;
            }
    }
};
struct EpiResid {
    static constexpr bool PERM = false;
    const float* xin; float* xout; const float* gate; float coef;
    __device__ __forceinline__ void operator()(const f32x4 (&acc)[2][2][4][2], const pg8::Unit& u, int wr, int wc, int fr, int fq) const {
        const int b = (u.pm * 256) >> 11;
        const int row0 = u.pm * 256 + wr * 64 + fr;
#pragma unroll
        for (int bj = 0; bj < 2; ++bj)
#pragma unroll
            for (int n = 0; n < 2; ++n) {
                const int col = u.pn * 256 + bj * 128 + wc * 32 + n * 16 + 4 * fq;
                const f32x4 gv = *(const f32x4*)(gate + (size_t)b * NADA + col) * coef;
                f32x4 xv[2][4];
#pragma unroll
                for (int ai = 0; ai < 2; ++ai)
#pragma unroll
                    for (int m = 0; m < 4; ++m) xv[ai][m] = *(const f32x4*)(xin + (size_t)(row0 + ai * 128 + m * 16) * DM + col);
#pragma unroll
                for (int ai = 0; ai < 2; ++ai)
#pragma unroll
                    for (int m = 0; m < 4; ++m) {
                        const size_t off = (size_t)(row0 + ai * 128 + m * 16) * DM + col;
                        *(f32x4*)(xout + off) = xv[ai][m] + gv * acc[ai][bj][m][n];
                    }
            }
    }
};
struct EpiGelu {
    static constexpr bool PERM = true;
    bf16_t* O; const float* bias;
    __device__ __forceinline__ void operator()(const f32x4 (&acc)[2][2][4][2], const pg8::Unit& u, int wr, int wc, int fr, int fq) const {
        const int row0 = u.pm * 256 + wr * 64 + fr;
#pragma unroll
        for (int bj = 0; bj < 2; ++bj) {
            const int col0 = u.pn * 256 + bj * 128 + wc * 32 + 8 * fq;
            const f32x4 bv0 = *(const f32x4*)(bias + col0), bv1 = *(const f32x4*)(bias + col0 + 4);
#pragma unroll
            for (int ai = 0; ai < 2; ++ai)
#pragma unroll
                for (int m = 0; m < 4; ++m) {
                    const f32x4 v0 = acc[ai][bj][m][0] + bv0, v1 = acc[ai][bj][m][1] + bv1;
                    u32x4 w;
                    w.x = cvtpk(gelu_tanh(v0[0]), gelu_tanh(v0[1])); w.y = cvtpk(gelu_tanh(v0[2]), gelu_tanh(v0[3]));
                    w.z = cvtpk(gelu_tanh(v1[0]), gelu_tanh(v1[1])); w.w = cvtpk(gelu_tanh(v1[2]), gelu_tanh(v1[3]));
                    *(u32x4*)(O + (size_t)(row0 + ai * 128 + m * 16) * 256 + col0) = w;
                }
        }
    }
};
struct EpiInProj {
    static constexpr bool PERM = true;
    unsigned char* ws; const float* fbias;
    __device__ __forceinline__ void operator()(const f32x4 (&acc)[2][2][4][2], const pg8::Unit& u, int wr, int wc, int fr, int fq) const {
        part<0>(acc, u, wr, wc, fr, fq); part<1>(acc, u, wr, wc, fr, fq);
    }
    template <int bj>
    __device__ __forceinline__ void part(const f32x4 (&acc)[2][2][4][2], const pg8::Unit& u, int wr, int wc, int fr, int fq) const {
        const float* cosT = (const float*)(ws + WS_COS); const float* sinT = (const float*)(ws + WS_SIN);
        {
            const int cb = u.pn * 256 + bj * 128 + wc * 32;
            const int hg = cb >> 6, half = (cb >> 5) & 1;
            if (hg > 44) return;
            int mode, NH = 1, hd = 0, pitch = 0; bool rope = false; bf16_t* base = nullptr;
            if (hg < 8)       { mode = 0; base = (bf16_t*)(ws + WS_QNSA); pitch = 512; hd = hg; rope = true; }
            else if (hg < 10) { mode = 1; base = (bf16_t*)(ws + WS_KC); NH = 2; hd = hg - 8; rope = true; }
            else if (hg < 12) { mode = 4; base = (bf16_t*)(ws + WS_KS); NH = 2; hd = hg - 10; rope = true; }
            else if (hg < 14) { mode = 4; base = (bf16_t*)(ws + WS_KW); NH = 2; hd = hg - 12; rope = true; }
            else if (hg < 18) { mode = 0; base = (bf16_t*)(ws + WS_FOXQ); pitch = 256; hd = hg - 14; }
            else if (hg < 22) { mode = 4; base = (bf16_t*)(ws + WS_FOXK); NH = 4; hd = hg - 18; }
            else if (hg < 26) { mode = 0; base = (bf16_t*)(ws + WS_MOBAQ); pitch = 256; hd = hg - 22; rope = true; }
            else if (hg < 30) { mode = 4; base = (bf16_t*)(ws + WS_MOBAK); NH = 4; hd = hg - 26; rope = true; }
            else if (hg < 32) { mode = 1; base = (bf16_t*)(ws + WS_VC); NH = 2; hd = hg - 30; }
            else if (hg < 34) { mode = 2; base = (bf16_t*)(ws + WS_VST); NH = 2; hd = hg - 32; }
            else if (hg < 36) { mode = 2; base = (bf16_t*)(ws + WS_VWT); NH = 2; hd = hg - 34; }
            else if (hg < 40) { mode = 2; base = (bf16_t*)(ws + WS_FOXVT); NH = 4; hd = hg - 36; }
            else if (hg < 44) { mode = 2; base = (bf16_t*)(ws + WS_MOBAVT); NH = 4; hd = hg - 40; }
            else { mode = 3; if (half) return; }
            const bool do_rope = rope && (half == 0);
#pragma unroll
            for (int ai = 0; ai < 2; ++ai) {
                f32x4 rc[4][4];
                if (do_rope && fq < 2) {
#pragma unroll
                    for (int m = 0; m < 4; ++m) {
                        const size_t ro = (size_t)(u.pm * 256 + ai * 128 + wr * 64 + m * 16 + fr) * 8;
                        rc[m][0] = *(const f32x4*)(cosT + ro); rc[m][1] = *(const f32x4*)(cosT + ro + 4);
                        rc[m][2] = *(const f32x4*)(sinT + ro); rc[m][3] = *(const f32x4*)(sinT + ro + 4);
                    }
                }
#pragma unroll
                for (int m = 0; m < 4; ++m) {
                    const int row = u.pm * 256 + ai * 128 + wr * 64 + m * 16 + fr;
                    const int b = row >> 11, t = row & 2047;
                    float v[8];
#pragma unroll
                    for (int i = 0; i < 4; ++i) { v[i] = acc[ai][bj][m][0][i]; v[4 + i] = acc[ai][bj][m][1][i]; }
                    if (do_rope) {
                        float pr[8];
#pragma unroll
                        for (int i = 0; i < 8; ++i) pr[i] = __shfl_xor(v[i], 16);
                        if (fq < 2) {
                            const f32x4 c0 = rc[m][0], c1 = rc[m][1], s0 = rc[m][2], s1 = rc[m][3];
                            const float sg = (fq == 0) ? -1.0f : 1.0f;
#pragma unroll
                            for (int i = 0; i < 4; ++i) { v[i] = v[i] * c0[i] + sg * pr[i] * s0[i]; v[4 + i] = v[4 + i] * c1[i] + sg * pr[4 + i] * s1[i]; }
                        }
                    }
                    if (mode == 3) {
                        float* gates = (float*)(ws + WS_GATES); float* flog = (float*)(ws + WS_FLOG);
                        if (fq < 3) {
                            f32x4 g0, g1;
#pragma unroll
                            for (int i = 0; i < 4; ++i) { g0[i] = sigmoid_f(v[i]); g1[i] = sigmoid_f(v[4 + i]); }
                            *(f32x4*)(gates + (size_t)row * 24 + 8 * fq) = g0; *(f32x4*)(gates + (size_t)row * 24 + 8 * fq + 4) = g1;
                        } else {
#pragma unroll
                            for (int i = 0; i < 4; ++i) {
                                const float z = v[i] + fbias[i];
                                const float ls = (z > 0.f) ? -log1pf(__expf(-z)) : (z - log1pf(__expf(z)));
                                flog[(size_t)(b * 4 + i) * SEQ + t] = ls;
                            }
                        }
                    } else {
                        u32x4 w; w.x = cvtpk(v[0], v[1]); w.y = cvtpk(v[2], v[3]); w.z = cvtpk(v[4], v[5]); w.w = cvtpk(v[6], v[7]);
                        const int dcol = half * 32 + 8 * fq;
                        if (mode == 0) *(u32x4*)(base + (size_t)row * pitch + hd * 64 + dcol) = w;
                        else if (mode == 1) *(u32x4*)(base + ((size_t)(b * NH + hd) * SEQ + t) * 64 + dcol) = w;
                        else if (mode == 4) {
                            const int d0 = half * 2 + (fq >> 1), khi = fq & 1;
                            *(u32x4*)(base + (size_t)(b * NH + hd) * SEQ * 64 + (size_t)(t >> 6) * 4096 + ((((t >> 5) & 1) * 4 + d0) * 64 + khi * 32 + (t & 31)) * 8) = w;
                        } else {
                            const int tt = t & 63, hf = tt >> 5, jj = (tt >> 4) & 1, piece = (tt >> 3) & 1, vhi = (tt >> 2) & 1, e = tt & 3;
                            bf16_t* p = base + (size_t)(b * NH + hd) * SEQ * 64 + (size_t)(t >> 6) * 4096 + (((hf * 2 + jj) * 2 + half) * 64 + vhi * 32 + 8 * fq) * 8 + piece * 4 + e;
                            p[0 * 8] = (bf16_t)(w.x & 0xffffu); p[1 * 8] = (bf16_t)(w.x >> 16);
                            p[2 * 8] = (bf16_t)(w.y & 0xffffu); p[3 * 8] = (bf16_t)(w.y >> 16);
                            p[4 * 8] = (bf16_t)(w.z & 0xffffu); p[5 * 8] = (bf16_t)(w.z >> 16);
                            p[6 * 8] = (bf16_t)(w.w & 0xffffu); p[7 * 8] = (bf16_t)(w.w >> 16);
                        }
                    }
                }
            }
        }
    }
};

#define MFMA32(a, b, c) __builtin_amdgcn_mfma_f32_32x32x16_bf16((a), (b), (c), 0, 0, 0)
__device__ __forceinline__ f32x16 qk32(const bf16_t* kp, const bf16x8 (&qf)[4]) {
    f32x16 p;
#pragma unroll
    for (int r = 0; r < 16; ++r) p[r] = 0.f;
#pragma unroll
    for (int d0 = 0; d0 < 4; ++d0) { const bf16x8 kf = *(const bf16x8*)(kp + 16 * d0); p = MFMA32(kf, qf[d0], p); }
    return p;
}
__device__ __forceinline__ void pv32(f32x16 (&o)[2], const bf16_t* vp, int vpitch, const f32x16& p) {
#pragma unroll
    for (int j = 0; j < 2; ++j) {
        u32x4 pw; pw.x = cvtpk(p[8 * j + 0], p[8 * j + 1]); pw.y = cvtpk(p[8 * j + 2], p[8 * j + 3]); pw.z = cvtpk(p[8 * j + 4], p[8 * j + 5]); pw.w = cvtpk(p[8 * j + 6], p[8 * j + 7]);
        const bf16x8 pb = __builtin_bit_cast(bf16x8, pw);
#pragma unroll
        for (int dh = 0; dh < 2; ++dh) {
            const bf16_t* q = vp + (size_t)dh * 32 * vpitch + 16 * j;
            const s16x4 lo = *(const s16x4*)q, hi4 = *(const s16x4*)(q + 8);
            const bf16x8 va = (bf16x8){lo[0], lo[1], lo[2], lo[3], hi4[0], hi4[1], hi4[2], hi4[3]};
            o[dh] = MFMA32(va, pb, o[dh]);
        }
    }
}
__device__ __forceinline__ void load_k64(bf16x8 (&kf)[8], const bf16_t* ktile, int lane) {
    const bf16_t* p = ktile + lane * 8;
#pragma unroll
    for (int i = 0; i < 8; ++i) kf[i] = *(const bf16x8*)(p + i * 512);
}
__device__ __forceinline__ void load_v64(bf16x8 (&vf)[8], const bf16_t* vtile, int lane) {
    const bf16_t* p = vtile + lane * 8;
#pragma unroll
    for (int i = 0; i < 8; ++i) vf[i] = *(const bf16x8*)(p + i * 512);
}
template <int MODE, int MK>
__device__ __forceinline__ void softmax_pv(f32x16 (&o)[2], float& m, float& l, f32x16& p0, f32x16& p1, const bf16x8 (&vf)[8],
                                           int kb, int t, bool tsel, const float* F8, float Fq8, int hi) {
    if (MK == 2) {
#pragma unroll
        for (int r = 0; r < 16; ++r) {
            const int k0 = kb + crow(r, hi), k1 = k0 + 32;
            bool v0, v1;
            if (MODE == 0) { v0 = tsel && (k0 <= t); v1 = tsel && (k1 <= t); }
            else if (MODE == 1) { v0 = (k0 <= t) && (k0 > t - 512); v1 = (k1 <= t) && (k1 > t - 512); }
            else { v0 = (k0 <= t); v1 = (k1 <= t); }
            p0[r] = v0 ? p0[r] : NEG_INF; p1[r] = v1 ? p1[r] : NEG_INF;
        }
    }
    int ia = max(__float_as_int(p0[0]), __float_as_int(p1[0])), ib = max(__float_as_int(p0[1]), __float_as_int(p1[1]));
#pragma unroll
    for (int r = 2; r < 16; r += 2) { ia = max(ia, max(__float_as_int(p0[r]), __float_as_int(p1[r]))); ib = max(ib, max(__float_as_int(p0[r + 1]), __float_as_int(p1[r + 1]))); }
    float mx = __int_as_float(max(max(ia, ib), 0));
    if (MK == 1) mx = tsel ? mx : NEG_INF;
    mx = fmaxf(mx, __shfl_xor(mx, 32));
    const float mnew = fmaxf(m, mx);
    const float msafe = (mnew == NEG_INF) ? 0.f : mnew;
    const float alpha = fast_exp2((m - msafe) * QK_C2);
    float nm = -msafe * QK_C2;
    if (MK == 1) nm = tsel ? nm : NEG_INF;
    float ps = 0.f;
#pragma unroll
    for (int r = 0; r < 16; ++r) { p0[r] = fast_exp2(__builtin_fmaf(p0[r], QK_C2, nm)); p1[r] = fast_exp2(__builtin_fmaf(p1[r], QK_C2, nm)); ps += p0[r] + p1[r]; }
    l = l * alpha + ps; m = mnew;
#pragma unroll
    for (int r = 0; r < 16; ++r) { o[0][r] *= alpha; o[1][r] *= alpha; }
#pragma unroll
    for (int hf = 0; hf < 2; ++hf)
#pragma unroll
        for (int j = 0; j < 2; ++j) {
            const f32x16& p = hf ? p1 : p0;
            u32x4 pw; pw.x = cvtpk(p[8 * j + 0], p[8 * j + 1]); pw.y = cvtpk(p[8 * j + 2], p[8 * j + 3]); pw.z = cvtpk(p[8 * j + 4], p[8 * j + 5]); pw.w = cvtpk(p[8 * j + 6], p[8 * j + 7]);
            const bf16x8 pb = __builtin_bit_cast(bf16x8, pw);
#pragma unroll
            for (int dh = 0; dh < 2; ++dh) o[dh] = MFMA32(vf[(hf * 2 + j) * 2 + dh], pb, o[dh]);
        }
}
template <int MODE, class Sel>
__device__ __forceinline__ void flash_loop(f32x16 (&o)[2], float& m, float& l, const bf16x8 (&qf)[4], const bf16_t* K, const bf16_t* Vt,
                                           int jlo, int jhi, int t, int tmin, int tmax, Sel sel, const float* F8, float Fq8, int lane) {
    const int hi = lane >> 5;
    int j = jlo;
    for (; j <= jhi; ++j) { if (__any(sel(j))) break; }
    bf16x8 kf[8], vf[8];
    if (j <= jhi) load_k64(kf, K + (size_t)j * 4096, lane);
    while (j <= jhi) {
        int jn = j + 1;
        for (; jn <= jhi; ++jn) { if (__any(sel(jn))) break; }
        load_v64(vf, Vt + (size_t)j * 4096, lane);
        f32x16 p0, p1;
        const int kb = j * 64;
        if (MODE == 2) {
#pragma unroll
            for (int g = 0; g < 4; ++g) {
                const f32x4 fa = *(const f32x4*)(F8 + kb + 8 * g + 4 * hi), fbv = *(const f32x4*)(F8 + kb + 32 + 8 * g + 4 * hi);
#pragma unroll
                for (int i = 0; i < 4; ++i) { p0[4 * g + i] = fa[i]; p1[4 * g + i] = fbv[i]; }
            }
        } else {
#pragma unroll
            for (int r = 0; r < 16; ++r) { p0[r] = 0.f; p1[r] = 0.f; }
        }
#pragma unroll
        for (int d0 = 0; d0 < 4; ++d0) { p0 = MFMA32(kf[d0], qf[d0], p0); p1 = MFMA32(kf[4 + d0], qf[d0], p1); }
        if (jn <= jhi) load_k64(kf, K + (size_t)jn * 4096, lane);
        bool full = (kb + 63 <= tmin);
        if (MODE == 1) full = full && (kb > tmax - 512);
        if (full) {
            if (MODE == 0 && !__all(sel(j))) softmax_pv<MODE, 1>(o, m, l, p0, p1, vf, kb, t, sel(j), F8, Fq8, hi);
            else softmax_pv<MODE, 0>(o, m, l, p0, p1, vf, kb, t, true, F8, Fq8, hi);
        } else softmax_pv<MODE, 2>(o, m, l, p0, p1, vf, kb, t, sel(j), F8, Fq8, hi);
        j = jn;
    }
}
__device__ __forceinline__ void load_q(bf16x8 (&qf)[4], const bf16_t* qrow, int hi) {
#pragma unroll
    for (int d0 = 0; d0 < 4; ++d0) qf[d0] = *(const bf16x8*)(qrow + 16 * d0 + 8 * hi);
}
__device__ __forceinline__ void store_o(bf16_t* dst, const f32x16 (&o)[2], int hi) {
#pragma unroll
    for (int dh = 0; dh < 2; ++dh)
#pragma unroll
        for (int g = 0; g < 4; ++g) {
            u32x2 w; w.x = cvtpk(o[dh][4 * g + 0], o[dh][4 * g + 1]); w.y = cvtpk(o[dh][4 * g + 2], o[dh][4 * g + 3]);
            *(u32x2*)(dst + 32 * dh + 8 * g + 4 * hi) = w;
        }
}
__device__ __forceinline__ unsigned nsa_select(const float (&imp)[32], int t) {
    const int tb = t >> 6;
    unsigned sel = 1u | (1u << tb) | (1u << (tb > 0 ? tb - 1 : 0));
#pragma unroll
    for (int it = 0; it < 5; ++it) {
        float bv = NEG_INF; int bj = -1;
#pragma unroll
        for (int j = 1; j < 32; ++j) { const bool cand = (j <= tb - 2) && !((sel >> j) & 1u) && (imp[j] > bv); if (cand) { bv = imp[j]; bj = j; } }
        if (bj >= 0) sel |= 1u << bj;
    }
    if (tb <= 7) sel = (2u << tb) - 1u;
    return sel;
}

__device__ __forceinline__ void nsa_unit(unsigned char* ws, int b, int g, int qg, int lane, float* wl) {
    const int hi = lane >> 5, c = lane & 31;
    const int t = qg * 8 + (c >> 2), head = g * 4 + (c & 3), row = b * SEQ + t, bg = b * 2 + g;
    bf16x8 qf[4];
    load_q(qf, (const bf16_t*)(ws + WS_QNSA) + (size_t)row * 512 + head * 64, hi);
    const float* gp = (const float*)(ws + WS_GATES) + (size_t)row * 24 + head * 3;
    const float g0 = gp[0];
    f32x16 o[2];
    float* oa = wl + 256 + lane;
    {
        const bf16_t* Kc = (const bf16_t*)(ws + WS_KCMP) + (size_t)bg * 8192;
        const bf16_t* Vct = (const bf16_t*)(ws + WS_VCMPT) + (size_t)bg * 8192;
        f32x16 s[4];
        float mx = NEG_INF;
#pragma unroll
        for (int tile = 0; tile < 2; ++tile) {
            bf16x8 kf[8];
            load_k64(kf, Kc + tile * 4096, lane);
#pragma unroll
            for (int hf = 0; hf < 2; ++hf) {
                const int grp = tile * 2 + hf;
#pragma unroll
                for (int r = 0; r < 16; ++r) s[grp][r] = 0.f;
#pragma unroll
                for (int d0 = 0; d0 < 4; ++d0) s[grp] = MFMA32(kf[hf * 4 + d0], qf[d0], s[grp]);
#pragma unroll
                for (int r = 0; r < 16; ++r) {
                    const int key = 32 * grp + crow(r, hi);
                    const float v = (16 * key + 31 <= t) ? s[grp][r] * QK_C2 : NEG_INF;
                    s[grp][r] = v; mx = fmaxf(mx, v);
                }
            }
        }
        mx = fmaxf(mx, __shfl_xor(mx, 32));
        const float msafe = (mx == NEG_INF) ? 0.f : mx;
        float ps = 0.f;
#pragma unroll
        for (int grp = 0; grp < 4; ++grp)
#pragma unroll
            for (int r = 0; r < 16; ++r) { s[grp][r] = fast_exp2(s[grp][r] - msafe); ps += s[grp][r]; }
        ps += __shfl_xor(ps, 32);
        const float inv = 1.0f / fmaxf(ps, 1e-30f);
#pragma unroll
        for (int grp = 0; grp < 4; ++grp)
#pragma unroll
            for (int r = 0; r < 16; ++r) s[grp][r] *= inv;
#pragma unroll
        for (int r = 0; r < 16; ++r) { o[0][r] = 0.f; o[1][r] = 0.f; }
#pragma unroll
        for (int tile = 0; tile < 2; ++tile) {
            bf16x8 vf[8];
            load_v64(vf, Vct + tile * 4096, lane);
#pragma unroll
            for (int hf = 0; hf < 2; ++hf)
#pragma unroll
                for (int j = 0; j < 2; ++j) {
                    const f32x16& p = s[tile * 2 + hf];
                    u32x4 pw; pw.x = cvtpk(p[8 * j + 0], p[8 * j + 1]); pw.y = cvtpk(p[8 * j + 2], p[8 * j + 3]); pw.z = cvtpk(p[8 * j + 4], p[8 * j + 5]); pw.w = cvtpk(p[8 * j + 6], p[8 * j + 7]);
                    const bf16x8 pb = __builtin_bit_cast(bf16x8, pw);
#pragma unroll
                    for (int dh = 0; dh < 2; ++dh) o[dh] = MFMA32(vf[(hf * 2 + j) * 2 + dh], pb, o[dh]);
                }
        }
#pragma unroll
        for (int r = 0; r < 16; ++r) { oa[r * 64] = g0 * o[0][r]; oa[(16 + r) * 64] = g0 * o[1][r]; }
        float recv[4][4];
#pragma unroll
        for (int grp = 0; grp < 4; ++grp)
#pragma unroll
            for (int gq = 0; gq < 4; ++gq) recv[grp][gq] = __shfl_xor(s[grp][4 * gq + 3], 32);
#pragma unroll
        for (int grp = 0; grp < 4; ++grp)
#pragma unroll
            for (int gq = 0; gq < 4; ++gq) {
                const float own = (s[grp][4 * gq] + s[grp][4 * gq + 1]) + (s[grp][4 * gq + 2] + s[grp][4 * gq + 3]);
                const float plo = (gq > 0) ? recv[grp][gq > 0 ? gq - 1 : 0] : ((grp > 0) ? recv[grp > 0 ? grp - 1 : 0][3] : 0.f);
                const float prev = hi ? recv[grp][gq] : plo;
                float v = own + prev;
                v += __shfl_xor(v, 1); v += __shfl_xor(v, 2);
                if ((c & 3) == 0) wl[(c >> 2) * 32 + 8 * grp + 2 * gq + hi] = v;
            }
    }
    asm volatile("s_waitcnt lgkmcnt(0)" ::: "memory");
    float imp[32];
#pragma unroll
    for (int j4 = 0; j4 < 8; ++j4) { const f32x4 v = *(const f32x4*)(wl + (c >> 2) * 32 + 4 * j4); imp[4 * j4] = v[0]; imp[4 * j4 + 1] = v[1]; imp[4 * j4 + 2] = v[2]; imp[4 * j4 + 3] = v[3]; }
    asm volatile("s_waitcnt lgkmcnt(0)" ::: "memory");
    const unsigned sel = nsa_select(imp, t);
    const int jmax = (qg * 8 + 7) >> 6;
    {
        const bf16_t* Ks = (const bf16_t*)(ws + WS_KS) + (size_t)bg * SEQ * 64;
        const bf16_t* Vst = (const bf16_t*)(ws + WS_VST) + (size_t)bg * 64 * SEQ;
        float m = NEG_INF, l = 0.f;
#pragma unroll
        for (int r = 0; r < 16; ++r) { o[0][r] = 0.f; o[1][r] = 0.f; }
        flash_loop<0>(o, m, l, qf, Ks, Vst, 0, jmax, t, qg * 8, qg * 8 + 7, [&](int j) { return (bool)((sel >> j) & 1u); }, nullptr, 0.f, lane);
        l += __shfl_xor(l, 32);
        const float sc = gp[1] / fmaxf(l, 1e-30f);
#pragma unroll
        for (int r = 0; r < 16; ++r) { oa[r * 64] += sc * o[0][r]; oa[(16 + r) * 64] += sc * o[1][r]; }
        asm volatile("s_waitcnt lgkmcnt(0)" ::: "memory");
    }
    {
        const bf16_t* Kw = (const bf16_t*)(ws + WS_KW) + (size_t)bg * SEQ * 64;
        const bf16_t* Vwt = (const bf16_t*)(ws + WS_VWT) + (size_t)bg * 64 * SEQ;
        float m = NEG_INF, l = 0.f;
#pragma unroll
        for (int r = 0; r < 16; ++r) { o[0][r] = 0.f; o[1][r] = 0.f; }
        const int tl = qg * 8 - 511;
        const int jlo = (tl > 0 ? tl : 0) >> 6;
        flash_loop<1>(o, m, l, qf, Kw, Vwt, jlo, jmax, t, qg * 8, qg * 8 + 7, [&](int) { return true; }, nullptr, 0.f, lane);
        l += __shfl_xor(l, 32);
        const float sc = gp[2] / fmaxf(l, 1e-30f);
#pragma unroll
        for (int r = 0; r < 16; ++r) { o[0][r] = oa[r * 64] + sc * o[0][r]; o[1][r] = oa[(16 + r) * 64] + sc * o[1][r]; }
        asm volatile("s_waitcnt lgkmcnt(0)" ::: "memory");
    }
    store_o((bf16_t*)(ws + WS_H) + (size_t)row * DM + head * 64, o, hi);
}

__device__ __forceinline__ void fox_unit(unsigned char* ws, int bh, int qt, int lane) {
    const int hi = lane >> 5, c = lane & 31, b = bh >> 2, h = bh & 3;
    const int t = qt * 32 + c, row = b * SEQ + t;
    bf16x8 qf[4];
    load_q(qf, (const bf16_t*)(ws + WS_FOXQ) + (size_t)row * 256 + h * 64, hi);
    const bf16_t* K = (const bf16_t*)(ws + WS_FOXK) + (size_t)bh * SEQ * 64;
    const bf16_t* Vt = (const bf16_t*)(ws + WS_FOXVT) + (size_t)bh * 64 * SEQ;
    const float* F2 = (const float*)(ws + WS_FCUM) + (size_t)bh * SEQ;
    const float Fq2 = F2[t];
    f32x16 o[2]; float m = NEG_INF, l = 0.f;
#pragma unroll
    for (int r = 0; r < 16; ++r) { o[0][r] = 0.f; o[1][r] = 0.f; }
    const int jmax = (qt * 32 + 31) >> 6;
    flash_loop<2>(o, m, l, qf, K, Vt, 0, jmax, t, qt * 32, qt * 32 + 31, [&](int) { return true; }, F2, Fq2, lane);
    l += __shfl_xor(l, 32);
    const float sc = 1.0f / fmaxf(l, 1e-30f);
#pragma unroll
    for (int r = 0; r < 16; ++r) { o[0][r] *= sc; o[1][r] *= sc; }
    store_o((bf16_t*)(ws + WS_H) + (size_t)row * DM + 512 + h * 64, o, hi);
}

__device__ __forceinline__ void moba_unit(unsigned char* ws, int bh, int qt, int lane) {
    const int hi = lane >> 5, c = lane & 31, b = bh >> 2, h = bh & 3;
    const int t = qt * 32 + c, row = b * SEQ + t;
    bf16x8 qf[4];
    load_q(qf, (const bf16_t*)(ws + WS_MOBAQ) + (size_t)row * 256 + h * 64, hi);
    const bf16_t* K = (const bf16_t*)(ws + WS_MOBAK) + (size_t)bh * SEQ * 64;
    const bf16_t* Vt = (const bf16_t*)(ws + WS_MOBAVT) + (size_t)bh * 64 * SEQ;
    const int own = (qt * 32) >> 8;
    unsigned sel = 0u;
    {
        float gt[7];
        const float* km = (const float*)(ws + WS_KMEAN) + (size_t)bh * 8 * 64;
#pragma unroll
        for (int blk = 0; blk < 7; ++blk) {
            float a = 0.f;
            if (blk < own) {
#pragma unroll
                for (int d0 = 0; d0 < 4; ++d0) {
                    const f32x4 k0 = *(const f32x4*)(km + blk * 64 + 16 * d0 + 8 * hi), k1 = *(const f32x4*)(km + blk * 64 + 16 * d0 + 8 * hi + 4);
#pragma unroll
                    for (int i = 0; i < 4; ++i) { a += bf2f(qf[d0][i]) * k0[i]; a += bf2f(qf[d0][4 + i]) * k1[i]; }
                }
                a += __shfl_xor(a, 32);
            }
            gt[blk] = a;
        }
#pragma unroll
        for (int it = 0; it < 3; ++it) {
            float bv = NEG_INF; int bj = -1;
#pragma unroll
            for (int blk = 0; blk < 7; ++blk) { const bool cand = (blk < own) && !((sel >> blk) & 1u) && (gt[blk] > bv); if (cand) { bv = gt[blk]; bj = blk; } }
            if (bj >= 0) sel |= 1u << bj;
        }
    }
    f32x16 o[2]; float m = NEG_INF, l = 0.f;
#pragma unroll
    for (int r = 0; r < 16; ++r) { o[0][r] = 0.f; o[1][r] = 0.f; }
    const int jmax = (qt * 32 + 31) >> 6;
    flash_loop<0>(o, m, l, qf, K, Vt, 0, jmax, t, qt * 32, qt * 32 + 31, [&](int j) { const int blk = j >> 2; return (blk == own) || (bool)((sel >> blk) & 1u); }, nullptr, 0.f, lane);
    l += __shfl_xor(l, 32);
    const float sc = 1.0f / fmaxf(l, 1e-30f);
#pragma unroll
    for (int r = 0; r < 16; ++r) { o[0][r] *= sc; o[1][r] *= sc; }
    store_o((bf16_t*)(ws + WS_H) + (size_t)row * DM + 768 + h * 64, o, hi);
}


#define XB_TMO      128
#define XB_XCNT(j)  (256  + 64 * (j))
#define XB_XSUB(j)  (1280 + 64 * (j))
#define XB_XGEN(j)  (2304 + 64 * (j))
#define XB_TOP      3328
#define XB_TOPGEN   3392
#define XCD_BAR_WORDS 3456
#define XB_SPIN_CAP (1u << 22)
__device__ __forceinline__ unsigned xb_ld(unsigned* p)              { return __hip_atomic_load(p, __ATOMIC_RELAXED, __HIP_MEMORY_SCOPE_AGENT); }
__device__ __forceinline__ unsigned xb_add(unsigned* p, unsigned v) { return __hip_atomic_fetch_add(p, v, __ATOMIC_RELAXED, __HIP_MEMORY_SCOPE_AGENT); }
__device__ __forceinline__ unsigned xb_xcc_id() { return (unsigned)__builtin_amdgcn_s_getreg((3 << 11) | 20) & 0xFu; }
#define XB_SPIN(cond, bar) do { unsigned _sp = 0; while (cond) { __builtin_amdgcn_s_sleep(1); \
    if ((++_sp & 255u) == 0u) { if (xb_ld(&(bar)[XB_TMO])) break; if (_sp > XB_SPIN_CAP) { atomicAdd(&(bar)[XB_TMO], 1u); break; } } } } while (0)
__device__ __forceinline__ void xcd_barrier_post(unsigned* bar, unsigned x, volatile LAS unsigned* st) {
    if (threadIdx.x == 0) st[2] = xb_add(&bar[XB_XCNT(x)], 1u);
}
__device__ __forceinline__ void xcd_barrier_complete(unsigned* bar, unsigned x, unsigned& nloc, unsigned& nx) {
    const unsigned G = gridDim.x * gridDim.y * gridDim.z;
    unsigned sum, cnt, mine, sp = 0u;
    for (;;) {
        sum = 0u; cnt = 0u; mine = 0u;
#pragma unroll
        for (unsigned j = 0; j < 16; ++j) { const unsigned c = xb_ld(&bar[XB_XCNT(j)]); sum += c; cnt += (c > 0u) ? 1u : 0u; mine = (j == x) ? c : mine; }
        if (sum == G) break;
        __builtin_amdgcn_s_sleep(1);
        if ((++sp & 255u) == 0u) { if (xb_ld(&bar[XB_TMO])) break; if (sp > XB_SPIN_CAP) { atomicAdd(&bar[XB_TMO], 1u); break; } }
    }
    nloc = mine > 0u ? mine : 1u; nx = cnt > 0u ? cnt : 1u;
}
__device__ __forceinline__ void xcd_barrier(unsigned* bar_, unsigned x_, volatile LAS unsigned* st, bool leader) {
    asm volatile("s_waitcnt vmcnt(0)" ::: "memory");
    __syncthreads();
    if (leader) {
        size_t zo = 0; unsigned x = x_;
        asm volatile("" : "+s"(zo), "+s"(x));
        unsigned* bar = bar_ + zo;
        __builtin_amdgcn_s_waitcnt(0);
        unsigned nloc = st[0], nx = st[1];
        if (nloc == 0u) { xcd_barrier_complete(bar, x, nloc, nx); st[0] = nloc; st[1] = nx; }
        const unsigned old = xb_add(&bar[XB_XSUB(x)], 1u);
        const unsigned gen = old / nloc;
        if (old + 1u == (gen + 1u) * nloc) {
            __builtin_amdgcn_fence(__ATOMIC_RELEASE, "agent");
            asm volatile("s_waitcnt vmcnt(0)" ::: "memory");
            const unsigned og = xb_add(&bar[XB_TOP], 1u);
            const unsigned tg = og / nx;
            if (og + 1u == (tg + 1u) * nx) xb_add(&bar[XB_TOPGEN], 1u);
            else XB_SPIN(xb_ld(&bar[XB_TOPGEN]) == tg, bar);
            __builtin_amdgcn_fence(__ATOMIC_ACQUIRE, "agent");
            xb_add(&bar[XB_XGEN(x)], 1u);
            asm volatile("s_waitcnt vmcnt(0)" ::: "memory");
        } else {
            XB_SPIN(xb_ld(&bar[XB_XGEN(x)]) == gen, bar);
            __builtin_amdgcn_fence(__ATOMIC_ACQUIRE, "agent");
            asm volatile("s_waitcnt vmcnt(0)" ::: "memory");
        }
    }
    __syncthreads();
}

__device__ __forceinline__ int map_identity(int n) { return n; }
__device__ __forceinline__ int map_w13(int n) { const int tile = n >> 8, w = n & 255; return (w < 128) ? tile * 128 + w : FF + tile * 128 + (w - 128); }
__device__ __forceinline__ int map_win(int n) {
    if (n < 640) return n;
    if (n < 768) return n - 640 + 768;
    if (n < 896) return n - 768 + 1024;
    if (n < 1152) return n - 896 + 1304;
    if (n < 1408) return n - 1152 + 1560;
    if (n < 1664) return n - 1408 + 2076;
    if (n < 1920) return n - 1664 + 2332;
    if (n < 2048) return n - 1920 + 640;
    if (n < 2176) return n - 2048 + 896;
    if (n < 2304) return n - 2176 + 1152;
    if (n < 2560) return n - 2304 + 1816;
    if (n < 2816) return n - 2560 + 2588;
    if (n < 2840) return n - 2816 + 1280;
    if (n < 2844) return n - 2840 + 2072;
    return -1;
}
template <int MAP>
__device__ __forceinline__ void transpose_item(const float* W, int K, int Nsrc, int Ndst, bf16_t* WT, float* scr, int item, int lane) {
    const int nblk = Ndst / 64, kb = item / nblk, nb = item % nblk, k0 = 64 * kb, n0 = 64 * nb;
    const int nq = (lane & 15) * 4, nd = n0 + nq;
    const int src = (MAP == 0) ? map_identity(nd) : (MAP == 1) ? map_w13(nd) : map_win(nd);
    f32x4 v[16];
#pragma unroll
    for (int i = 0; i < 16; ++i) { const int kk = 4 * i + (lane >> 4); v[i] = (src >= 0) ? *(const f32x4*)(W + (size_t)(k0 + kk) * Nsrc + src) : (f32x4){0.f, 0.f, 0.f, 0.f}; }
#pragma unroll
    for (int i = 0; i < 16; ++i) { const int kk = 4 * i + (lane >> 4); float* d = scr + kk * 65 + nq; d[0] = v[i][0]; d[1] = v[i][1]; d[2] = v[i][2]; d[3] = v[i][3]; }
    asm volatile("s_waitcnt lgkmcnt(0)" ::: "memory");
    const int cc = lane & 7;
#pragma unroll
    for (int j = 0; j < 8; ++j) { const int n = (lane >> 3) + 8 * j; const float* sp = scr + (8 * cc) * 65 + n;
        u32x4 ov; ov.x = cvtpk(sp[0 * 65], sp[1 * 65]); ov.y = cvtpk(sp[2 * 65], sp[3 * 65]); ov.z = cvtpk(sp[4 * 65], sp[5 * 65]); ov.w = cvtpk(sp[6 * 65], sp[7 * 65]);
        *(u32x4*)(WT + (size_t)(n0 + n) * K + k0 + 8 * cc) = ov; }
    asm volatile("s_waitcnt lgkmcnt(0)" ::: "memory");
}
__device__ __forceinline__ void sincos_acc(float ang, float& sn, float& cs) {
    const double a = (double)ang;
    const double k = __builtin_rint(a * 0.15915494309189535);
    const double r = (a - k * 6.283185307179586) * 0.25;
    const double r2 = r * r;
    double s = r * (1.0 + r2 * (-1.0 / 6 + r2 * (1.0 / 120 + r2 * (-1.0 / 5040 + r2 * (1.0 / 362880 + r2 * (-1.0 / 39916800 + r2 * (1.0 / 6227020800.0)))))));
    double c = 1.0 + r2 * (-0.5 + r2 * (1.0 / 24 + r2 * (-1.0 / 720 + r2 * (1.0 / 40320 + r2 * (-1.0 / 3628800 + r2 * (1.0 / 479001600.0))))));
    double s2 = 2.0 * s * c, c2 = c * c - s * s;
    double s4 = 2.0 * s2 * c2, c4 = c2 * c2 - s2 * s2;
    sn = (float)s4; cs = (float)c4;
}

struct Params {
    const float* x; const float* c; const int* positions; const float* norm_g; const float* w_ada; const float* b_ada; const float* w_in; const float* fox_fbias;
    const float* cmp_pos; const float* cmp_w1; const float* cmp_w2; const float* w_out; const float* ffn_w13; const float* ffn_w2; const float* final_g;
    float* out; unsigned char* ws;
};

__device__ __forceinline__ void prologue(const Params& P, unsigned char* lds, int tid, int lane, int wave, int G) {
    unsigned char* ws = P.ws;
    float* cact = (float*)lds;
    float* part = (float*)(lds + 65536);
    for (int i = tid; i < NB * DM; i += 512) { const float v = P.c[i]; cact[i] = v / (1.0f + __expf(-v)); }
    __syncthreads();
    float* MOD = (float*)(ws + WS_MOD);
    for (int item = blockIdx.x; item < DEPTH * 64; item += G) {
        const int l = item >> 6, jb = (item & 63) * 144, j0 = jb + 4 * lane;
        const bool act = lane < 36;
        const float* wp = P.w_ada + (size_t)l * DM * NADA + (act ? j0 : jb);
        f32x4 acc4[16];
#pragma unroll
        for (int b = 0; b < 16; ++b) acc4[b] = (f32x4){0.f, 0.f, 0.f, 0.f};
        const int kbeg = wave * 128;
#pragma unroll 4
        for (int k = kbeg; k < kbeg + 128; ++k) {
            const f32x4 w = *(const f32x4*)(wp + (size_t)k * NADA);
#pragma unroll
            for (int b = 0; b < 16; ++b) acc4[b] += w * cact[b * DM + k];
        }
        if (act) {
#pragma unroll
            for (int b = 0; b < 16; ++b) *(f32x4*)(part + (wave * 16 + b) * 144 + 4 * lane) = acc4[b];
        }
        __syncthreads();
        for (int o = tid; o < 16 * 144; o += 512) {
            const int b = o / 144, col = o % 144;
            float sm = 0.f;
#pragma unroll
            for (int w = 0; w < 8; ++w) sm += part[(w * 16 + b) * 144 + col];
            const int j = jb + col;
            MOD[((size_t)l * NB + b) * NADA + j] = sm + P.b_ada[(size_t)l * NADA + j];
        }
        __syncthreads();
    }
    float* scr = (float*)(lds + wave * 16640);
    const int gw = blockIdx.x * NWAVES + wave, NGW = G * NWAVES;
    constexpr int I_WIN = 16 * 48, I_WOUT = 16 * 16, I_CW1 = 32 * 4, I_W13 = 16 * 88, I_W2 = 44 * 16, I_CW2 = 4 * 1;
    constexpr int T_WIN = 4 * I_WIN, T_WOUT = 4 * I_WOUT, T_CW1 = 8 * I_CW1, T_W13 = 8 * I_W13, T_W2 = 8 * I_W2, T_CW2 = 8 * I_CW2;
    constexpr int NITEMS = T_WIN + T_WOUT + T_CW1 + T_W13 + T_W2 + T_CW2;
    for (int it = gw; it < NITEMS; it += NGW) {
        int r = it;
        if (r < T_W13) { const int q = r / I_W13; transpose_item<1>(P.ffn_w13 + (size_t)q * DM * 2 * FF, DM, 2 * FF, 2 * FF, (bf16_t*)(ws + WS_W13) + (size_t)q * 2 * FF * DM, scr, r % I_W13, lane); continue; } r -= T_W13;
        if (r < T_W2) { const int q = r / I_W2; transpose_item<0>(P.ffn_w2 + (size_t)q * FF * DM, FF, DM, DM, (bf16_t*)(ws + WS_W2) + (size_t)q * DM * FF, scr, r % I_W2, lane); continue; } r -= T_W2;
        if (r < T_WIN) { const int q = r / I_WIN; transpose_item<2>(P.w_in + (size_t)q * DM * 2844, DM, 2844, NIN, (bf16_t*)(ws + WS_WIN) + (size_t)q * NIN * DM, scr, r % I_WIN, lane); continue; } r -= T_WIN;
        if (r < T_WOUT) { const int q = r / I_WOUT; transpose_item<0>(P.w_out + (size_t)q * DM * DM, DM, DM, DM, (bf16_t*)(ws + WS_WOUT) + (size_t)q * DM * DM, scr, r % I_WOUT, lane); continue; } r -= T_WOUT;
        if (r < T_CW1) { const int q = r / I_CW1; transpose_item<0>(P.cmp_w1 + (size_t)q * 2048 * 256, 2048, 256, 256, (bf16_t*)(ws + WS_CW1) + (size_t)q * 256 * 2048, scr, r % I_CW1, lane); continue; } r -= T_CW1;
        { const int q = r / I_CW2; transpose_item<0>(P.cmp_w2 + (size_t)q * 256 * 64, 256, 64, 64, (bf16_t*)(ws + WS_CW2T) + (size_t)q * 64 * 256, scr, r % I_CW2, lane); }
    }
    {
        float* cosT = (float*)(ws + WS_COS); float* sinT = (float*)(ws + WS_SIN);
        for (int e = blockIdx.x * 512 + tid; e < NTOK * 8; e += G * 512) {
            const int i = e & 7;
            const float inv = (i == 0) ? 1.0f : (i == 1) ? 0.1939227432012558f : (i == 2) ? 0.03760603070259094f : (i == 3) ? 0.007292664609849453f :
                              (i == 4) ? 0.0014142135623842478f : (i == 5) ? 0.00027424818836152554f : (i == 6) ? 5.318296098266728e-05f : 1.0313386155758053e-05f;
            const float ang = (float)P.positions[e >> 3] * inv;
            float sn, cs; sincos_acc(ang, sn, cs);
            cosT[e] = cs; sinT[e] = sn;
        }
    }
}

__device__ __forceinline__ void norm_phase(const float* xin, const float* g, const float* mod  , bf16_t* H, int lane, int wave, int G) {
    const int gw = blockIdx.x * NWAVES + wave, NGW = G * NWAVES;
    const f32x4* gr = (const f32x4*)g + lane;
    f32x4 gg[4];
#pragma unroll
    for (int j = 0; j < 4; ++j) gg[j] = gr[64 * j];
    f32x4 v[4], sh[4], sc[4];
    int row = gw;
    if (row < NTOK) {
        const int b = row >> 11;
        const f32x4* xr = (const f32x4*)(xin + (size_t)row * DM) + lane;
        const f32x4* shp = (const f32x4*)(mod + (size_t)b * NADA) + lane;
#pragma unroll
        for (int j = 0; j < 4; ++j) { v[j] = xr[64 * j]; sh[j] = shp[64 * j]; sc[j] = shp[256 + 64 * j]; }
    }
    for (; row < NTOK; row += NGW) {
        const int nrow = row + NGW;
        f32x4 vn[4], shn[4], scn[4];
        if (nrow < NTOK) {
            const int b = nrow >> 11;
            const f32x4* xr = (const f32x4*)(xin + (size_t)nrow * DM) + lane;
            const f32x4* shp = (const f32x4*)(mod + (size_t)b * NADA) + lane;
#pragma unroll
            for (int j = 0; j < 4; ++j) { vn[j] = xr[64 * j]; shn[j] = shp[64 * j]; scn[j] = shp[256 + 64 * j]; }
        }
        float s = 0.f;
#pragma unroll
        for (int j = 0; j < 4; ++j) s += (v[j].x * v[j].x + v[j].y * v[j].y) + (v[j].z * v[j].z + v[j].w * v[j].w);
        const float rstd = 1.0f / sqrtf(wave_sum(s) * (1.0f / DM) + 1e-6f);
        u32x2* o8 = (u32x2*)(H + (size_t)row * DM) + lane;
#pragma unroll
        for (int j = 0; j < 4; ++j) {
            const f32x4 y = v[j] * rstd * gg[j] * (sc[j] + 1.0f) + sh[j];
            u32x2 w; w.x = cvtpk(y.x, y.y); w.y = cvtpk(y.z, y.w);
            o8[64 * j] = w;
        }
#pragma unroll
        for (int j = 0; j < 4; ++j) { v[j] = vn[j]; sh[j] = shn[j]; sc[j] = scn[j]; }
    }
}
__device__ __forceinline__ void final_norm(float* x, const float* g, int lane, int wave, int G) {
    const int gw = blockIdx.x * NWAVES + wave, NGW = G * NWAVES;
    for (int row = gw; row < NTOK; row += NGW) {
        f32x4* xr = (f32x4*)(x + (size_t)row * DM) + lane;
        f32x4 v[4]; float s = 0.f;
#pragma unroll
        for (int j = 0; j < 4; ++j) { v[j] = xr[64 * j]; s += (v[j].x * v[j].x + v[j].y * v[j].y) + (v[j].z * v[j].z + v[j].w * v[j].w); }
        const float rstd = 1.0f / sqrtf(wave_sum(s) * (1.0f / DM) + 1e-6f);
        const f32x4* gr = (const f32x4*)g + lane;
#pragma unroll
        for (int j = 0; j < 4; ++j) xr[64 * j] = v[j] * rstd * gr[64 * j];
    }
}

__global__ void __launch_bounds__(512, 2) fwd_megakernel(Params P) {
    extern __shared__ __attribute__((aligned(16))) unsigned char lds[];
    cg::grid_group grid = cg::this_grid();
    const int tid = threadIdx.x, lane = tid & 63, wave = __builtin_amdgcn_readfirstlane(tid >> 6), wave0 = wave;
    const int G = gridDim.x;
    unsigned char* ws = P.ws;
    LAS unsigned char* lds3 = (LAS unsigned char*)lds;
    const float* MOD = (const float*)(ws + WS_MOD);
    unsigned* ctl = (unsigned*)(ws + WS_CTL);

    volatile LAS unsigned* bst = (volatile LAS unsigned*)(lds3 + LDS_BYTES - 64);
    if (tid == 0) { bst[0] = 0u; bst[1] = 0u; }
    __syncthreads();
    const unsigned xcc = (unsigned)__builtin_amdgcn_readfirstlane((int)xb_xcc_id());
    xcd_barrier_post(ctl + 65536, xcc, bst);
    const bool leader = (tid == 0);
#define GRID_BAR() xcd_barrier((unsigned*)(P.ws + WS_CTL) + 65536, xcc, bst, leader)
    prologue(P, lds, tid, lane, wave, G);
    if (P.ws == nullptr) grid.sync();
    GRID_BAR();
    if (tid == 0) {
        bool ok = ((G & 7) == 0);
        for (unsigned j = 0; j < 16; ++j) { const unsigned cnt = xb_ld(ctl + 65536 + XB_XCNT(j)); ok = ok && (cnt == ((j < 8u) ? (unsigned)(G >> 3) : 0u)); }
        bst[3] = ok ? (bst[2] * 8u + xcc) : (unsigned)blockIdx.x;
    }
    __syncthreads();
    const int vbid = __builtin_amdgcn_readfirstlane((int)bst[3]);
#ifdef PROBE_SYNC20
    for (int i = 0; i < 20; ++i) GRID_BAR();
#endif
    {
        const int ln = fresh_lane(), wv = wave0;
        for (int it = blockIdx.x * NWAVES + wv; it < 8 * 256; it += G * NWAVES) {
            const int lm = it >> 8;
            const bf16_t* wr_ = (const bf16_t*)(ws + WS_CW1) + (size_t)it * 2048 + ln * 32;
            const float* pp = P.cmp_pos + (size_t)lm * 2048 + ln * 32;
            float a = 0.f;
#pragma unroll
            for (int j = 0; j < 4; ++j) {
                const bf16x8 wv8 = *(const bf16x8*)(wr_ + 8 * j);
                const f32x4 p0 = *(const f32x4*)(pp + 8 * j), p1 = *(const f32x4*)(pp + 8 * j + 4);
#pragma unroll
                for (int i = 0; i < 4; ++i) { a += p0[i] * bf2f(wv8[i]); a += p1[i] * bf2f(wv8[4 + i]); }
            }
            a = wave_sum(a);
            if (ln == 0) ((float*)(ws + WS_B1))[it] = a;
        }
    }

    const float* xin = P.x;
    for (int l = 0; l < DEPTH; ++l) {
        const float* modl = MOD + (size_t)l * NB * NADA;
        for (int sub = 0; sub < 3; ++sub) {
            unsigned char* ws = launder_p(P.ws);
            const int bid = launder_i(vbid);
            const int lane = fresh_lane(), wave = wave0;
            norm_phase(xin, P.norm_g + ((size_t)l * 3 + sub) * DM, modl + (size_t)sub * 3 * DM, (bf16_t*)(ws + WS_H), lane, wave, G);
            GRID_BAR();
            if (sub != 1) {
                const int s = (sub == 0) ? 0 : 1;
                {
                    pg8::Gemm g{(const bf16_t*)(ws + WS_H), (const bf16_t*)(ws + WS_W13) + (size_t)(l * 2 + s) * 2 * FF * DM, NTOK, 2 * FF, DM, DM};
                    pg8::StaticOrder S; S.init(NTOK, 2 * FF, G, bid);
                    EpiSwiglu E{(bf16_t*)(ws + WS_BIG)};
#ifndef NO_G1
                    pg8::gemm_phase<EpiSwiglu, true>(lds3, g, S, E, wave0);
#endif
#ifdef PROBE_G1X2
                    pg8::gemm_phase<EpiSwiglu, true>(lds3, g, S, E, wave0);
#endif
                }
                GRID_BAR();
                {
                    pg8::Gemm g{(const bf16_t*)(ws + WS_BIG), (const bf16_t*)(ws + WS_W2) + (size_t)(l * 2 + s) * DM * FF, NTOK, DM, FF, FF};
                    pg8::StaticOrder S; S.init(NTOK, DM, G, bid);
                    EpiResid E{xin, P.out, modl + (size_t)(sub * 3 + 2) * DM, 0.5f};
#ifndef NO_G2
                    pg8::gemm_phase<EpiResid, true>(lds3, g, S, E, wave0);
#endif
                }
                xin = P.out;
                GRID_BAR();
            } else {
                {
                    pg8::Gemm g{(const bf16_t*)(ws + WS_H), (const bf16_t*)(ws + WS_WIN) + (size_t)l * NIN * DM, NTOK, NIN, DM, DM};
                    pg8::StaticOrder S; S.init(NTOK, NIN, G, bid);
                    EpiInProj E{ws, P.fox_fbias + l * 4};
#ifndef NO_INPROJ
                    pg8::gemm_phase<EpiInProj, true>(lds3, g, S, E, wave0);
#endif
                }
                GRID_BAR();
                if (bid < 32) {
                    const int mat = bid >> 4;
                    pg8::Gemm g{(const bf16_t*)(ws + (mat ? WS_VC : WS_KC)), (const bf16_t*)(ws + WS_CW1) + (size_t)(l * 2 + mat) * 256 * 2048, 4096, 256, 2048, 1024};
                    pg8::StaticOrder S; S.init(4096, 256, 16, bid & 15);
                    EpiGelu E{(bf16_t*)(ws + WS_CMPHID) + (size_t)mat * 4096 * 256, (const float*)(ws + WS_B1) + (l * 2 + mat) * 256};
#ifndef NO_CMP1
                    pg8::gemm_phase<EpiGelu, true>(lds3, g, S, E, wave0);
#endif
                } else {
                    const int nw = (G - 32) * NWAVES;
                    for (int it = (bid - 32) * NWAVES + wave; it < 64 + 512; it += nw) {
                        if (it < 64) {
                            const float* src = (const float*)(ws + WS_FLOG) + (size_t)it * SEQ + lane * 32;
                            float v[32];
#pragma unroll
                            for (int j = 0; j < 8; ++j) { const f32x4 q = *(const f32x4*)(src + 4 * j); v[4 * j] = q.x; v[4 * j + 1] = q.y; v[4 * j + 2] = q.z; v[4 * j + 3] = q.w; }
#pragma unroll
                            for (int j = 1; j < 32; ++j) v[j] += v[j - 1];
                            float tot = v[31], inc = tot;
#pragma unroll
                            for (int o = 1; o < 64; o <<= 1) { const float n = __shfl_up(inc, o); if (lane >= o) inc += n; }
                            const float excl = inc - tot;
                            float* dst = (float*)(ws + WS_FCUM) + (size_t)it * SEQ + lane * 32;
#pragma unroll
                            for (int j = 0; j < 8; ++j) { f32x4 q; q.x = (v[4 * j] + excl) * -8.0f; q.y = (v[4 * j + 1] + excl) * -8.0f; q.z = (v[4 * j + 2] + excl) * -8.0f; q.w = (v[4 * j + 3] + excl) * -8.0f; *(f32x4*)(dst + 4 * j) = q; }
                        } else {
                            const int id = it - 64;
                            const bf16_t* kp = (const bf16_t*)(ws + WS_MOBAK) + (size_t)id * 256 * 64 + (((lane >> 4) * 64 + ((lane >> 3) & 1) * 32) * 8 + (lane & 7));
                            float a = 0.f;
#pragma unroll 8
                            for (int k = 0; k < 256; ++k) a += bf2f((short)kp[(size_t)(k >> 6) * 4096 + (((k >> 5) & 1) * 4 * 64 + (k & 31)) * 8]);
                            ((float*)(ws + WS_KMEAN))[(size_t)id * 64 + lane] = a * (1.0f / 256.0f);
                        }
                    }
                }
                GRID_BAR();
                for (int it = bid * NWAVES + wave; it < 256; it += G * NWAVES) {
                    const int mat = it >> 7, rt = it & 127, hi = lane >> 5, c = lane & 31;
                    const bf16_t* A = (const bf16_t*)(ws + WS_CMPHID) + ((size_t)mat * 4096 + rt * 32 + c) * 256 + 8 * hi;
                    const bf16_t* Bt = (const bf16_t*)(ws + WS_CW2T) + (size_t)(l * 2 + mat) * 64 * 256 + (size_t)c * 256 + 8 * hi;
                    f32x16 a0, a1;
#pragma unroll
                    for (int r = 0; r < 16; ++r) { a0[r] = 0.f; a1[r] = 0.f; }
#pragma unroll 4
                    for (int ks = 0; ks < 16; ++ks) {
                        const bf16x8 af = *(const bf16x8*)(A + 16 * ks);
                        const bf16x8 b0 = *(const bf16x8*)(Bt + 16 * ks), b1 = *(const bf16x8*)(Bt + 32 * 256 + 16 * ks);
                        a0 = MFMA32(af, b0, a0); a1 = MFMA32(af, b1, a1);
                    }
#pragma unroll
                    for (int r = 0; r < 16; ++r) {
                        const int row = rt * 32 + crow(r, hi), rl = row & 127, bg = row >> 7;
                        const float v0 = (rl == 127) ? 0.f : a0[r], v1 = (rl == 127) ? 0.f : a1[r];
                        const bf16_t h0 = (bf16_t)(cvtpk(v0, 0.f) & 0xffffu), h1 = (bf16_t)(cvtpk(v1, 0.f) & 0xffffu);
                        if (mat == 0) {
                            bf16_t* kc = (bf16_t*)(ws + WS_KCMP) + (size_t)bg * 8192 + (rl >> 6) * 4096 + ((((rl >> 5) & 1) * 4) * 64 + (rl & 31)) * 8;
                            const int o0 = ((c >> 4) * 64 + ((c >> 3) & 1) * 32) * 8 + (c & 7);
                            kc[o0] = h0; kc[o0 + 2 * 64 * 8] = h1;
                        } else {
                            const int tt = rl & 63;
                            bf16_t* vc = (bf16_t*)(ws + WS_VCMPT) + (size_t)bg * 8192 + (rl >> 6) * 4096
                                         + ((((tt >> 5) * 2 + ((tt >> 4) & 1)) * 2) * 64 + ((tt >> 2) & 1) * 32 + c) * 8 + ((tt >> 3) & 1) * 4 + (tt & 3);
                            vc[0] = h0; vc[64 * 8] = h1;
                        }
                    }
                }
                GRID_BAR();
                {
#ifdef PROBE_ATTN2
                  for (int rep = 0; rep < 2; ++rep)
#else
                  const int rep = 0;
#endif
                  {
                    float* wl = (float*)(lds + wave * 16384);
                    const int lane_ = lane;
                    const int myq = (int)(__builtin_amdgcn_s_getreg((3 << 11) | 20) & 7u);
                    for (int qi = 0; qi < 8; ++qi) {
                        const int q = (myq + qi) & 7;
                        unsigned* ctr = ctl + 64 * (1 + (l * 2 + rep) * 8 + q);
                        for (;;) {
                            unsigned u = 0;
                            if (lane_ == 0) u = atomicAdd(ctr, 1u);
                            u = (unsigned)__builtin_amdgcn_readfirstlane((int)u);
                            if (u >= 2048u) break;
                            const int lane = launder_v(lane_);
                            if (u < 1024u) {
                                const int pr = (int)(u >> 9), i = (int)(u & 511u), slot = 63 - (i >> 3), w = i & 7;
                                const int bg = 4 * q + 2 * pr + (w >> 2);
                                nsa_unit(ws, bg >> 1, bg & 1, slot * 4 + (w & 3), lane, wl);
                            } else if (u < 1536u) {
                                const int i = (int)(u - 1024u), hf = i >> 8, slot = 63 - ((i & 255) >> 2);
                                fox_unit(ws, 8 * q + 4 * hf + (i & 3), slot, lane);
                            } else {
                                const int i = (int)(u - 1536u), hf = i >> 8, slot = 63 - ((i & 255) >> 2);
                                moba_unit(ws, 8 * q + 4 * hf + (i & 3), slot, lane);
                            }
                        }
                    }
                  }
                }
                GRID_BAR();
                {
                    pg8::Gemm g{(const bf16_t*)(ws + WS_H), (const bf16_t*)(ws + WS_WOUT) + (size_t)l * DM * DM, NTOK, DM, DM, DM};
                    pg8::StaticOrder S; S.init(NTOK, DM, G, bid);
                    EpiResid E{xin, P.out, modl + (size_t)(1 * 3 + 2) * DM, 1.0f};
#ifndef NO_OUTPROJ
                    pg8::gemm_phase<EpiResid, true>(lds3, g, S, E, wave0);
#endif
                }
                GRID_BAR();
            }
        }
    }
    final_norm(P.out, P.final_g, fresh_lane(), wave0, G);
}

extern "C" void kernel_launch(void* const* d_in, const int* in_sizes, int n_in, void* d_out, int out_size, void* d_ws, size_t ws_size, hipStream_t stream) {
    static int grid_blocks = 0;
    if (grid_blocks == 0) {
        if (n_in != 15 || ws_size < WS_END) { fprintf(stderr, "kernel_launch: unexpected inputs (n_in %d, ws %zu)\n", n_in, ws_size); grid_blocks = -1; return; }
        int dev = 0, cus = 0, per_cu = 0;
        hipGetDevice(&dev);
        hipDeviceGetAttribute(&cus, hipDeviceAttributeMultiprocessorCount, dev);
        if (hipFuncSetAttribute((const void*)fwd_megakernel, hipFuncAttributeMaxDynamicSharedMemorySize, LDS_BYTES) != hipSuccess) fprintf(stderr, "kernel_launch: hipFuncSetAttribute failed\n");
        if (hipOccupancyMaxActiveBlocksPerMultiprocessor(&per_cu, (const void*)fwd_megakernel, 512, LDS_BYTES) != hipSuccess || per_cu < 1) { fprintf(stderr, "kernel_launch: occupancy query gave %d\n", per_cu); per_cu = 1; }
        (void)hipGetLastError();
        grid_blocks = cus * per_cu;
        if (grid_blocks > 256) grid_blocks = 256;
    }
    if (grid_blocks < 0) return;
    hipMemsetAsync((char*)d_ws + WS_CTL, 0, 1 * MiB, stream);
    Params p{};
    p.x = (const float*)d_in[0]; p.c = (const float*)d_in[1]; p.positions = (const int*)d_in[2]; p.norm_g = (const float*)d_in[3];
    p.w_ada = (const float*)d_in[4]; p.b_ada = (const float*)d_in[5]; p.w_in = (const float*)d_in[6]; p.fox_fbias = (const float*)d_in[7];
    p.cmp_pos = (const float*)d_in[8]; p.cmp_w1 = (const float*)d_in[9]; p.cmp_w2 = (const float*)d_in[10]; p.w_out = (const float*)d_in[11];
    p.ffn_w13 = (const float*)d_in[12]; p.ffn_w2 = (const float*)d_in[13]; p.final_g = (const float*)d_in[14];
    p.out = (float*)d_out; p.ws = (unsigned char*)d_ws;
    void* args[] = {&p};
    hipError_t e = hipLaunchCooperativeKernel((const void*)fwd_megakernel, dim3(grid_blocks), dim3(512), args, LDS_BYTES, stream);
    if (e != hipSuccess) fprintf(stderr, "kernel_launch: cooperative launch failed: %s (grid %d)\n", hipGetErrorString(e), grid_blocks);
}
```

```cpp
#include <hip/hip_runtime.h>
#include <hip/hip_cooperative_groups.h>
#include <cstdio>
#include <cstdint>
namespace cg = cooperative_groups;

#define LAS __attribute__((address_space(3)))
typedef unsigned short bf16_t;
typedef short bf16x8 __attribute__((ext_vector_type(8)));
typedef short s16x4 __attribute__((ext_vector_type(4)));
typedef float f32x4 __attribute__((ext_vector_type(4)));
typedef float f32x2 __attribute__((ext_vector_type(2)));
typedef float f32x16 __attribute__((ext_vector_type(16)));
typedef unsigned u32x4 __attribute__((ext_vector_type(4)));
typedef unsigned u32x2 __attribute__((ext_vector_type(2)));
typedef __bf16 bf16x2_t __attribute__((ext_vector_type(2)));

constexpr int NB = 16, SEQ = 2048, DM = 1024, NTOK = NB * SEQ, DEPTH = 4, FF = 2816, NIN = 3072, NADA = 9216;
constexpr float LOG2E = 1.4426950408889634f;
constexpr float QK_C2 = 0.125f * LOG2E;
constexpr float NEG_INF = -__builtin_inff();

constexpr size_t MiB = 1u << 20;
constexpr size_t WS_CTL = 0;
constexpr size_t WS_B1 = 4 * MiB;
constexpr size_t WS_MOD = 1 * MiB;
constexpr size_t WS_COS = 5 * MiB, WS_SIN = 6 * MiB;
constexpr size_t WS_CW2T = 7 * MiB;
constexpr size_t WS_WIN = 8 * MiB;
constexpr size_t WS_WOUT = 32 * MiB;
constexpr size_t WS_CW1 = 40 * MiB;
constexpr size_t WS_W13 = 48 * MiB;
constexpr size_t WS_W2 = 136 * MiB;
constexpr size_t WS_H = 180 * MiB;
constexpr size_t WS_BIG = 244 * MiB;
constexpr size_t WS_QNSA = 244 * MiB;
constexpr size_t WS_KC = 276 * MiB;
constexpr size_t WS_VC = 285 * MiB;
constexpr size_t WS_KS = 294 * MiB, WS_KW = 302 * MiB;
constexpr size_t WS_FOXQ = 310 * MiB;
constexpr size_t WS_FOXK = 326 * MiB;
constexpr size_t WS_MOBAQ = 342 * MiB, WS_MOBAK = 358 * MiB;
constexpr size_t WS_VST = 374 * MiB, WS_VWT = 382 * MiB;
constexpr size_t WS_FOXVT = 390 * MiB, WS_MOBAVT = 406 * MiB;
constexpr size_t WS_GATES = 422 * MiB;
constexpr size_t WS_FLOG = 425 * MiB;
constexpr size_t WS_FCUM = 426 * MiB;
constexpr size_t WS_KMEAN = 427 * MiB;
constexpr size_t WS_CMPHID = 428 * MiB;
constexpr size_t WS_KCMP = 432 * MiB;
constexpr size_t WS_VCMPT = 433 * MiB;
constexpr size_t WS_END = 436 * MiB;

constexpr int RING_BYTES = 131072;
constexpr int LDS_BYTES = 147456;
constexpr int NWAVES = 8;

__device__ __forceinline__ unsigned cvtpk(float lo, float hi) { f32x2 v = {lo, hi}; bf16x2_t b = __builtin_convertvector(v, bf16x2_t); return __builtin_bit_cast(unsigned, b); }
__device__ __forceinline__ float bf2f(short s) { return __uint_as_float(((unsigned)(unsigned short)s) << 16); }
__device__ __forceinline__ float fast_exp2(float x) { return __builtin_amdgcn_exp2f(x); }
__device__ __forceinline__ float fast_rcp(float x) { return __builtin_amdgcn_rcpf(x); }
__device__ __forceinline__ float silu_f(float a) { return a * fast_rcp(1.0f + fast_exp2(-a * LOG2E)); }
__device__ __forceinline__ float sigmoid_f(float a) { return 1.0f / (1.0f + __expf(-a)); }
__device__ __forceinline__ float gelu_tanh(float x) {
    const float u = 0.7978845608028654f * (x + 0.044715f * x * x * x);
    const float e = fast_exp2(2.0f * LOG2E * u);
    const float th = 1.0f - 2.0f * fast_rcp(e + 1.0f);
    return 0.5f * x * (1.0f + th);
}
__device__ __forceinline__ float wave_sum(float v) {
#pragma unroll
    for (int o = 1; o < 64; o <<= 1) v += __shfl_xor(v, o);
    return v;
}
__device__ __forceinline__ unsigned char* launder_p(unsigned char* p) { size_t z = 0; asm volatile("" : "+s"(z)); return p + z; }
__device__ __forceinline__ int launder_i(int v) { asm volatile("" : "+s"(v)); return v; }
__device__ __forceinline__ int launder_v(int v) { asm volatile("" : "+v"(v)); return v; }
__device__ __forceinline__ int fresh_lane() { unsigned m = ~0u; asm volatile("" : "+s"(m)); return (int)__builtin_amdgcn_mbcnt_hi(m, __builtin_amdgcn_mbcnt_lo(m, 0u)); }
__device__ __forceinline__ int crow(int r, int hi) { return (r & 3) + 8 * (r >> 2) + 4 * hi; }

namespace pg8 {
constexpr int BM = 256, BK = 64, HALF = 128, HTB = HALF * BK * 2, STAGE_BYTES = 8 * HTB, NXCD = 8, WGM = 8;
__host__ __device__ __forceinline__ int lds_byte(int r, int c) { const int st = (r >> 4) * 2 + (c >> 5), rr = r & 15, cc = c & 31, ob = rr * 64 + cc * 2; return st * 1024 + (ob ^ (((ob >> 9) & 1) << 5)); }
__host__ __device__ __forceinline__ void stage_rc(int b, int& R, int& C) { const int st = b / 1024, sb = b % 1024, swz = sb ^ (((sb >> 9) & 1) << 5); R = (st >> 1) * 16 + swz / 64; C = (st & 1) * 32 + (swz % 64) / 2; }
__host__ __device__ __forceinline__ int perm32(int rho) { const int n = rho >> 4, i = rho & 15; return 8 * (i >> 2) + 4 * n + (i & 3); }

struct Unit { int pm, pn; };
struct Gemm { const bf16_t* A; const bf16_t* Bt; int M, N, K, lda; };

struct StaticOrder {
    int nM, nN, nwg, G, c;
    __device__ void init(int M, int N, int G_, int c_) { nM = M / BM; nN = N / BM; nwg = nM * nN; G = G_; c = c_; }
    __device__ bool next(int i, Unit& u) const {
        const long L = (long)i * G + c; if (L >= nwg) return false;
        int wgid = (int)L; { const int q = nwg / NXCD, r = nwg % NXCD, xcd = wgid % NXCD, off = wgid / NXCD; wgid = (xcd < r ? xcd * (q + 1) : r * (q + 1) + (xcd - r) * q) + off; }
        const int nig = WGM * nN, gid = wgid / nig, fm = gid * WGM, gsz = (nM - fm) < WGM ? (nM - fm) : WGM;
        u.pm = fm + ((wgid % nig) % gsz); u.pn = (wgid % nig) / gsz; return true;
    }
};

template <class Epi, bool ALIGN_EPI>
__device__ __forceinline__ void gemm_phase(LAS unsigned char* lds, const Gemm g, const StaticOrder& S, const Epi& E, int wave0) {
    const int wid = wave0, lane = fresh_lane(), tid = wid * 64 + lane, wr = wid >> 2, wc = wid & 3, fr = lane & 15, fq = lane >> 4;
    const int K = g.K, nt = K / BK, lda = g.lda;
    unsigned voffA[2], voffB[2];
#pragma unroll
    for (int i = 0; i < 2; ++i) { int R, C; stage_rc(tid * 16 + i * 8192, R, C); const int Rb = Epi::PERM ? ((R & ~31) + perm32(R & 31)) : R;
        voffA[i] = (unsigned)(R * lda + C) * 2u; voffB[i] = (unsigned)(Rb * K + C) * 2u; }
    const size_t kstep = (size_t)(BK * 2);
    const size_t hstepA = (size_t)HALF * lda * 2, hstepB = (size_t)HALF * K * 2;
    const size_t tstepA = 2 * hstepA, tstepB = 2 * hstepB;
    const unsigned ldsw = (unsigned)wid * 1024u;
    const int aoff = lds_byte(wr * 64 + fr, fq * 8), boff = lds_byte(wc * 32 + fr, fq * 8);
#define PG8_SA(b, h) (((b) * 2 + (h)) * HTB)
#define PG8_SB(b, h) ((4 + (b) * 2 + (h)) * HTB)
#define PG8_STAGE(bufoff, gbase, voff) do { _Pragma("unroll") for (int _i = 0; _i < 2; ++_i) \
        __builtin_amdgcn_global_load_lds((const unsigned*)((const char*)(gbase) + (voff)[_i]), (LAS unsigned*)(lds + (bufoff) + ldsw + _i * 8192), 16, 0, 0); } while (0)
#define PG8_LDA(dst, b, h) do { _Pragma("unroll") for (int m = 0; m < 4; ++m) _Pragma("unroll") for (int k = 0; k < 2; ++k) dst[m][k] = *(const LAS bf16x8*)(lds + PG8_SA(b, h) + aoff + m * 2048 + k * 1024); } while (0)
#define PG8_LDB(dst, b, h) do { _Pragma("unroll") for (int n = 0; n < 2; ++n) _Pragma("unroll") for (int k = 0; k < 2; ++k) dst[n][k] = *(const LAS bf16x8*)(lds + PG8_SB(b, h) + boff + n * 2048 + k * 1024); } while (0)
#define PG8_MMA(ai, bj, At, Bt) do { __builtin_amdgcn_s_setprio(1); _Pragma("unroll") for (int m = 0; m < 4; ++m) _Pragma("unroll") for (int n = 0; n < 2; ++n) _Pragma("unroll") for (int k = 0; k < 2; ++k) \
        acc[ai][bj][m][n] = __builtin_amdgcn_mfma_f32_16x16x32_bf16(Bt[n][k], At[m][k], acc[ai][bj][m][n], 0, 0, 0); __builtin_amdgcn_s_setprio(0); } while (0)
#define PG8_WAIT_V(n) asm volatile("s_waitcnt vmcnt(" #n ")" ::: "memory")
#define PG8_WAIT_L(n) asm volatile("s_waitcnt lgkmcnt(" #n ")" ::: "memory")
#define PG8_BAR __builtin_amdgcn_s_barrier()
#define PG8_SCHED __builtin_amdgcn_sched_barrier(0)
    Unit cur, nxt; int ui = 0;
    if (!S.next(0, cur)) return;
    f32x4 acc[2][2][4][2];
#pragma unroll
    for (int a = 0; a < 2; ++a)
#pragma unroll
        for (int b = 0; b < 2; ++b)
#pragma unroll
            for (int m = 0; m < 4; ++m)
#pragma unroll
                for (int n = 0; n < 2; ++n) acc[a][b][m][n] = (f32x4){0.f, 0.f, 0.f, 0.f};
    bf16x8 At[4][2], B0[2][2], B1[2][2];
    const char* cA = (const char*)g.A + (size_t)cur.pm * tstepA; const char* cB = (const char*)g.Bt + (size_t)cur.pn * tstepB;
    PG8_STAGE(PG8_SB(0, 0), cB, voffB); PG8_STAGE(PG8_SB(0, 1), cB + hstepB, voffB); PG8_STAGE(PG8_SA(0, 0), cA, voffA); PG8_STAGE(PG8_SA(0, 1), cA + hstepA, voffA);
    if (wr == 1) PG8_BAR;
    PG8_WAIT_V(2); PG8_BAR;
    PG8_STAGE(PG8_SB(1, 0), cB + kstep, voffB); PG8_STAGE(PG8_SA(1, 0), cA + kstep, voffA); PG8_STAGE(PG8_SB(1, 1), cB + hstepB + kstep, voffB);
    PG8_WAIT_V(6); PG8_BAR;
    for (;;) {
        const bool has_next = S.next(ui + 1, nxt);
        const char* nA = has_next ? (const char*)g.A + (size_t)nxt.pm * tstepA : cA; const char* nB = has_next ? (const char*)g.Bt + (size_t)nxt.pn * tstepB : cB;
        for (int t = 0; t < nt; t += 2) {
            const bool last = (t == nt - 2);
            const char* a1 = cA + (size_t)(t + 1) * kstep;
            const char* a2 = last ? nA : cA + (size_t)(t + 2) * kstep; const char* b2 = last ? nB : cB + (size_t)(t + 2) * kstep;
            const char* a3 = a2 + kstep; const char* b3 = b2 + kstep;
            PG8_LDB(B0, 0, 0); PG8_LDB(B1, 0, 1); PG8_SCHED; PG8_LDA(At, 0, 0); PG8_STAGE(PG8_SA(1, 1), a1 + hstepA, voffA);
            PG8_WAIT_V(8); PG8_WAIT_L(0); PG8_BAR; PG8_MMA(0, 0, At, B0); PG8_MMA(0, 1, At, B1); PG8_BAR; PG8_SCHED;
            PG8_LDA(At, 0, 1); PG8_STAGE(PG8_SB(0, 0), b2, voffB); PG8_STAGE(PG8_SB(0, 1), b2 + hstepB, voffB); PG8_STAGE(PG8_SA(0, 0), a2, voffA);
            PG8_WAIT_V(8); PG8_WAIT_L(0); PG8_BAR; PG8_MMA(1, 0, At, B0); PG8_MMA(1, 1, At, B1); PG8_BAR; PG8_SCHED;
            PG8_LDB(B0, 1, 0); PG8_LDB(B1, 1, 1); PG8_SCHED; PG8_LDA(At, 1, 0); PG8_STAGE(PG8_SA(0, 1), a2 + hstepA, voffA);
            PG8_WAIT_V(8); PG8_WAIT_L(0); PG8_BAR; PG8_MMA(0, 0, At, B0); PG8_MMA(0, 1, At, B1); PG8_BAR; PG8_SCHED;
            PG8_LDA(At, 1, 1); PG8_STAGE(PG8_SB(1, 0), b3, voffB); PG8_STAGE(PG8_SB(1, 1), b3 + hstepB, voffB); PG8_STAGE(PG8_SA(1, 0), a3, voffA);
            PG8_WAIT_V(8); PG8_WAIT_L(0); PG8_BAR; PG8_MMA(1, 0, At, B0); PG8_MMA(1, 1, At, B1); PG8_BAR; PG8_SCHED;
        }
        if constexpr (ALIGN_EPI) { if (wr == 0) PG8_BAR; }
        { int efr = fr, efq = fq, ewr = wr, ewc = wc; asm volatile("" : "+v"(efr), "+v"(efq), "+s"(ewr), "+s"(ewc)); E(acc, cur, ewr, ewc, efr, efq); }
        if (!has_next) break;
#pragma unroll
        for (int a = 0; a < 2; ++a)
#pragma unroll
            for (int b = 0; b < 2; ++b)
#pragma unroll
                for (int m = 0; m < 4; ++m)
#pragma unroll
                    for (int n = 0; n < 2; ++n) acc[a][b][m][n] = (f32x4){0.f, 0.f, 0.f, 0.f};
        cur = nxt; cA = nA; cB = nB; ++ui;
        if constexpr (ALIGN_EPI) { if (wr == 1) PG8_BAR; }
    }
    PG8_WAIT_V(0);
    if constexpr (!ALIGN_EPI) { if (wr == 0) PG8_BAR; }
    PG8_BAR;
#undef PG8_SA
#undef PG8_SB
#undef PG8_STAGE
#undef PG8_LDA
#undef PG8_LDB
#undef PG8_MMA
#undef PG8_WAIT_V
#undef PG8_WAIT_L
#undef PG8_BAR
#undef PG8_SCHED
}
}

struct EpiSwiglu {
    static constexpr bool PERM = true;
    bf16_t* O;
    __device__ __forceinline__ void operator()(const f32x4 (&acc)[2][2][4][2], const pg8::Unit& u, int wr, int wc, int fr, int fq) const {
        const int row0 = u.pm * 256 + wr * 64 + fr, col0 = u.pn * 128 + wc * 32 + 8 * fq;
#pragma unroll
        for (int ai = 0; ai < 2; ++ai)
#pragma unroll
            for (int m = 0; m < 4; ++m) {
                bf16_t* rowp = O + (size_t)(row0 + ai * 128 + m * 16) * FF + col0;
                const f32x4 a0 = acc[ai][0][m][0], a1 = acc[ai][0][m][1], b0 = acc[ai][1][m][0], b1 = acc[ai][1][m][1];
                u32x4 w;
                w.x = cvtpk(silu_f(a0[0]) * b0[0], silu_f(a0[1]) * b0[1]); w.y = cvtpk(silu_f(a0[2]) * b0[2], silu_f(a0[3]) * b0[3]);
                w.z = cvtpk(silu_f(a1[0]) * b1[0], silu_f(a1[1]) * b1[1]); w.w = cvtpk(silu_f(a1[2]) * b1[2], silu_f(a1[3]) * b1[3]);
                *(u32x4*)rowp = w;
            }
    }
};
struct EpiResid {
    static constexpr bool PERM = false;
    const float* xin; float* xout; const float* gate; float coef;
    __device__ __forceinline__ void operator()(const f32x4 (&acc)[2][2][4][2], const pg8::Unit& u, int wr, int wc, int fr, int fq) const {
        const int b = (u.pm * 256) >> 11;
        const int row0 = u.pm * 256 + wr * 64 + fr;
#pragma unroll
        for (int bj = 0; bj < 2; ++bj)
#pragma unroll
            for (int n = 0; n < 2; ++n) {
                const int col = u.pn * 256 + bj * 128 + wc * 32 + n * 16 + 4 * fq;
                const f32x4 gv = *(const f32x4*)(gate + (size_t)b * NADA + col) * coef;
                f32x4 xv[2][4];
#pragma unroll
                for (int ai = 0; ai < 2; ++ai)
#pragma unroll
                    for (int m = 0; m < 4; ++m) xv[ai][m] = *(const f32x4*)(xin + (size_t)(row0 + ai * 128 + m * 16) * DM + col);
#pragma unroll
                for (int ai = 0; ai < 2; ++ai)
#pragma unroll
                    for (int m = 0; m < 4; ++m) {
                        const size_t off = (size_t)(row0 + ai * 128 + m * 16) * DM + col;
                        *(f32x4*)(xout + off) = xv[ai][m] + gv * acc[ai][bj][m][n];
                    }
            }
    }
};
struct EpiGelu {
    static constexpr bool PERM = true;
    bf16_t* O; const float* bias;
    __device__ __forceinline__ void operator()(const f32x4 (&acc)[2][2][4][2], const pg8::Unit& u, int wr, int wc, int fr, int fq) const {
        const int row0 = u.pm * 256 + wr * 64 + fr;
#pragma unroll
        for (int bj = 0; bj < 2; ++bj) {
            const int col0 = u.pn * 256 + bj * 128 + wc * 32 + 8 * fq;
            const f32x4 bv0 = *(const f32x4*)(bias + col0), bv1 = *(const f32x4*)(bias + col0 + 4);
#pragma unroll
            for (int ai = 0; ai < 2; ++ai)
#pragma unroll
                for (int m = 0; m < 4; ++m) {
                    const f32x4 v0 = acc[ai][bj][m][0] + bv0, v1 = acc[ai][bj][m][1] + bv1;
                    u32x4 w;
                    w.x = cvtpk(gelu_tanh(v0[0]), gelu_tanh(v0[1])); w.y = cvtpk(gelu_tanh(v0[2]), gelu_tanh(v0[3]));
                    w.z = cvtpk(gelu_tanh(v1[0]), gelu_tanh(v1[1])); w.w = cvtpk(gelu_tanh(v1[2]), gelu_tanh(v1[3]));
                    *(u32x4*)(O + (size_t)(row0 + ai * 128 + m * 16) * 256 + col0) = w;
                }
        }
    }
};
struct EpiInProj {
    static constexpr bool PERM = true;
    unsigned char* ws; const float* fbias;
    __device__ __forceinline__ void operator()(const f32x4 (&acc)[2][2][4][2], const pg8::Unit& u, int wr, int wc, int fr, int fq) const {
        part<0>(acc, u, wr, wc, fr, fq); part<1>(acc, u, wr, wc, fr, fq);
    }
    template <int bj>
    __device__ __forceinline__ void part(const f32x4 (&acc)[2][2][4][2], const pg8::Unit& u, int wr, int wc, int fr, int fq) const {
        const float* cosT = (const float*)(ws + WS_COS); const float* sinT = (const float*)(ws + WS_SIN);
        {
            const int cb = u.pn * 256 + bj * 128 + wc * 32;
            const int hg = cb >> 6, half = (cb >> 5) & 1;
            if (hg > 44) return;
            int mode, NH = 1, hd = 0, pitch = 0; bool rope = false; bf16_t* base = nullptr;
            if (hg < 8)       { mode = 0; base = (bf16_t*)(ws + WS_QNSA); pitch = 512; hd = hg; rope = true; }
            else if (hg < 10) { mode = 1; base = (bf16_t*)(ws + WS_KC); NH = 2; hd = hg - 8; rope = true; }
            else if (hg < 12) { mode = 4; base = (bf16_t*)(ws + WS_KS); NH = 2; hd = hg - 10; rope = true; }
            else if (hg < 14) { mode = 4; base = (bf16_t*)(ws + WS_KW); NH = 2; hd = hg - 12; rope = true; }
            else if (hg < 18) { mode = 0; base = (bf16_t*)(ws + WS_FOXQ); pitch = 256; hd = hg - 14; }
            else if (hg < 22) { mode = 4; base = (bf16_t*)(ws + WS_FOXK); NH = 4; hd = hg - 18; }
            else if (hg < 26) { mode = 0; base = (bf16_t*)(ws + WS_MOBAQ); pitch = 256; hd = hg - 22; rope = true; }
            else if (hg < 30) { mode = 4; base = (bf16_t*)(ws + WS_MOBAK); NH = 4; hd = hg - 26; rope = true; }
            else if (hg < 32) { mode = 1; base = (bf16_t*)(ws + WS_VC); NH = 2; hd = hg - 30; }
            else if (hg < 34) { mode = 2; base = (bf16_t*)(ws + WS_VST); NH = 2; hd = hg - 32; }
            else if (hg < 36) { mode = 2; base = (bf16_t*)(ws + WS_VWT); NH = 2; hd = hg - 34; }
            else if (hg < 40) { mode = 2; base = (bf16_t*)(ws + WS_FOXVT); NH = 4; hd = hg - 36; }
            else if (hg < 44) { mode = 2; base = (bf16_t*)(ws + WS_MOBAVT); NH = 4; hd = hg - 40; }
            else { mode = 3; if (half) return; }
            const bool do_rope = rope && (half == 0);
#pragma unroll
            for (int ai = 0; ai < 2; ++ai) {
                f32x4 rc[4][4];
                if (do_rope && fq < 2) {
#pragma unroll
                    for (int m = 0; m < 4; ++m) {
                        const size_t ro = (size_t)(u.pm * 256 + ai * 128 + wr * 64 + m * 16 + fr) * 8;
                        rc[m][0] = *(const f32x4*)(cosT + ro); rc[m][1] = *(const f32x4*)(cosT + ro + 4);
                        rc[m][2] = *(const f32x4*)(sinT + ro); rc[m][3] = *(const f32x4*)(sinT + ro + 4);
                    }
                }
#pragma unroll
                for (int m = 0; m < 4; ++m) {
                    const int row = u.pm * 256 + ai * 128 + wr * 64 + m * 16 + fr;
                    const int b = row >> 11, t = row & 2047;
                    float v[8];
#pragma unroll
                    for (int i = 0; i < 4; ++i) { v[i] = acc[ai][bj][m][0][i]; v[4 + i] = acc[ai][bj][m][1][i]; }
                    if (do_rope) {
                        float pr[8];
#pragma unroll
                        for (int i = 0; i < 8; ++i) pr[i] = __shfl_xor(v[i], 16);
                        if (fq < 2) {
                            const f32x4 c0 = rc[m][0], c1 = rc[m][1], s0 = rc[m][2], s1 = rc[m][3];
                            const float sg = (fq == 0) ? -1.0f : 1.0f;
#pragma unroll
                            for (int i = 0; i < 4; ++i) { v[i] = v[i] * c0[i] + sg * pr[i] * s0[i]; v[4 + i] = v[4 + i] * c1[i] + sg * pr[4 + i] * s1[i]; }
                        }
                    }
                    if (mode == 3) {
                        float* gates = (float*)(ws + WS_GATES); float* flog = (float*)(ws + WS_FLOG);
                        if (fq < 3) {
                            f32x4 g0, g1;
#pragma unroll
                            for (int i = 0; i < 4; ++i) { g0[i] = sigmoid_f(v[i]); g1[i] = sigmoid_f(v[4 + i]); }
                            *(f32x4*)(gates + (size_t)row * 24 + 8 * fq) = g0; *(f32x4*)(gates + (size_t)row * 24 + 8 * fq + 4) = g1;
                        } else {
#pragma unroll
                            for (int i = 0; i < 4; ++i) {
                                const float z = v[i] + fbias[i];
                                const float ls = (z > 0.f) ? -log1pf(__expf(-z)) : (z - log1pf(__expf(z)));
                                flog[(size_t)(b * 4 + i) * SEQ + t] = ls;
                            }
                        }
                    } else {
                        u32x4 w; w.x = cvtpk(v[0], v[1]); w.y = cvtpk(v[2], v[3]); w.z = cvtpk(v[4], v[5]); w.w = cvtpk(v[6], v[7]);
                        const int dcol = half * 32 + 8 * fq;
                        if (mode == 0) *(u32x4*)(base + (size_t)row * pitch + hd * 64 + dcol) = w;
                        else if (mode == 1) *(u32x4*)(base + ((size_t)(b * NH + hd) * SEQ + t) * 64 + dcol) = w;
                        else if (mode == 4) {
                            const int d0 = half * 2 + (fq >> 1), khi = fq & 1;
                            *(u32x4*)(base + (size_t)(b * NH + hd) * SEQ * 64 + (size_t)(t >> 6) * 4096 + ((((t >> 5) & 1) * 4 + d0) * 64 + khi * 32 + (t & 31)) * 8) = w;
                        } else {
                            const int tt = t & 63, hf = tt >> 5, jj = (tt >> 4) & 1, piece = (tt >> 3) & 1, vhi = (tt >> 2) & 1, e = tt & 3;
                            bf16_t* p = base + (size_t)(b * NH + hd) * SEQ * 64 + (size_t)(t >> 6) * 4096 + (((hf * 2 + jj) * 2 + half) * 64 + vhi * 32 + 8 * fq) * 8 + piece * 4 + e;
                            p[0 * 8] = (bf16_t)(w.x & 0xffffu); p[1 * 8] = (bf16_t)(w.x >> 16);
                            p[2 * 8] = (bf16_t)(w.y & 0xffffu); p[3 * 8] = (bf16_t)(w.y >> 16);
                            p[4 * 8] = (bf16_t)(w.z & 0xffffu); p[5 * 8] = (bf16_t)(w.z >> 16);
                            p[6 * 8] = (bf16_t)(w.w & 0xffffu); p[7 * 8] = (bf16_t)(w.w >> 16);
                        }
                    }
                }
            }
        }
    }
};

#define MFMA32(a, b, c) __builtin_amdgcn_mfma_f32_32x32x16_bf16((a), (b), (c), 0, 0, 0)
__device__ __forceinline__ f32x16 qk32(const bf16_t* kp, const bf16x8 (&qf)[4]) {
    f32x16 p;
#pragma unroll
    for (int r = 0; r < 16; ++r) p[r] = 0.f;
#pragma unroll
    for (int d0 = 0; d0 < 4; ++d0) { const bf16x8 kf = *(const bf16x8*)(kp + 16 * d0); p = MFMA32(kf, qf[d0], p); }
    return p;
}
__device__ __forceinline__ void pv32(f32x16 (&o)[2], const bf16_t* vp, int vpitch, const f32x16& p) {
#pragma unroll
    for (int j = 0; j < 2; ++j) {
        u32x4 pw; pw.x = cvtpk(p[8 * j + 0], p[8 * j + 1]); pw.y = cvtpk(p[8 * j + 2], p[8 * j + 3]); pw.z = cvtpk(p[8 * j + 4], p[8 * j + 5]); pw.w = cvtpk(p[8 * j + 6], p[8 * j + 7]);
        const bf16x8 pb = __builtin_bit_cast(bf16x8, pw);
#pragma unroll
        for (int dh = 0; dh < 2; ++dh) {
            const bf16_t* q = vp + (size_t)dh * 32 * vpitch + 16 * j;
            const s16x4 lo = *(const s16x4*)q, hi4 = *(const s16x4*)(q + 8);
            const bf16x8 va = (bf16x8){lo[0], lo[1], lo[2], lo[3], hi4[0], hi4[1], hi4[2], hi4[3]};
            o[dh] = MFMA32(va, pb, o[dh]);
        }
    }
}
__device__ __forceinline__ void load_k64(bf16x8 (&kf)[8], const bf16_t* ktile, int lane) {
    const bf16_t* p = ktile + lane * 8;
#pragma unroll
    for (int i = 0; i < 8; ++i) kf[i] = *(const bf16x8*)(p + i * 512);
}
__device__ __forceinline__ void load_v64(bf16x8 (&vf)[8], const bf16_t* vtile, int lane) {
    const bf16_t* p = vtile + lane * 8;
#pragma unroll
    for (int i = 0; i < 8; ++i) vf[i] = *(const bf16x8*)(p + i * 512);
}
template <int MODE, int MK>
__device__ __forceinline__ void softmax_pv(f32x16 (&o)[2], float& m, float& l, f32x16& p0, f32x16& p1, const bf16x8 (&vf)[8],
                                           int kb, int t, bool tsel, const float* F8, float Fq8, int hi) {
    if (MK == 2) {
#pragma unroll
        for (int r = 0; r < 16; ++r) {
            const int k0 = kb + crow(r, hi), k1 = k0 + 32;
            bool v0, v1;
            if (MODE == 0) { v0 = tsel && (k0 <= t); v1 = tsel && (k1 <= t); }
            else if (MODE == 1) { v0 = (k0 <= t) && (k0 > t - 512); v1 = (k1 <= t) && (k1 > t - 512); }
            else { v0 = (k0 <= t); v1 = (k1 <= t); }
            p0[r] = v0 ? p0[r] : NEG_INF; p1[r] = v1 ? p1[r] : NEG_INF;
        }
    }
    int ia = max(__float_as_int(p0[0]), __float_as_int(p1[0])), ib = max(__float_as_int(p0[1]), __float_as_int(p1[1]));
#pragma unroll
    for (int r = 2; r < 16; r += 2) { ia = max(ia, max(__float_as_int(p0[r]), __float_as_int(p1[r]))); ib = max(ib, max(__float_as_int(p0[r + 1]), __float_as_int(p1[r + 1]))); }
    float mx = __int_as_float(max(max(ia, ib), 0));
    if (MK == 1) mx = tsel ? mx : NEG_INF;
    mx = fmaxf(mx, __shfl_xor(mx, 32));
    const float mnew = fmaxf(m, mx);
    const float msafe = (mnew == NEG_INF) ? 0.f : mnew;
    const float alpha = fast_exp2((m - msafe) * QK_C2);
    float nm = -msafe * QK_C2;
    if (MK == 1) nm = tsel ? nm : NEG_INF;
    float ps = 0.f;
#pragma unroll
    for (int r = 0; r < 16; ++r) { p0[r] = fast_exp2(__builtin_fmaf(p0[r], QK_C2, nm)); p1[r] = fast_exp2(__builtin_fmaf(p1[r], QK_C2, nm)); ps += p0[r] + p1[r]; }
    l = l * alpha + ps; m = mnew;
#pragma unroll
    for (int r = 0; r < 16; ++r) { o[0][r] *= alpha; o[1][r] *= alpha; }
#pragma unroll
    for (int hf = 0; hf < 2; ++hf)
#pragma unroll
        for (int j = 0; j < 2; ++j) {
            const f32x16& p = hf ? p1 : p0;
            u32x4 pw; pw.x = cvtpk(p[8 * j + 0], p[8 * j + 1]); pw.y = cvtpk(p[8 * j + 2], p[8 * j + 3]); pw.z = cvtpk(p[8 * j + 4], p[8 * j + 5]); pw.w = cvtpk(p[8 * j + 6], p[8 * j + 7]);
            const bf16x8 pb = __builtin_bit_cast(bf16x8, pw);
#pragma unroll
            for (int dh = 0; dh < 2; ++dh) o[dh] = MFMA32(vf[(hf * 2 + j) * 2 + dh], pb, o[dh]);
        }
}
template <int MODE, class Sel>
__device__ __forceinline__ void flash_loop(f32x16 (&o)[2], float& m, float& l, const bf16x8 (&qf)[4], const bf16_t* K, const bf16_t* Vt,
                                           int jlo, int jhi, int t, int tmin, int tmax, Sel sel, const float* F8, float Fq8, int lane) {
    const int hi = lane >> 5;
    int j = jlo;
    for (; j <= jhi; ++j) { if (__any(sel(j))) break; }
    bf16x8 kf[8], vf[8];
    if (j <= jhi) load_k64(kf, K + (size_t)j * 4096, lane);
    while (j <= jhi) {
        int jn = j + 1;
        for (; jn <= jhi; ++jn) { if (__any(sel(jn))) break; }
        load_v64(vf, Vt + (size_t)j * 4096, lane);
        f32x16 p0, p1;
        const int kb = j * 64;
        if (MODE == 2) {
#pragma unroll
            for (int g = 0; g < 4; ++g) {
                const f32x4 fa = *(const f32x4*)(F8 + kb + 8 * g + 4 * hi), fbv = *(const f32x4*)(F8 + kb + 32 + 8 * g + 4 * hi);
#pragma unroll
                for (int i = 0; i < 4; ++i) { p0[4 * g + i] = fa[i]; p1[4 * g + i] = fbv[i]; }
            }
        } else {
#pragma unroll
            for (int r = 0; r < 16; ++r) { p0[r] = 0.f; p1[r] = 0.f; }
        }
#pragma unroll
        for (int d0 = 0; d0 < 4; ++d0) { p0 = MFMA32(kf[d0], qf[d0], p0); p1 = MFMA32(kf[4 + d0], qf[d0], p1); }
        if (jn <= jhi) load_k64(kf, K + (size_t)jn * 4096, lane);
        bool full = (kb + 63 <= tmin);
        if (MODE == 1) full = full && (kb > tmax - 512);
        if (full) {
            if (MODE == 0 && !__all(sel(j))) softmax_pv<MODE, 1>(o, m, l, p0, p1, vf, kb, t, sel(j), F8, Fq8, hi);
            else softmax_pv<MODE, 0>(o, m, l, p0, p1, vf, kb, t, true, F8, Fq8, hi);
        } else softmax_pv<MODE, 2>(o, m, l, p0, p1, vf, kb, t, sel(j), F8, Fq8, hi);
        j = jn;
    }
}
__device__ __forceinline__ void load_q(bf16x8 (&qf)[4], const bf16_t* qrow, int hi) {
#pragma unroll
    for (int d0 = 0; d0 < 4; ++d0) qf[d0] = *(const bf16x8*)(qrow + 16 * d0 + 8 * hi);
}
__device__ __forceinline__ void store_o(bf16_t* dst, const f32x16 (&o)[2], int hi) {
#pragma unroll
    for (int dh = 0; dh < 2; ++dh)
#pragma unroll
        for (int g = 0; g < 4; ++g) {
            u32x2 w; w.x = cvtpk(o[dh][4 * g + 0], o[dh][4 * g + 1]); w.y = cvtpk(o[dh][4 * g + 2], o[dh][4 * g + 3]);
            *(u32x2*)(dst + 32 * dh + 8 * g + 4 * hi) = w;
        }
}
__device__ __forceinline__ unsigned nsa_select(const float (&imp)[32], int t) {
    const int tb = t >> 6;
    unsigned sel = 1u | (1u << tb) | (1u << (tb > 0 ? tb - 1 : 0));
#pragma unroll
    for (int it = 0; it < 5; ++it) {
        float bv = NEG_INF; int bj = -1;
#pragma unroll
        for (int j = 1; j < 32; ++j) { const bool cand = (j <= tb - 2) && !((sel >> j) & 1u) && (imp[j] > bv); if (cand) { bv = imp[j]; bj = j; } }
        if (bj >= 0) sel |= 1u << bj;
    }
    if (tb <= 7) sel = (2u << tb) - 1u;
    return sel;
}

__device__ __forceinline__ void nsa_unit(unsigned char* ws, int b, int g, int qg, int lane, float* wl) {
    const int hi = lane >> 5, c = lane & 31;
    const int t = qg * 8 + (c >> 2), head = g * 4 + (c & 3), row = b * SEQ + t, bg = b * 2 + g;
    bf16x8 qf[4];
    load_q(qf, (const bf16_t*)(ws + WS_QNSA) + (size_t)row * 512 + head * 64, hi);
    const float* gp = (const float*)(ws + WS_GATES) + (size_t)row * 24 + head * 3;
    const float g0 = gp[0];
    f32x16 o[2];
    float* oa = wl + 256 + lane;
    {
        const bf16_t* Kc = (const bf16_t*)(ws + WS_KCMP) + (size_t)bg * 8192;
        const bf16_t* Vct = (const bf16_t*)(ws + WS_VCMPT) + (size_t)bg * 8192;
        f32x16 s[4];
        float mx = NEG_INF;
#pragma unroll
        for (int tile = 0; tile < 2; ++tile) {
            bf16x8 kf[8];
            load_k64(kf, Kc + tile * 4096, lane);
#pragma unroll
            for (int hf = 0; hf < 2; ++hf) {
                const int grp = tile * 2 + hf;
#pragma unroll
                for (int r = 0; r < 16; ++r) s[grp][r] = 0.f;
#pragma unroll
                for (int d0 = 0; d0 < 4; ++d0) s[grp] = MFMA32(kf[hf * 4 + d0], qf[d0], s[grp]);
#pragma unroll
                for (int r = 0; r < 16; ++r) {
                    const int key = 32 * grp + crow(r, hi);
                    const float v = (16 * key + 31 <= t) ? s[grp][r] * QK_C2 : NEG_INF;
                    s[grp][r] = v; mx = fmaxf(mx, v);
                }
            }
        }
        mx = fmaxf(mx, __shfl_xor(mx, 32));
        const float msafe = (mx == NEG_INF) ? 0.f : mx;
        float ps = 0.f;
#pragma unroll
        for (int grp = 0; grp < 4; ++grp)
#pragma unroll
            for (int r = 0; r < 16; ++r) { s[grp][r] = fast_exp2(s[grp][r] - msafe); ps += s[grp][r]; }
        ps += __shfl_xor(ps, 32);
        const float inv = 1.0f / fmaxf(ps, 1e-30f);
#pragma unroll
        for (int grp = 0; grp < 4; ++grp)
#pragma unroll
            for (int r = 0; r < 16; ++r) s[grp][r] *= inv;
#pragma unroll
        for (int r = 0; r < 16; ++r) { o[0][r] = 0.f; o[1][r] = 0.f; }
#pragma unroll
        for (int tile = 0; tile < 2; ++tile) {
            bf16x8 vf[8];
            load_v64(vf, Vct + tile * 4096, lane);
#pragma unroll
            for (int hf = 0; hf < 2; ++hf)
#pragma unroll
                for (int j = 0; j < 2; ++j) {
                    const f32x16& p = s[tile * 2 + hf];
                    u32x4 pw; pw.x = cvtpk(p[8 * j + 0], p[8 * j + 1]); pw.y = cvtpk(p[8 * j + 2], p[8 * j + 3]); pw.z = cvtpk(p[8 * j + 4], p[8 * j + 5]); pw.w = cvtpk(p[8 * j + 6], p[8 * j + 7]);
                    const bf16x8 pb = __builtin_bit_cast(bf16x8, pw);
#pragma unroll
                    for (int dh = 0; dh < 2; ++dh) o[dh] = MFMA32(vf[(hf * 2 + j) * 2 + dh], pb, o[dh]);
                }
        }
#pragma unroll
        for (int r = 0; r < 16; ++r) { oa[r * 64] = g0 * o[0][r]; oa[(16 + r) * 64] = g0 * o[1][r]; }
        float recv[4][4];
#pragma unroll
        for (int grp = 0; grp < 4; ++grp)
#pragma unroll
            for (int gq = 0; gq < 4; ++gq) recv[grp][gq] = __shfl_xor(s[grp][4 * gq + 3], 32);
#pragma unroll
        for (int grp = 0; grp < 4; ++grp)
#pragma unroll
            for (int gq = 0; gq < 4; ++gq) {
                const float own = (s[grp][4 * gq] + s[grp][4 * gq + 1]) + (s[grp][4 * gq + 2] + s[grp][4 * gq + 3]);
                const float plo = (gq > 0) ? recv[grp][gq > 0 ? gq - 1 : 0] : ((grp > 0) ? recv[grp > 0 ? grp - 1 : 0][3] : 0.f);
                const float prev = hi ? recv[grp][gq] : plo;
                float v = own + prev;
                v += __shfl_xor(v, 1); v += __shfl_xor(v, 2);
                if ((c & 3) == 0) wl[(c >> 2) * 32 + 8 * grp + 2 * gq + hi] = v;
            }
    }
    asm volatile("s_waitcnt lgkmcnt(0)" ::: "memory");
    float imp[32];
#pragma unroll
    for (int j4 = 0; j4 < 8; ++j4) { const f32x4 v = *(const f32x4*)(wl + (c >> 2) * 32 + 4 * j4); imp[4 * j4] = v[0]; imp[4 * j4 + 1] = v[1]; imp[4 * j4 + 2] = v[2]; imp[4 * j4 + 3] = v[3]; }
    asm volatile("s_waitcnt lgkmcnt(0)" ::: "memory");
    const unsigned sel = nsa_select(imp, t);
    const int jmax = (qg * 8 + 7) >> 6;
    {
        const bf16_t* Ks = (const bf16_t*)(ws + WS_KS) + (size_t)bg * SEQ * 64;
        const bf16_t* Vst = (const bf16_t*)(ws + WS_VST) + (size_t)bg * 64 * SEQ;
        float m = NEG_INF, l = 0.f;
#pragma unroll
        for (int r = 0; r < 16; ++r) { o[0][r] = 0.f; o[1][r] = 0.f; }
        flash_loop<0>(o, m, l, qf, Ks, Vst, 0, jmax, t, qg * 8, qg * 8 + 7, [&](int j) { return (bool)((sel >> j) & 1u); }, nullptr, 0.f, lane);
        l += __shfl_xor(l, 32);
        const float sc = gp[1] / fmaxf(l, 1e-30f);
#pragma unroll
        for (int r = 0; r < 16; ++r) { oa[r * 64] += sc * o[0][r]; oa[(16 + r) * 64] += sc * o[1][r]; }
        asm volatile("s_waitcnt lgkmcnt(0)" ::: "memory");
    }
    {
        const bf16_t* Kw = (const bf16_t*)(ws + WS_KW) + (size_t)bg * SEQ * 64;
        const bf16_t* Vwt = (const bf16_t*)(ws + WS_VWT) + (size_t)bg * 64 * SEQ;
        float m = NEG_INF, l = 0.f;
#pragma unroll
        for (int r = 0; r < 16; ++r) { o[0][r] = 0.f; o[1][r] = 0.f; }
        const int tl = qg * 8 - 511;
        const int jlo = (tl > 0 ? tl : 0) >> 6;
        flash_loop<1>(o, m, l, qf, Kw, Vwt, jlo, jmax, t, qg * 8, qg * 8 + 7, [&](int) { return true; }, nullptr, 0.f, lane);
        l += __shfl_xor(l, 32);
        const float sc = gp[2] / fmaxf(l, 1e-30f);
#pragma unroll
        for (int r = 0; r < 16; ++r) { o[0][r] = oa[r * 64] + sc * o[0][r]; o[1][r] = oa[(16 + r) * 64] + sc * o[1][r]; }
        asm volatile("s_waitcnt lgkmcnt(0)" ::: "memory");
    }
    store_o((bf16_t*)(ws + WS_H) + (size_t)row * DM + head * 64, o, hi);
}

__device__ __forceinline__ void fox_unit(unsigned char* ws, int bh, int qt, int lane) {
    const int hi = lane >> 5, c = lane & 31, b = bh >> 2, h = bh & 3;
    const int t = qt * 32 + c, row = b * SEQ + t;
    bf16x8 qf[4];
    load_q(qf, (const bf16_t*)(ws + WS_FOXQ) + (size_t)row * 256 + h * 64, hi);
    const bf16_t* K = (const bf16_t*)(ws + WS_FOXK) + (size_t)bh * SEQ * 64;
    const bf16_t* Vt = (const bf16_t*)(ws + WS_FOXVT) + (size_t)bh * 64 * SEQ;
    const float* F2 = (const float*)(ws + WS_FCUM) + (size_t)bh * SEQ;
    const float Fq2 = F2[t];
    f32x16 o[2]; float m = NEG_INF, l = 0.f;
#pragma unroll
    for (int r = 0; r < 16; ++r) { o[0][r] = 0.f; o[1][r] = 0.f; }
    const int jmax = (qt * 32 + 31) >> 6;
    flash_loop<2>(o, m, l, qf, K, Vt, 0, jmax, t, qt * 32, qt * 32 + 31, [&](int) { return true; }, F2, Fq2, lane);
    l += __shfl_xor(l, 32);
    const float sc = 1.0f / fmaxf(l, 1e-30f);
#pragma unroll
    for (int r = 0; r < 16; ++r) { o[0][r] *= sc; o[1][r] *= sc; }
    store_o((bf16_t*)(ws + WS_H) + (size_t)row * DM + 512 + h * 64, o, hi);
}

__device__ __forceinline__ void moba_unit(unsigned char* ws, int bh, int qt, int lane) {
    const int hi = lane >> 5, c = lane & 31, b = bh >> 2, h = bh & 3;
    const int t = qt * 32 + c, row = b * SEQ + t;
    bf16x8 qf[4];
    load_q(qf, (const bf16_t*)(ws + WS_MOBAQ) + (size_t)row * 256 + h * 64, hi);
    const bf16_t* K = (const bf16_t*)(ws + WS_MOBAK) + (size_t)bh * SEQ * 64;
    const bf16_t* Vt = (const bf16_t*)(ws + WS_MOBAVT) + (size_t)bh * 64 * SEQ;
    const int own = (qt * 32) >> 8;
    unsigned sel = 0u;
    {
        float gt[7];
        const float* km = (const float*)(ws + WS_KMEAN) + (size_t)bh * 8 * 64;
#pragma unroll
        for (int blk = 0; blk < 7; ++blk) {
            float a = 0.f;
            if (blk < own) {
#pragma unroll
                for (int d0 = 0; d0 < 4; ++d0) {
                    const f32x4 k0 = *(const f32x4*)(km + blk * 64 + 16 * d0 + 8 * hi), k1 = *(const f32x4*)(km + blk * 64 + 16 * d0 + 8 * hi + 4);
#pragma unroll
                    for (int i = 0; i < 4; ++i) { a += bf2f(qf[d0][i]) * k0[i]; a += bf2f(qf[d0][4 + i]) * k1[i]; }
                }
                a += __shfl_xor(a, 32);
            }
            gt[blk] = a;
        }
#pragma unroll
        for (int it = 0; it < 3; ++it) {
            float bv = NEG_INF; int bj = -1;
#pragma unroll
            for (int blk = 0; blk < 7; ++blk) { const bool cand = (blk < own) && !((sel >> blk) & 1u) && (gt[blk] > bv); if (cand) { bv = gt[blk]; bj = blk; } }
            if (bj >= 0) sel |= 1u << bj;
        }
    }
    f32x16 o[2]; float m = NEG_INF, l = 0.f;
#pragma unroll
    for (int r = 0; r < 16; ++r) { o[0][r] = 0.f; o[1][r] = 0.f; }
    const int jmax = (qt * 32 + 31) >> 6;
    flash_loop<0>(o, m, l, qf, K, Vt, 0, jmax, t, qt * 32, qt * 32 + 31, [&](int j) { const int blk = j >> 2; return (blk == own) || (bool)((sel >> blk) & 1u); }, nullptr, 0.f, lane);
    l += __shfl_xor(l, 32);
    const float sc = 1.0f / fmaxf(l, 1e-30f);
#pragma unroll
    for (int r = 0; r < 16; ++r) { o[0][r] *= sc; o[1][r] *= sc; }
    store_o((bf16_t*)(ws + WS_H) + (size_t)row * DM + 768 + h * 64, o, hi);
}


#define XB_TMO      128
#define XB_XCNT(j)  (256  + 64 * (j))
#define XB_XSUB(j)  (1280 + 64 * (j))
#define XB_XGEN(j)  (2304 + 64 * (j))
#define XB_TOP      3328
#define XB_TOPGEN   3392
#define XCD_BAR_WORDS 3456
#define XB_SPIN_CAP (1u << 22)
__device__ __forceinline__ unsigned xb_ld(unsigned* p)              { return __hip_atomic_load(p, __ATOMIC_RELAXED, __HIP_MEMORY_SCOPE_AGENT); }
__device__ __forceinline__ unsigned xb_add(unsigned* p, unsigned v) { return __hip_atomic_fetch_add(p, v, __ATOMIC_RELAXED, __HIP_MEMORY_SCOPE_AGENT); }
__device__ __forceinline__ unsigned xb_xcc_id() { return (unsigned)__builtin_amdgcn_s_getreg((3 << 11) | 20) & 0xFu; }
#define XB_SPIN(cond, bar) do { unsigned _sp = 0; while (cond) { __builtin_amdgcn_s_sleep(1); \
    if ((++_sp & 255u) == 0u) { if (xb_ld(&(bar)[XB_TMO])) break; if (_sp > XB_SPIN_CAP) { atomicAdd(&(bar)[XB_TMO], 1u); break; } } } } while (0)
__device__ __forceinline__ void xcd_barrier_post(unsigned* bar, unsigned x, volatile LAS unsigned* st) {
    if (threadIdx.x == 0) st[2] = xb_add(&bar[XB_XCNT(x)], 1u);
}
__device__ __forceinline__ void xcd_barrier_complete(unsigned* bar, unsigned x, unsigned& nloc, unsigned& nx) {
    const unsigned G = gridDim.x * gridDim.y * gridDim.z;
    unsigned sum, cnt, mine, sp = 0u;
    for (;;) {
        sum = 0u; cnt = 0u; mine = 0u;
#pragma unroll
        for (unsigned j = 0; j < 16; ++j) { const unsigned c = xb_ld(&bar[XB_XCNT(j)]); sum += c; cnt += (c > 0u) ? 1u : 0u; mine = (j == x) ? c : mine; }
        if (sum == G) break;
        __builtin_amdgcn_s_sleep(1);
        if ((++sp & 255u) == 0u) { if (xb_ld(&bar[XB_TMO])) break; if (sp > XB_SPIN_CAP) { atomicAdd(&bar[XB_TMO], 1u); break; } }
    }
    nloc = mine > 0u ? mine : 1u; nx = cnt > 0u ? cnt : 1u;
}
__device__ __forceinline__ void xcd_barrier(unsigned* bar_, unsigned x_, volatile LAS unsigned* st, bool leader) {
    asm volatile("s_waitcnt vmcnt(0)" ::: "memory");
    __syncthreads();
    if (leader) {
        size_t zo = 0; unsigned x = x_;
        asm volatile("" : "+s"(zo), "+s"(x));
        unsigned* bar = bar_ + zo;
        __builtin_amdgcn_s_waitcnt(0);
        unsigned nloc = st[0], nx = st[1];
        if (nloc == 0u) { xcd_barrier_complete(bar, x, nloc, nx); st[0] = nloc; st[1] = nx; }
        const unsigned old = xb_add(&bar[XB_XSUB(x)], 1u);
        const unsigned gen = old / nloc;
        if (old + 1u == (gen + 1u) * nloc) {
            __builtin_amdgcn_fence(__ATOMIC_RELEASE, "agent");
            asm volatile("s_waitcnt vmcnt(0)" ::: "memory");
            const unsigned og = xb_add(&bar[XB_TOP], 1u);
            const unsigned tg = og / nx;
            if (og + 1u == (tg + 1u) * nx) xb_add(&bar[XB_TOPGEN], 1u);
            else XB_SPIN(xb_ld(&bar[XB_TOPGEN]) == tg, bar);
            __builtin_amdgcn_fence(__ATOMIC_ACQUIRE, "agent");
            xb_add(&bar[XB_XGEN(x)], 1u);
            asm volatile("s_waitcnt vmcnt(0)" ::: "memory");
        } else {
            XB_SPIN(xb_ld(&bar[XB_XGEN(x)]) == gen, bar);
            __builtin_amdgcn_fence(__ATOMIC_ACQUIRE, "agent");
            asm volatile("s_waitcnt vmcnt(0)" ::: "memory");
        }
    }
    __syncthreads();
}

__device__ __forceinline__ int map_identity(int n) { return n; }
__device__ __forceinline__ int map_w13(int n) { const int tile = n >> 8, w = n & 255; return (w < 128) ? tile * 128 + w : FF + tile * 128 + (w - 128); }
__device__ __forceinline__ int map_win(int n) {
    if (n < 640) return n;
    if (n < 768) return n - 640 + 768;
    if (n < 896) return n - 768 + 1024;
    if (n < 1152) return n - 896 + 1304;
    if (n < 1408) return n - 1152 + 1560;
    if (n < 1664) return n - 1408 + 2076;
    if (n < 1920) return n - 1664 + 2332;
    if (n < 2048) return n - 1920 + 640;
    if (n < 2176) return n - 2048 + 896;
    if (n < 2304) return n - 2176 + 1152;
    if (n < 2560) return n - 2304 + 1816;
    if (n < 2816) return n - 2560 + 2588;
    if (n < 2840) return n - 2816 + 1280;
    if (n < 2844) return n - 2840 + 2072;
    return -1;
}
template <int MAP>
__device__ __forceinline__ void transpose_item(const float* W, int K, int Nsrc, int Ndst, bf16_t* WT, float* scr, int item, int lane) {
    const int nblk = Ndst / 64, kb = item / nblk, nb = item % nblk, k0 = 64 * kb, n0 = 64 * nb;
    const int nq = (lane & 15) * 4, nd = n0 + nq;
    const int src = (MAP == 0) ? map_identity(nd) : (MAP == 1) ? map_w13(nd) : map_win(nd);
    f32x4 v[16];
#pragma unroll
    for (int i = 0; i < 16; ++i) { const int kk = 4 * i + (lane >> 4); v[i] = (src >= 0) ? *(const f32x4*)(W + (size_t)(k0 + kk) * Nsrc + src) : (f32x4){0.f, 0.f, 0.f, 0.f}; }
#pragma unroll
    for (int i = 0; i < 16; ++i) { const int kk = 4 * i + (lane >> 4); float* d = scr + kk * 65 + nq; d[0] = v[i][0]; d[1] = v[i][1]; d[2] = v[i][2]; d[3] = v[i][3]; }
    asm volatile("s_waitcnt lgkmcnt(0)" ::: "memory");
    const int cc = lane & 7;
#pragma unroll
    for (int j = 0; j < 8; ++j) { const int n = (lane >> 3) + 8 * j; const float* sp = scr + (8 * cc) * 65 + n;
        u32x4 ov; ov.x = cvtpk(sp[0 * 65], sp[1 * 65]); ov.y = cvtpk(sp[2 * 65], sp[3 * 65]); ov.z = cvtpk(sp[4 * 65], sp[5 * 65]); ov.w = cvtpk(sp[6 * 65], sp[7 * 65]);
        *(u32x4*)(WT + (size_t)(n0 + n) * K + k0 + 8 * cc) = ov; }
    asm volatile("s_waitcnt lgkmcnt(0)" ::: "memory");
}
__device__ __forceinline__ void sincos_acc(float ang, float& sn, float& cs) {
    const double a = (double)ang;
    const double k = __builtin_rint(a * 0.15915494309189535);
    const double r = (a - k * 6.283185307179586) * 0.25;
    const double r2 = r * r;
    double s = r * (1.0 + r2 * (-1.0 / 6 + r2 * (1.0 / 120 + r2 * (-1.0 / 5040 + r2 * (1.0 / 362880 + r2 * (-1.0 / 39916800 + r2 * (1.0 / 6227020800.0)))))));
    double c = 1.0 + r2 * (-0.5 + r2 * (1.0 / 24 + r2 * (-1.0 / 720 + r2 * (1.0 / 40320 + r2 * (-1.0 / 3628800 + r2 * (1.0 / 479001600.0))))));
    double s2 = 2.0 * s * c, c2 = c * c - s * s;
    double s4 = 2.0 * s2 * c2, c4 = c2 * c2 - s2 * s2;
    sn = (float)s4; cs = (float)c4;
}

struct Params {
    const float* x; const float* c; const int* positions; const float* norm_g; const float* w_ada; const float* b_ada; const float* w_in; const float* fox_fbias;
    const float* cmp_pos; const float* cmp_w1; const float* cmp_w2; const float* w_out; const float* ffn_w13; const float* ffn_w2; const float* final_g;
    float* out; unsigned char* ws;
};

__device__ __forceinline__ void prologue(const Params& P, unsigned char* lds, int tid, int lane, int wave, int G) {
    unsigned char* ws = P.ws;
    float* cact = (float*)lds;
    float* part = (float*)(lds + 65536);
    for (int i = tid; i < NB * DM; i += 512) { const float v = P.c[i]; cact[i] = v / (1.0f + __expf(-v)); }
    __syncthreads();
    float* MOD = (float*)(ws + WS_MOD);
    for (int item = blockIdx.x; item < DEPTH * 64; item += G) {
        const int l = item >> 6, jb = (item & 63) * 144, j0 = jb + 4 * lane;
        const bool act = lane < 36;
        const float* wp = P.w_ada + (size_t)l * DM * NADA + (act ? j0 : jb);
        f32x4 acc4[16];
#pragma unroll
        for (int b = 0; b < 16; ++b) acc4[b] = (f32x4){0.f, 0.f, 0.f, 0.f};
        const int kbeg = wave * 128;
#pragma unroll 4
        for (int k = kbeg; k < kbeg + 128; ++k) {
            const f32x4 w = *(const f32x4*)(wp + (size_t)k * NADA);
#pragma unroll
            for (int b = 0; b < 16; ++b) acc4[b] += w * cact[b * DM + k];
        }
        if (act) {
#pragma unroll
            for (int b = 0; b < 16; ++b) *(f32x4*)(part + (wave * 16 + b) * 144 + 4 * lane) = acc4[b];
        }
        __syncthreads();
        for (int o = tid; o < 16 * 144; o += 512) {
            const int b = o / 144, col = o % 144;
            float sm = 0.f;
#pragma unroll
            for (int w = 0; w < 8; ++w) sm += part[(w * 16 + b) * 144 + col];
            const int j = jb + col;
            MOD[((size_t)l * NB + b) * NADA + j] = sm + P.b_ada[(size_t)l * NADA + j];
        }
        __syncthreads();
    }
    float* scr = (float*)(lds + wave * 16640);
    const int gw = blockIdx.x * NWAVES + wave, NGW = G * NWAVES;
    constexpr int I_WIN = 16 * 48, I_WOUT = 16 * 16, I_CW1 = 32 * 4, I_W13 = 16 * 88, I_W2 = 44 * 16, I_CW2 = 4 * 1;
    constexpr int T_WIN = 4 * I_WIN, T_WOUT = 4 * I_WOUT, T_CW1 = 8 * I_CW1, T_W13 = 8 * I_W13, T_W2 = 8 * I_W2, T_CW2 = 8 * I_CW2;
    constexpr int NITEMS = T_WIN + T_WOUT + T_CW1 + T_W13 + T_W2 + T_CW2;
    for (int it = gw; it < NITEMS; it += NGW) {
        int r = it;
        if (r < T_W13) { const int q = r / I_W13; transpose_item<1>(P.ffn_w13 + (size_t)q * DM * 2 * FF, DM, 2 * FF, 2 * FF, (bf16_t*)(ws + WS_W13) + (size_t)q * 2 * FF * DM, scr, r % I_W13, lane); continue; } r -= T_W13;
        if (r < T_W2) { const int q = r / I_W2; transpose_item<0>(P.ffn_w2 + (size_t)q * FF * DM, FF, DM, DM, (bf16_t*)(ws + WS_W2) + (size_t)q * DM * FF, scr, r % I_W2, lane); continue; } r -= T_W2;
        if (r < T_WIN) { const int q = r / I_WIN; transpose_item<2>(P.w_in + (size_t)q * DM * 2844, DM, 2844, NIN, (bf16_t*)(ws + WS_WIN) + (size_t)q * NIN * DM, scr, r % I_WIN, lane); continue; } r -= T_WIN;
        if (r < T_WOUT) { const int q = r / I_WOUT; transpose_item<0>(P.w_out + (size_t)q * DM * DM, DM, DM, DM, (bf16_t*)(ws + WS_WOUT) + (size_t)q * DM * DM, scr, r % I_WOUT, lane); continue; } r -= T_WOUT;
        if (r < T_CW1) { const int q = r / I_CW1; transpose_item<0>(P.cmp_w1 + (size_t)q * 2048 * 256, 2048, 256, 256, (bf16_t*)(ws + WS_CW1) + (size_t)q * 256 * 2048, scr, r % I_CW1, lane); continue; } r -= T_CW1;
        { const int q = r / I_CW2; transpose_item<0>(P.cmp_w2 + (size_t)q * 256 * 64, 256, 64, 64, (bf16_t*)(ws + WS_CW2T) + (size_t)q * 64 * 256, scr, r % I_CW2, lane); }
    }
    {
        float* cosT = (float*)(ws + WS_COS); float* sinT = (float*)(ws + WS_SIN);
        for (int e = blockIdx.x * 512 + tid; e < NTOK * 8; e += G * 512) {
            const int i = e & 7;
            const float inv = (i == 0) ? 1.0f : (i == 1) ? 0.1939227432012558f : (i == 2) ? 0.03760603070259094f : (i == 3) ? 0.007292664609849453f :
                              (i == 4) ? 0.0014142135623842478f : (i == 5) ? 0.00027424818836152554f : (i == 6) ? 5.318296098266728e-05f : 1.0313386155758053e-05f;
            const float ang = (float)P.positions[e >> 3] * inv;
            float sn, cs; sincos_acc(ang, sn, cs);
            cosT[e] = cs; sinT[e] = sn;
        }
    }
}

__device__ __forceinline__ void norm_phase(const float* xin, const float* g, const float* mod  , bf16_t* H, int lane, int wave, int G) {
    const int gw = blockIdx.x * NWAVES + wave, NGW = G * NWAVES;
    const f32x4* gr = (const f32x4*)g + lane;
    f32x4 gg[4];
#pragma unroll
    for (int j = 0; j < 4; ++j) gg[j] = gr[64 * j];
    f32x4 v[4], v1[4], sh[4], sc[4];
    int row = gw;
    if (row < NTOK) {
        const f32x4* xr = (const f32x4*)(xin + (size_t)row * DM) + lane;
        const f32x4* shp = (const f32x4*)(mod + (size_t)(row >> 11) * NADA) + lane;
#pragma unroll
        for (int j = 0; j < 4; ++j) { v[j] = xr[64 * j]; sh[j] = shp[64 * j]; sc[j] = shp[256 + 64 * j]; }
    }
    if (row + NGW < NTOK) {
        const f32x4* xr = (const f32x4*)(xin + (size_t)(row + NGW) * DM) + lane;
#pragma unroll
        for (int j = 0; j < 4; ++j) v1[j] = xr[64 * j];
    }
    for (; row < NTOK; row += NGW) {
        const int r1 = row + NGW, r2 = row + 2 * NGW;
        f32x4 v2[4], shn[4], scn[4];
        if (r2 < NTOK) {
            const f32x4* xr = (const f32x4*)(xin + (size_t)r2 * DM) + lane;
#pragma unroll
            for (int j = 0; j < 4; ++j) v2[j] = xr[64 * j];
        }
        if (r1 < NTOK) {
            const f32x4* shp = (const f32x4*)(mod + (size_t)(r1 >> 11) * NADA) + lane;
#pragma unroll
            for (int j = 0; j < 4; ++j) { shn[j] = shp[64 * j]; scn[j] = shp[256 + 64 * j]; }
        }
        float s = 0.f;
#pragma unroll
        for (int j = 0; j < 4; ++j) s += (v[j].x * v[j].x + v[j].y * v[j].y) + (v[j].z * v[j].z + v[j].w * v[j].w);
        const float rstd = 1.0f / sqrtf(wave_sum(s) * (1.0f / DM) + 1e-6f);
        u32x2* o8 = (u32x2*)(H + (size_t)row * DM) + lane;
#pragma unroll
        for (int j = 0; j < 4; ++j) {
            const f32x4 y = v[j] * rstd * gg[j] * (sc[j] + 1.0f) + sh[j];
            u32x2 w; w.x = cvtpk(y.x, y.y); w.y = cvtpk(y.z, y.w);
            o8[64 * j] = w;
        }
#pragma unroll
        for (int j = 0; j < 4; ++j) { v[j] = v1[j]; v1[j] = v2[j]; sh[j] = shn[j]; sc[j] = scn[j]; }
    }
}
__device__ __forceinline__ void final_norm(float* x, const float* g, int lane, int wave, int G) {
    const int gw = blockIdx.x * NWAVES + wave, NGW = G * NWAVES;
    const f32x4* gr = (const f32x4*)g + lane;
    f32x4 gg[4];
#pragma unroll
    for (int j = 0; j < 4; ++j) gg[j] = gr[64 * j];
    f32x4 v[4];
    int row = gw;
    if (row < NTOK) { const f32x4* xr = (const f32x4*)(x + (size_t)row * DM) + lane;
#pragma unroll
        for (int j = 0; j < 4; ++j) v[j] = xr[64 * j]; }
    for (; row < NTOK; row += NGW) {
        f32x4 vn[4];
        if (row + NGW < NTOK) { const f32x4* xr = (const f32x4*)(x + (size_t)(row + NGW) * DM) + lane;
#pragma unroll
            for (int j = 0; j < 4; ++j) vn[j] = xr[64 * j]; }
        float s = 0.f;
#pragma unroll
        for (int j = 0; j < 4; ++j) s += (v[j].x * v[j].x + v[j].y * v[j].y) + (v[j].z * v[j].z + v[j].w * v[j].w);
        const float rstd = 1.0f / sqrtf(wave_sum(s) * (1.0f / DM) + 1e-6f);
        f32x4* xo = (f32x4*)(x + (size_t)row * DM) + lane;
#pragma unroll
        for (int j = 0; j < 4; ++j) xo[64 * j] = v[j] * rstd * gg[j];
#pragma unroll
        for (int j = 0; j < 4; ++j) v[j] = vn[j];
    }
}

__global__ void __launch_bounds__(512, 2) fwd_megakernel(Params P) {
    extern __shared__ __attribute__((aligned(16))) unsigned char lds[];
    cg::grid_group grid = cg::this_grid();
    const int tid = threadIdx.x, lane = tid & 63, wave = __builtin_amdgcn_readfirstlane(tid >> 6), wave0 = wave;
    const int G = gridDim.x;
    unsigned char* ws = P.ws;
    LAS unsigned char* lds3 = (LAS unsigned char*)lds;
    const float* MOD = (const float*)(ws + WS_MOD);
    unsigned* ctl = (unsigned*)(ws + WS_CTL);

    volatile LAS unsigned* bst = (volatile LAS unsigned*)(lds3 + LDS_BYTES - 64);
    if (tid == 0) { bst[0] = 0u; bst[1] = 0u; }
    __syncthreads();
    const unsigned xcc = (unsigned)__builtin_amdgcn_readfirstlane((int)xb_xcc_id());
    xcd_barrier_post(ctl + 65536, xcc, bst);
    const bool leader = (tid == 0);
#define GRID_BAR() xcd_barrier((unsigned*)(P.ws + WS_CTL) + 65536, xcc, bst, leader)
    prologue(P, lds, tid, lane, wave, G);
    if (P.ws == nullptr) grid.sync();
    GRID_BAR();
    if (tid == 0) {
        bool ok = ((G & 7) == 0);
        for (unsigned j = 0; j < 16; ++j) { const unsigned cnt = xb_ld(ctl + 65536 + XB_XCNT(j)); ok = ok && (cnt == ((j < 8u) ? (unsigned)(G >> 3) : 0u)); }
        bst[3] = ok ? (bst[2] * 8u + xcc) : (unsigned)blockIdx.x;
    }
    __syncthreads();
    const int vbid = __builtin_amdgcn_readfirstlane((int)bst[3]);
#ifdef PROBE_SYNC20
    for (int i = 0; i < 20; ++i) GRID_BAR();
#endif
    {
        const int ln = fresh_lane(), wv = wave0;
        for (int it = blockIdx.x * NWAVES + wv; it < 8 * 256; it += G * NWAVES) {
            const int lm = it >> 8;
            const bf16_t* wr_ = (const bf16_t*)(ws + WS_CW1) + (size_t)it * 2048 + ln * 32;
            const float* pp = P.cmp_pos + (size_t)lm * 2048 + ln * 32;
            float a = 0.f;
#pragma unroll
            for (int j = 0; j < 4; ++j) {
                const bf16x8 wv8 = *(const bf16x8*)(wr_ + 8 * j);
                const f32x4 p0 = *(const f32x4*)(pp + 8 * j), p1 = *(const f32x4*)(pp + 8 * j + 4);
#pragma unroll
                for (int i = 0; i < 4; ++i) { a += p0[i] * bf2f(wv8[i]); a += p1[i] * bf2f(wv8[4 + i]); }
            }
            a = wave_sum(a);
            if (ln == 0) ((float*)(ws + WS_B1))[it] = a;
        }
    }

    const float* xin = P.x;
    for (int l = 0; l < DEPTH; ++l) {
        const float* modl = MOD + (size_t)l * NB * NADA;
        for (int sub = 0; sub < 3; ++sub) {
            unsigned char* ws = launder_p(P.ws);
            const int bid = launder_i(vbid);
            const int lane = fresh_lane(), wave = wave0;
            norm_phase(xin, P.norm_g + ((size_t)l * 3 + sub) * DM, modl + (size_t)sub * 3 * DM, (bf16_t*)(ws + WS_H), lane, wave, G);
            GRID_BAR();
            if (sub != 1) {
                const int s = (sub == 0) ? 0 : 1;
                {
                    pg8::Gemm g{(const bf16_t*)(ws + WS_H), (const bf16_t*)(ws + WS_W13) + (size_t)(l * 2 + s) * 2 * FF * DM, NTOK, 2 * FF, DM, DM};
                    pg8::StaticOrder S; S.init(NTOK, 2 * FF, G, bid);
                    EpiSwiglu E{(bf16_t*)(ws + WS_BIG)};
#ifndef NO_G1
                    pg8::gemm_phase<EpiSwiglu, true>(lds3, g, S, E, wave0);
#endif
#ifdef PROBE_G1X2
                    pg8::gemm_phase<EpiSwiglu, true>(lds3, g, S, E, wave0);
#endif
                }
                GRID_BAR();
                {
                    pg8::Gemm g{(const bf16_t*)(ws + WS_BIG), (const bf16_t*)(ws + WS_W2) + (size_t)(l * 2 + s) * DM * FF, NTOK, DM, FF, FF};
                    pg8::StaticOrder S; S.init(NTOK, DM, G, bid);
                    EpiResid E{xin, P.out, modl + (size_t)(sub * 3 + 2) * DM, 0.5f};
#ifndef NO_G2
                    pg8::gemm_phase<EpiResid, true>(lds3, g, S, E, wave0);
#endif
                }
                xin = P.out;
                GRID_BAR();
            } else {
                {
                    pg8::Gemm g{(const bf16_t*)(ws + WS_H), (const bf16_t*)(ws + WS_WIN) + (size_t)l * NIN * DM, NTOK, NIN, DM, DM};
                    pg8::StaticOrder S; S.init(NTOK, NIN, G, bid);
                    EpiInProj E{ws, P.fox_fbias + l * 4};
#ifndef NO_INPROJ
                    pg8::gemm_phase<EpiInProj, true>(lds3, g, S, E, wave0);
#endif
                }
                GRID_BAR();
                if (bid < 32) {
                    const int mat = bid >> 4;
                    pg8::Gemm g{(const bf16_t*)(ws + (mat ? WS_VC : WS_KC)), (const bf16_t*)(ws + WS_CW1) + (size_t)(l * 2 + mat) * 256 * 2048, 4096, 256, 2048, 1024};
                    pg8::StaticOrder S; S.init(4096, 256, 16, bid & 15);
                    EpiGelu E{(bf16_t*)(ws + WS_CMPHID) + (size_t)mat * 4096 * 256, (const float*)(ws + WS_B1) + (l * 2 + mat) * 256};
#ifndef NO_CMP1
                    pg8::gemm_phase<EpiGelu, true>(lds3, g, S, E, wave0);
#endif
                } else {
                    const int nw = (G - 32) * NWAVES;
                    for (int it = (bid - 32) * NWAVES + wave; it < 64 + 512; it += nw) {
                        if (it < 64) {
                            const float* src = (const float*)(ws + WS_FLOG) + (size_t)it * SEQ + lane * 32;
                            float v[32];
#pragma unroll
                            for (int j = 0; j < 8; ++j) { const f32x4 q = *(const f32x4*)(src + 4 * j); v[4 * j] = q.x; v[4 * j + 1] = q.y; v[4 * j + 2] = q.z; v[4 * j + 3] = q.w; }
#pragma unroll
                            for (int j = 1; j < 32; ++j) v[j] += v[j - 1];
                            float tot = v[31], inc = tot;
#pragma unroll
                            for (int o = 1; o < 64; o <<= 1) { const float n = __shfl_up(inc, o); if (lane >= o) inc += n; }
                            const float excl = inc - tot;
                            float* dst = (float*)(ws + WS_FCUM) + (size_t)it * SEQ + lane * 32;
#pragma unroll
                            for (int j = 0; j < 8; ++j) { f32x4 q; q.x = (v[4 * j] + excl) * -8.0f; q.y = (v[4 * j + 1] + excl) * -8.0f; q.z = (v[4 * j + 2] + excl) * -8.0f; q.w = (v[4 * j + 3] + excl) * -8.0f; *(f32x4*)(dst + 4 * j) = q; }
                        } else {
                            const int id = it - 64;
                            const bf16_t* kp = (const bf16_t*)(ws + WS_MOBAK) + (size_t)id * 256 * 64 + (((lane >> 4) * 64 + ((lane >> 3) & 1) * 32) * 8 + (lane & 7));
                            float a = 0.f;
#pragma unroll 8
                            for (int k = 0; k < 256; ++k) a += bf2f((short)kp[(size_t)(k >> 6) * 4096 + (((k >> 5) & 1) * 4 * 64 + (k & 31)) * 8]);
                            ((float*)(ws + WS_KMEAN))[(size_t)id * 64 + lane] = a * (1.0f / 256.0f);
                        }
                    }
                }
                GRID_BAR();
                for (int it = bid * NWAVES + wave; it < 256; it += G * NWAVES) {
                    const int mat = it >> 7, rt = it & 127, hi = lane >> 5, c = lane & 31;
                    const bf16_t* A = (const bf16_t*)(ws + WS_CMPHID) + ((size_t)mat * 4096 + rt * 32 + c) * 256 + 8 * hi;
                    const bf16_t* Bt = (const bf16_t*)(ws + WS_CW2T) + (size_t)(l * 2 + mat) * 64 * 256 + (size_t)c * 256 + 8 * hi;
                    f32x16 a0, a1;
#pragma unroll
                    for (int r = 0; r < 16; ++r) { a0[r] = 0.f; a1[r] = 0.f; }
#pragma unroll 4
                    for (int ks = 0; ks < 16; ++ks) {
                        const bf16x8 af = *(const bf16x8*)(A + 16 * ks);
                        const bf16x8 b0 = *(const bf16x8*)(Bt + 16 * ks), b1 = *(const bf16x8*)(Bt + 32 * 256 + 16 * ks);
                        a0 = MFMA32(af, b0, a0); a1 = MFMA32(af, b1, a1);
                    }
#pragma unroll
                    for (int r = 0; r < 16; ++r) {
                        const int row = rt * 32 + crow(r, hi), rl = row & 127, bg = row >> 7;
                        const float v0 = (rl == 127) ? 0.f : a0[r], v1 = (rl == 127) ? 0.f : a1[r];
                        const bf16_t h0 = (bf16_t)(cvtpk(v0, 0.f) & 0xffffu), h1 = (bf16_t)(cvtpk(v1, 0.f) & 0xffffu);
                        if (mat == 0) {
                            bf16_t* kc = (bf16_t*)(ws + WS_KCMP) + (size_t)bg * 8192 + (rl >> 6) * 4096 + ((((rl >> 5) & 1) * 4) * 64 + (rl & 31)) * 8;
                            const int o0 = ((c >> 4) * 64 + ((c >> 3) & 1) * 32) * 8 + (c & 7);
                            kc[o0] = h0; kc[o0 + 2 * 64 * 8] = h1;
                        } else {
                            const int tt = rl & 63;
                            bf16_t* vc = (bf16_t*)(ws + WS_VCMPT) + (size_t)bg * 8192 + (rl >> 6) * 4096
                                         + ((((tt >> 5) * 2 + ((tt >> 4) & 1)) * 2) * 64 + ((tt >> 2) & 1) * 32 + c) * 8 + ((tt >> 3) & 1) * 4 + (tt & 3);
                            vc[0] = h0; vc[64 * 8] = h1;
                        }
                    }
                }
                GRID_BAR();
                {
#ifdef PROBE_ATTN2
                  for (int rep = 0; rep < 2; ++rep)
#else
                  const int rep = 0;
#endif
                  {
                    float* wl = (float*)(lds + wave * 16384);
                    const int lane_ = lane;
                    const int myq = (int)(__builtin_amdgcn_s_getreg((3 << 11) | 20) & 7u);
                    for (int qi = 0; qi < 8; ++qi) {
                        const int q = (myq + qi) & 7;
                        unsigned* ctr = ctl + 64 * (1 + (l * 2 + rep) * 8 + q);
                        for (;;) {
                            unsigned u = 0;
                            if (lane_ == 0) u = atomicAdd(ctr, 1u);
                            u = (unsigned)__builtin_amdgcn_readfirstlane((int)u);
                            if (u >= 2048u) break;
                            const int lane = launder_v(lane_);
                            if (u < 1024u) {
                                const int pr = (int)(u >> 9), i = (int)(u & 511u), slot = 63 - (i >> 3), w = i & 7;
                                const int bg = 4 * q + 2 * pr + (w >> 2);
                                nsa_unit(ws, bg >> 1, bg & 1, slot * 4 + (w & 3), lane, wl);
                            } else if (u < 1536u) {
                                const int i = (int)(u - 1024u), hf = i >> 8, slot = 63 - ((i & 255) >> 2);
                                fox_unit(ws, 8 * q + 4 * hf + (i & 3), slot, lane);
                            } else {
                                const int i = (int)(u - 1536u), hf = i >> 8, slot = 63 - ((i & 255) >> 2);
                                moba_unit(ws, 8 * q + 4 * hf + (i & 3), slot, lane);
                            }
                        }
                    }
                  }
                }
                GRID_BAR();
                {
                    pg8::Gemm g{(const bf16_t*)(ws + WS_H), (const bf16_t*)(ws + WS_WOUT) + (size_t)l * DM * DM, NTOK, DM, DM, DM};
                    pg8::StaticOrder S; S.init(NTOK, DM, G, bid);
                    EpiResid E{xin, P.out, modl + (size_t)(1 * 3 + 2) * DM, 1.0f};
#ifndef NO_OUTPROJ
                    pg8::gemm_phase<EpiResid, true>(lds3, g, S, E, wave0);
#endif
                }
                GRID_BAR();
            }
        }
    }
    final_norm(P.out, P.final_g, fresh_lane(), wave0, G);
}

extern "C" void kernel_launch(void* const* d_in, const int* in_sizes, int n_in, void* d_out, int out_size, void* d_ws, size_t ws_size, hipStream_t stream) {
    static int grid_blocks = 0;
    if (grid_blocks == 0) {
        if (n_in != 15 || ws_size < WS_END) { fprintf(stderr, "kernel_launch: unexpected inputs (n_in %d, ws %zu)\n", n_in, ws_size); grid_blocks = -1; return; }
        int dev = 0, cus = 0, per_cu = 0;
        hipGetDevice(&dev);
        hipDeviceGetAttribute(&cus, hipDeviceAttributeMultiprocessorCount, dev);
        if (hipFuncSetAttribute((const void*)fwd_megakernel, hipFuncAttributeMaxDynamicSharedMemorySize, LDS_BYTES) != hipSuccess) fprintf(stderr, "kernel_launch: hipFuncSetAttribute failed\n");
        if (hipOccupancyMaxActiveBlocksPerMultiprocessor(&per_cu, (const void*)fwd_megakernel, 512, LDS_BYTES) != hipSuccess || per_cu < 1) { fprintf(stderr, "kernel_launch: occupancy query gave %d\n", per_cu); per_cu = 1; }
        (void)hipGetLastError();
        grid_blocks = cus * per_cu;
        if (grid_blocks > 256) grid_blocks = 256;
    }
    if (grid_blocks < 0) return;
    hipMemsetAsync((char*)d_ws + WS_CTL, 0, 1 * MiB, stream);
    Params p{};
    p.x = (const float*)d_in[0]; p.c = (const float*)d_in[1]; p.positions = (const int*)d_in[2]; p.norm_g = (const float*)d_in[3];
    p.w_ada = (const float*)d_in[4]; p.b_ada = (const float*)d_in[5]; p.w_in = (const float*)d_in[6]; p.fox_fbias = (const float*)d_in[7];
    p.cmp_pos = (const float*)d_in[8]; p.cmp_w1 = (const float*)d_in[9]; p.cmp_w2 = (const float*)d_in[10]; p.w_out = (const float*)d_in[11];
    p.ffn_w13 = (const float*)d_in[12]; p.ffn_w2 = (const float*)d_in[13]; p.final_g = (const float*)d_in[14];
    p.out = (float*)d_out; p.ws = (unsigned char*)d_ws;
    void* args[] = {&p};
    hipError_t e = hipLaunchCooperativeKernel((const void*)fwd_megakernel, dim3(grid_blocks), dim3(512), args, LDS_BYTES, stream);
    if (e != hipSuccess) fprintf(stderr, "kernel_launch: cooperative launch failed: %s (grid %d)\n", hipGetErrorString(e), grid_blocks);
}
```
